# Optimizing an MI355X kernel written in HIP

```python
import math
import jax, jax.numpy as jnp
from jax import lax
import numpy as np

D_MODEL = 1024
BATCH = 8
SEQ = 4096
DEPTH = 2

MEM_LEN = 256
D_FF = 2816
LN_EPS = 1e-5
RMS_EPS = 1e-6
ROPE_THETA = 10000.0
DEEPNORM_ALPHA = (2 * DEPTH) ** 0.25
DEEPNORM_BETA = (8 * DEPTH) ** -0.25
Q_BLOCK = 128
NEG_INF = -1e30
N_BRANCHES = 4

GMLP_CHUNK = 128
GMLP_GROUPS = 4
GMLP_WIDTH = 512
GMLP_GROUP_DIM = GMLP_WIDTH // GMLP_GROUPS

CONV_WIDTH = 512
CONV_K = 3

MLA_HEADS = 8
MLA_Q_RANK = 256
MLA_KV_RANK = 128
MLA_NOPE = 64
MLA_ROPE = 32
MLA_V = 64

NSA_HEADS = 8
NSA_KV_GROUPS = 2
NSA_HPG = NSA_HEADS // NSA_KV_GROUPS
NSA_DIM = 64
NSA_KV_WIDTH = NSA_KV_GROUPS * NSA_DIM
CMP_BLOCK = 32
CMP_STRIDE = 16
SLC_BLOCK = 64
SLC_TOPK = 8
WINDOW = 512

XATTN_HEADS = 4
XATTN_DIM = 128

IN_SPLITS = (GMLP_WIDTH, GMLP_WIDTH,
             CONV_WIDTH, CONV_WIDTH, CONV_WIDTH,
             MLA_Q_RANK, MLA_KV_RANK, MLA_ROPE,
             NSA_HEADS * NSA_DIM) + (NSA_KV_WIDTH,) * 6 + (NSA_HEADS * 3,) + (D_MODEL,) * N_BRANCHES
IN_WIDTH = sum(IN_SPLITS)

kernel_name = 'hybrid_gated_parallel_mixer_deepnorm'


def _layer_norm(x, g, b):
    xf = x.astype(jnp.float32)
    mu = jnp.mean(xf, -1, keepdims=True)
    var = jnp.mean(jnp.square(xf - mu), -1, keepdims=True)
    return ((xf - mu) * lax.rsqrt(var + LN_EPS) * g + b).astype(x.dtype)


def _rms_norm(x, g):
    xf = x.astype(jnp.float32)
    return (xf * lax.rsqrt(jnp.mean(xf * xf, -1, keepdims=True) + RMS_EPS) * g).astype(x.dtype)


def _rope_tables(pos, dim):
    inv = ROPE_THETA ** (-(jnp.arange(0, dim, 2, dtype=jnp.float32) / dim))
    ang = pos[:, None] * inv[None, :]
    return jnp.cos(ang), jnp.sin(ang)


def _apply_rope(x, cos, sin):
    x1, x2 = jnp.split(x.astype(jnp.float32), 2, axis=-1)
    return jnp.concatenate([x1 * cos - x2 * sin, x1 * sin + x2 * cos], -1).astype(x.dtype)


def _swiglu(x, w1, w3, w2):
    return (jax.nn.silu(x @ w1) * (x @ w3)) @ w2


def _blocked_causal_attention(q, k, v, scale):
    Bsz, S, H, dk = q.shape
    nq = S // Q_BLOCK
    qb = q.reshape(Bsz, nq, Q_BLOCK, H, dk).transpose(1, 0, 2, 3, 4)
    kpos = jnp.arange(S)

    def one(args):
        qi, blk = args
        qpos = blk * Q_BLOCK + jnp.arange(Q_BLOCK)
        s = jnp.einsum('bthd,bshd->bhts', qi, k).astype(jnp.float32) * scale
        s = jnp.where(kpos[None, :] <= qpos[:, None], s, NEG_INF)
        p = jax.nn.softmax(s, axis=-1).astype(v.dtype)
        return jnp.einsum('bhts,bshd->bthd', p, v)

    o = lax.map(one, (qb, jnp.arange(nq)))
    return o.transpose(1, 0, 2, 3, 4).reshape(Bsz, S, H, v.shape[-1])


def _gmlp_branch(u, v, ln_g, ln_b, w_s, b_s, w_out):
    Bsz, S, _ = u.shape
    n_chunk = S // GMLP_CHUNK
    v = _layer_norm(v, ln_g, ln_b).reshape(Bsz, n_chunk, GMLP_CHUNK, GMLP_GROUPS, GMLP_GROUP_DIM)
    causal = jnp.tril(jnp.ones((GMLP_CHUNK, GMLP_CHUNK), dtype=bool))
    w = jnp.where(causal, w_s, 0)
    s = jnp.einsum('gts,bcsgd->bctgd', w, v) + b_s.T[:, :, None]
    return (u * s.reshape(Bsz, S, GMLP_WIDTH)) @ w_out


def _short_conv_branch(b_gate, c_gate, h, conv_w, w_out):
    S = h.shape[1]
    zp = jnp.pad(c_gate * h, ((0, 0), (CONV_K - 1, 0), (0, 0)))
    y = zp[:, 0:S] * conv_w[0]
    for k in range(1, CONV_K):
        y = y + zp[:, k:k + S] * conv_w[k]
    return (b_gate * y) @ w_out


def _mla_branch(q_lat, kv_lat, k_rope, qn_g, kvn_g, w_uq, w_ukv, w_out, pos):
    Bsz, S, _ = q_lat.shape
    cos, sin = _rope_tables(pos, MLA_ROPE)
    q = (_rms_norm(q_lat, qn_g) @ w_uq).reshape(Bsz, S, MLA_HEADS, MLA_NOPE + MLA_ROPE)
    q = jnp.concatenate([q[..., :MLA_NOPE], _apply_rope(q[..., MLA_NOPE:], cos[:, None], sin[:, None])], -1)
    kv = (_rms_norm(kv_lat, kvn_g) @ w_ukv).reshape(Bsz, S, MLA_HEADS, MLA_NOPE + MLA_V)
    k_pe = _apply_rope(k_rope, cos, sin)[:, :, None, :]
    k = jnp.concatenate([kv[..., :MLA_NOPE], jnp.broadcast_to(k_pe, (Bsz, S, MLA_HEADS, MLA_ROPE))], -1)
    v = kv[..., MLA_NOPE:]
    o = _blocked_causal_attention(q, k, v, (MLA_NOPE + MLA_ROPE) ** -0.5)
    return o.reshape(Bsz, S, MLA_HEADS * MLA_V) @ w_out


def _nsa_branch(q, k_c, v_c, k_s, v_s, k_w, v_w, gate, pe_k, pe_v, wcmp_k, wcmp_v, w_out, pos):
    Bsz, S, _ = q.shape
    G, Hg, d = NSA_KV_GROUPS, NSA_HPG, NSA_DIM
    cos, sin = _rope_tables(pos, d)
    q = _apply_rope(q.reshape(Bsz, S, NSA_HEADS, d), cos[:, None], sin[:, None])
    k_c, v_c, k_s, v_s, k_w, v_w = [t.reshape(Bsz, S, G, d) for t in (k_c, v_c, k_s, v_s, k_w, v_w)]
    k_s = _apply_rope(k_s, cos[:, None], sin[:, None])
    k_w = _apply_rope(k_w, cos[:, None], sin[:, None])
    gate = jax.nn.sigmoid(gate).reshape(Bsz, S, NSA_HEADS, 3)

    n_cmp = (S - CMP_BLOCK) // CMP_STRIDE + 1
    cmp_start = jnp.arange(n_cmp) * CMP_STRIDE
    cmp_end = cmp_start + CMP_BLOCK - 1
    cmp_idx = cmp_start[:, None] + jnp.arange(CMP_BLOCK)[None, :]
    k_cmp = jnp.einsum('bnlgd,lde->bnge', k_c[:, cmp_idx] + pe_k[:, None, :], wcmp_k)
    v_cmp = jnp.einsum('bnlgd,lde->bnge', v_c[:, cmp_idx] + pe_v[:, None, :], wcmp_v)
    ccos, csin = _rope_tables(cmp_end.astype(jnp.float32), d)
    k_cmp = _apply_rope(k_cmp, ccos[:, None], csin[:, None])

    n_slc = S // SLC_BLOCK
    slc_start = jnp.arange(n_slc) * SLC_BLOCK
    ov = (jnp.minimum(cmp_start[:, None] + CMP_BLOCK, slc_start[None, :] + SLC_BLOCK)
          - jnp.maximum(cmp_start[:, None], slc_start[None, :]))
    overlap = jnp.clip(ov, 0).astype(jnp.float32) / CMP_BLOCK
    top_k = min(SLC_TOPK, n_slc)

    ks_blk = k_s.transpose(0, 2, 1, 3).reshape(Bsz, G, n_slc, SLC_BLOCK, d)
    vs_blk = v_s.transpose(0, 2, 1, 3).reshape(Bsz, G, n_slc, SLC_BLOCK, d)
    kw_pad = jnp.pad(k_w, ((0, 0), (WINDOW, 0), (0, 0), (0, 0)))
    vw_pad = jnp.pad(v_w, ((0, 0), (WINDOW, 0), (0, 0), (0, 0)))
    b_idx = jnp.arange(Bsz)[:, None, None, None]
    g_idx = jnp.arange(G)[None, :, None, None]
    scale = d ** -0.5
    jr = jnp.arange(n_slc)

    nq = S // Q_BLOCK
    qb = q.reshape(Bsz, nq, Q_BLOCK, G, Hg, d).transpose(1, 0, 2, 3, 4, 5)
    gb = gate.reshape(Bsz, nq, Q_BLOCK, G, Hg, 3).transpose(1, 0, 2, 3, 4, 5)

    def one(args):
        qi, g_blk, blk = args
        qpos = blk * Q_BLOCK + jnp.arange(Q_BLOCK)
        s = jnp.einsum('btghd,bngd->bghtn', qi, k_cmp).astype(jnp.float32) * scale
        valid = cmp_end[None, :] <= qpos[:, None]
        p_cmp = jnp.where(valid, jax.nn.softmax(jnp.where(valid, s, NEG_INF), axis=-1), 0.0)
        o_cmp = jnp.einsum('bghtn,bngd->btghd', p_cmp.astype(v_cmp.dtype), v_cmp)
        imp = jnp.einsum('bghtn,nj->bgtj', p_cmp, overlap)
        j_q = qpos // SLC_BLOCK
        forced = (jr[None, :] == 0) | (jr[None, :] == j_q[:, None]) | (jr[None, :] == j_q[:, None] - 1)
        imp = jnp.where(forced, 1e9, imp)
        imp = jnp.where(jr[None, :] <= j_q[:, None], imp, -1.0)
        top_s, top_i = lax.top_k(imp, top_k)
        k_sel = ks_blk[b_idx, g_idx, top_i].reshape(Bsz, G, Q_BLOCK, top_k * SLC_BLOCK, d)
        v_sel = vs_blk[b_idx, g_idx, top_i].reshape(Bsz, G, Q_BLOCK, top_k * SLC_BLOCK, d)
        tok = (top_i[..., None] * SLC_BLOCK + jnp.arange(SLC_BLOCK)).reshape(Bsz, G, Q_BLOCK, top_k * SLC_BLOCK)
        ok = (tok <= qpos[:, None]) & jnp.repeat(top_s >= 0, SLC_BLOCK, axis=-1)
        s = jnp.einsum('btghd,bgtnd->bghtn', qi, k_sel).astype(jnp.float32) * scale
        s = jnp.where(ok[:, :, None], s, NEG_INF)
        o_slc = jnp.einsum('bghtn,bgtnd->btghd', jax.nn.softmax(s, axis=-1).astype(v_sel.dtype), v_sel)
        k_win = lax.dynamic_slice_in_dim(kw_pad, blk * Q_BLOCK, WINDOW + Q_BLOCK, axis=1)
        v_win = lax.dynamic_slice_in_dim(vw_pad, blk * Q_BLOCK, WINDOW + Q_BLOCK, axis=1)
        kpos = blk * Q_BLOCK - WINDOW + jnp.arange(WINDOW + Q_BLOCK)
        dist = qpos[:, None] - kpos[None, :]
        okw = (dist >= 0) & (dist < WINDOW) & (kpos[None, :] >= 0)
        s = jnp.einsum('btghd,bsgd->bghts', qi, k_win).astype(jnp.float32) * scale
        s = jnp.where(okw, s, NEG_INF)
        o_win = jnp.einsum('bghts,bsgd->btghd', jax.nn.softmax(s, axis=-1).astype(v_win.dtype), v_win)
        return g_blk[..., 0:1] * o_cmp + g_blk[..., 1:2] * o_slc + g_blk[..., 2:3] * o_win

    o = lax.map(one, (qb, gb, jnp.arange(nq)))
    o = o.transpose(1, 0, 2, 3, 4, 5).reshape(Bsz, S, NSA_HEADS * d)
    return o @ w_out


def _token_mixing(h, w_in, b_in, gmlp_ln_g, gmlp_ln_b, gmlp_ws, gmlp_bs, gmlp_wout,
                  conv_w, conv_wout, mla_qnorm_g, mla_kvnorm_g, mla_wuq, mla_wukv, mla_wout,
                  nsa_pe_k, nsa_pe_v, nsa_wcmp_k, nsa_wcmp_v, nsa_wout, w_o):
    S = h.shape[1]
    z = h @ w_in + b_in
    offs = np.cumsum(IN_SPLITS)[:-1].tolist()
    (u, v, cb, cc, ch, q_lat, kv_lat, k_rope, nq, nkc, nvc, nks, nvs, nkw, nvw, ngate,
     ga, gb, gc, gd) = jnp.split(z, offs, axis=-1)
    pos = jnp.arange(S, dtype=jnp.float32)
    y_a = _gmlp_branch(u, v, gmlp_ln_g, gmlp_ln_b, gmlp_ws, gmlp_bs, gmlp_wout)
    y_b = _short_conv_branch(cb, cc, ch, conv_w, conv_wout)
    y_c = _mla_branch(q_lat, kv_lat, k_rope, mla_qnorm_g, mla_kvnorm_g, mla_wuq, mla_wukv, mla_wout, pos)
    y_d = _nsa_branch(nq, nkc, nvc, nks, nvs, nkw, nvw, ngate, nsa_pe_k, nsa_pe_v,
                      nsa_wcmp_k, nsa_wcmp_v, nsa_wout, pos)
    merged = (jax.nn.sigmoid(ga) * y_a + jax.nn.sigmoid(gb) * y_b
              + jax.nn.sigmoid(gc) * y_c + jax.nn.sigmoid(gd) * y_d)
    return merged @ w_o


def _cross_attention(x, mem, wq, wk, wv, wo):
    Bsz, S, _ = x.shape
    M = mem.shape[1]
    q = (x @ wq).reshape(Bsz, S, XATTN_HEADS, XATTN_DIM)
    k = (mem @ wk).reshape(Bsz, M, XATTN_HEADS, XATTN_DIM)
    v = (mem @ wv).reshape(Bsz, M, XATTN_HEADS, XATTN_DIM)
    s = jnp.einsum('bthd,bmhd->bhtm', q, k).astype(jnp.float32) * XATTN_DIM ** -0.5
    p = jax.nn.softmax(s, axis=-1).astype(v.dtype)
    o = jnp.einsum('bhtm,bmhd->bthd', p, v).reshape(Bsz, S, XATTN_HEADS * XATTN_DIM)
    return o @ wo


def setup_inputs(seed: int = 0) -> dict:
    key = jax.random.key(seed)
    keys = iter(jax.random.split(key, 64))

    def dense(shape, fan_in, scale=1.0):
        return jax.random.normal(next(keys), (DEPTH,) + shape, jnp.float32) * (scale * fan_in ** -0.5)

    def gain(shape):
        return 1.0 + 0.02 * jax.random.normal(next(keys), (DEPTH,) + shape, jnp.float32)

    def small(shape, s=0.01):
        return s * jax.random.normal(next(keys), (DEPTH,) + shape, jnp.float32)

    D, F = D_MODEL, D_FF
    return {
        'x': jax.random.normal(next(keys), (BATCH, SEQ, D), jnp.float32),
        'mem': jax.random.normal(next(keys), (BATCH, MEM_LEN, D), jnp.float32),
        'ffn1_w1': dense((D, F), D),
        'ffn1_w3': dense((D, F), D),
        'ffn1_w2': dense((F, D), F, DEEPNORM_BETA),
        'ln1_g': gain((D,)),
        'ln1_b': small((D,)),
        'w_in': dense((D, IN_WIDTH), D),
        'b_in': small((IN_WIDTH,)),
        'gmlp_ln_g': gain((GMLP_WIDTH,)),
        'gmlp_ln_b': small((GMLP_WIDTH,)),
        'gmlp_ws': dense((GMLP_GROUPS, GMLP_CHUNK, GMLP_CHUNK), GMLP_CHUNK),
        'gmlp_bs': gain((GMLP_GROUPS, GMLP_CHUNK)),
        'gmlp_wout': dense((GMLP_WIDTH, D), GMLP_WIDTH),
        'conv_w': dense((CONV_K, CONV_WIDTH), CONV_K),
        'conv_wout': dense((CONV_WIDTH, D), CONV_WIDTH),
        'mla_qnorm_g': gain((MLA_Q_RANK,)),
        'mla_kvnorm_g': gain((MLA_KV_RANK,)),
        'mla_wuq': dense((MLA_Q_RANK, MLA_HEADS * (MLA_NOPE + MLA_ROPE)), MLA_Q_RANK),
        'mla_wukv': dense((MLA_KV_RANK, MLA_HEADS * (MLA_NOPE + MLA_V)), MLA_KV_RANK),
        'mla_wout': dense((MLA_HEADS * MLA_V, D), MLA_HEADS * MLA_V),
        'nsa_pe_k': small((CMP_BLOCK, NSA_DIM), 0.02),
        'nsa_pe_v': small((CMP_BLOCK, NSA_DIM), 0.02),
        'nsa_wcmp_k': dense((CMP_BLOCK, NSA_DIM, NSA_DIM), CMP_BLOCK * NSA_DIM),
        'nsa_wcmp_v': dense((CMP_BLOCK, NSA_DIM, NSA_DIM), CMP_BLOCK * NSA_DIM),
        'nsa_wout': dense((NSA_HEADS * NSA_DIM, D), NSA_HEADS * NSA_DIM),
        'w_o': dense((D, D), D, DEEPNORM_BETA),
        'ln2_g': gain((D,)),
        'ln2_b': small((D,)),
        'xattn_wq': dense((D, XATTN_HEADS * XATTN_DIM), D),
        'xattn_wk': dense((D, XATTN_HEADS * XATTN_DIM), D),
        'xattn_wv': dense((D, XATTN_HEADS * XATTN_DIM), D),
        'xattn_wo': dense((XATTN_HEADS * XATTN_DIM, D), XATTN_HEADS * XATTN_DIM, DEEPNORM_BETA),
        'ln3_g': gain((D,)),
        'ln3_b': small((D,)),
        'ffn2_w1': dense((D, F), D),
        'ffn2_w3': dense((D, F), D),
        'ffn2_w2': dense((F, D), F, DEEPNORM_BETA),
        'ln4_g': gain((D,)),
        'ln4_b': small((D,)),
    }


def reference(x, mem, ffn1_w1, ffn1_w3, ffn1_w2, ln1_g, ln1_b, w_in, b_in,
              gmlp_ln_g, gmlp_ln_b, gmlp_ws, gmlp_bs, gmlp_wout, conv_w, conv_wout,
              mla_qnorm_g, mla_kvnorm_g, mla_wuq, mla_wukv, mla_wout,
              nsa_pe_k, nsa_pe_v, nsa_wcmp_k, nsa_wcmp_v, nsa_wout,
              w_o, ln2_g, ln2_b, xattn_wq, xattn_wk, xattn_wv, xattn_wo, ln3_g, ln3_b,
              ffn2_w1, ffn2_w3, ffn2_w2, ln4_g, ln4_b):
    a = DEEPNORM_ALPHA
    for l in range(DEPTH):
        x = _layer_norm(a * x + 0.5 * _swiglu(x, ffn1_w1[l], ffn1_w3[l], ffn1_w2[l]), ln1_g[l], ln1_b[l])
        mix = _token_mixing(x, w_in[l], b_in[l], gmlp_ln_g[l], gmlp_ln_b[l], gmlp_ws[l], gmlp_bs[l],
                            gmlp_wout[l], conv_w[l], conv_wout[l], mla_qnorm_g[l], mla_kvnorm_g[l],
                            mla_wuq[l], mla_wukv[l], mla_wout[l], nsa_pe_k[l], nsa_pe_v[l],
                            nsa_wcmp_k[l], nsa_wcmp_v[l], nsa_wout[l], w_o[l])
        x = _layer_norm(a * x + mix, ln2_g[l], ln2_b[l])
        x = _layer_norm(a * x + _cross_attention(x, mem, xattn_wq[l], xattn_wk[l], xattn_wv[l], xattn_wo[l]),
                        ln3_g[l], ln3_b[l])
        x = _layer_norm(a * x + 0.5 * _swiglu(x, ffn2_w1[l], ffn2_w3[l], ffn2_w2[l]), ln4_g[l], ln4_b[l])
    return x
```

```cpp
#include <hip/hip_runtime.h>
#include <hip/hip_cooperative_groups.h>
#include <cstdio>
#include <cstdint>
namespace cg = cooperative_groups;

typedef unsigned short u16;
using bf16x8 = __attribute__((ext_vector_type(8))) short;
using s16x4 = __attribute__((ext_vector_type(4))) short;
using f32x16 = __attribute__((ext_vector_type(16))) float;
#define DI __device__ __forceinline__
#define MFMA(a, b, c) __builtin_amdgcn_mfma_f32_32x32x16_bf16((a), (b), (c), 0, 0, 0)

constexpr int D = 1024, BATCH = 8, SEQ = 4096, T = BATCH * SEQ, DEPTH = 2, MEML = 256, FF = 2816;
constexpr int BG = 4;
constexpr int TG = BG * SEQ;
constexpr int NGRP = BATCH / BG;
constexpr int ZW = 4352;
constexpr int INW = 8376;
constexpr int ZC_U = 0, ZC_V = 512, ZC_CB = 1024, ZC_CC = 1536, ZC_CH = 2048, ZC_QLAT = 2560, ZC_KVLAT = 2816,
              ZC_NQ = 2944, ZC_NKC = 3456, ZC_NVC = 3584, ZC_NKS = 3712, ZC_NVS = 3840, ZC_NKW = 3968,
              ZC_NVW = 4096, ZC_KROPE = 4224, ZC_GATE = 4256;
constexpr float ALPHA = 1.4142135623730951f;
constexpr int NTHREADS = 512;
constexpr int SMEM_BYTES = 140 * 1024;
constexpr int XB_LDS_OFF = 138 * 1024;

constexpr size_t W_F1W1 = 0;
constexpr size_t W_F1W3 = W_F1W1 + (size_t)FF * D;
constexpr size_t W_F1W2 = W_F1W3 + (size_t)FF * D;
constexpr size_t W_F2W1 = W_F1W2 + (size_t)FF * D;
constexpr size_t W_F2W3 = W_F2W1 + (size_t)FF * D;
constexpr size_t W_F2W2 = W_F2W3 + (size_t)FF * D;
constexpr size_t W_IN = W_F2W2 + (size_t)FF * D;
constexpr size_t W_OUT4 = W_IN + (size_t)(ZW + 4096) * D;
constexpr size_t W_UQ = W_OUT4 + (size_t)4 * 1024 * 512;
constexpr size_t W_UKV = W_UQ + (size_t)768 * 256;
constexpr size_t W_O = W_UKV + (size_t)1024 * 128;
constexpr size_t W_XQ = W_O + (size_t)1024 * 1024;
constexpr size_t W_XKV = W_XQ + (size_t)512 * 1024;
constexpr size_t W_XO = W_XKV + (size_t)1024 * 1024;
constexpr size_t W_CK = W_XO + (size_t)1024 * 512;
constexpr size_t W_CV = W_CK + (size_t)128 * 1024;
constexpr size_t W_GWS = W_CV + (size_t)128 * 1024;
constexpr size_t LAYER_W = W_GWS + (size_t)4 * 128 * 128;

constexpr int F_BZ = 0, F_BGATE = ZW, F_CK = ZW + 4096, F_CV = F_CK + 64, F32_PER_LAYER = F_CV + 64;

constexpr size_t al256(size_t x) { return (x + 255) & ~(size_t)255; }
constexpr size_t cmax(size_t a, size_t b) { return a > b ? a : b; }
constexpr size_t WS_WTS = 0;
constexpr size_t WS_F32 = al256(WS_WTS + 2 * LAYER_W * 2);
constexpr size_t WS_BAR = al256(WS_F32 + (size_t)2 * F32_PER_LAYER * 4);
constexpr size_t WS_TAB64 = al256(WS_BAR + (size_t)4096 * 4);
constexpr size_t WS_TAB32 = al256(WS_TAB64 + (size_t)4096 * 32 * 8);
constexpr size_t WS_XB = al256(WS_TAB32 + (size_t)4096 * 16 * 8);
constexpr size_t WS_MEMB = al256(WS_XB + (size_t)T * D * 2);
constexpr size_t WS_KX = al256(WS_MEMB + (size_t)BATCH * MEML * D * 2);
constexpr size_t WS_VXT = al256(WS_KX + (size_t)BATCH * MEML * 512 * 2);
constexpr size_t WS_BIG = al256(WS_VXT + (size_t)BATCH * MEML * 512 * 2);
constexpr size_t B_H = 0;
constexpr size_t B_Z = 0;
constexpr size_t B_P = al256(B_Z + (size_t)TG * ZW * 2);
constexpr size_t B_QB = al256(B_P + (size_t)TG * 2048 * 2);
constexpr size_t B_KB = al256(B_QB + (size_t)TG * 768 * 2);
constexpr size_t B_MG = B_QB;
constexpr size_t B_VT = al256(B_KB + (size_t)TG * 768 * 2);
constexpr size_t B_VST = al256(B_VT + (size_t)TG * 512 * 2);
constexpr size_t B_VWT = al256(B_VST + (size_t)TG * 128 * 2);
constexpr size_t B_VLNT = al256(B_VWT + (size_t)TG * 128 * 2);
constexpr size_t B_UV = al256(B_VLNT + (size_t)TG * 512 * 2);
constexpr size_t B_END = al256(B_UV + (size_t)4 * (TG / 16) * 128 * 4);
constexpr size_t B_XQ = 0;
constexpr size_t B_XO = al256((size_t)T * 512 * 2);
constexpr size_t WS_TOTAL = WS_BIG + cmax(B_END, (size_t)T * FF * 2);
static_assert(WS_TOTAL <= (size_t)512 * 1024 * 1024, "workspace too large");

struct Params {
  const float* in[40];
  float* out;
  char* ws;
};

DI char* launder(char* x) {
  unsigned lo = (unsigned)(uintptr_t)x, hi = (unsigned)((uintptr_t)x >> 32);
  unsigned vlo, vhi;
  asm volatile("v_mov_b32 %0, %2\n\tv_mov_b32 %1, %3" : "=v"(vlo), "=v"(vhi) : "s"(lo), "s"(hi));
  lo = __builtin_amdgcn_readfirstlane(vlo);
  hi = __builtin_amdgcn_readfirstlane(vhi);
  return (char*)(__attribute__((address_space(1))) char*)(((uintptr_t)hi << 32) | (uintptr_t)lo);
}
#define PWS(p) launder((p).ws)
DI u16* WTS(const Params& p, int l) { return (u16*)(PWS(p) + WS_WTS) + (size_t)l * LAYER_W; }
DI float* F32L(const Params& p, int l) { return (float*)(PWS(p) + WS_F32) + (size_t)l * F32_PER_LAYER; }
DI float2* TAB64(const Params& p) { return (float2*)(PWS(p) + WS_TAB64); }
DI float2* TAB32(const Params& p) { return (float2*)(PWS(p) + WS_TAB32); }
DI u16* XB(const Params& p) { return (u16*)(PWS(p) + WS_XB); }
constexpr size_t B_R16_LAST = (size_t)192 * 1024 * 1024;
static_assert(B_R16_LAST >= (size_t)T * FF * 2 && B_R16_LAST + (size_t)T * D * 2 <= cmax(B_END, (size_t)T * FF * 2), "r16 placement");
DI u16* R16(const Params& p, bool last) { return last ? (u16*)(PWS(p) + WS_BIG + B_R16_LAST) : (u16*)launder((char*)p.out); }
DI u16* BUF(const Params& p, size_t off) { return (u16*)(PWS(p) + WS_BIG + off); }

typedef __bf16 hwbf16x2 __attribute__((ext_vector_type(2)));
typedef float f32x2v __attribute__((ext_vector_type(2)));
DI unsigned pack2(float a, float b) { f32x2v v = {a, b}; hwbf16x2 r = __builtin_convertvector(v, hwbf16x2); return __builtin_bit_cast(unsigned, r); }
DI u16 f2bf(float x) { return (u16)(pack2(x, 0.f) & 0xffffu); }
DI float bf2f(u16 v) { return __uint_as_float(((unsigned)v) << 16); }
DI int otid() { int t = threadIdx.x; asm volatile("" : "+v"(t)); return t; }
DI int crow(int i, int h) { return (i & 3) + 8 * (i >> 2) + 4 * h; }
DI float sigmoidf(float x) { return __builtin_amdgcn_rcpf(1.f + __expf(-x)); }
DI float wave_sum(float v) {
#pragma unroll
  for (int o = 32; o >= 1; o >>= 1) v += __shfl_xor(v, o);
  return v;
}

template <int NB, int NS>
DI void gemm_core(f32x16 (&acc)[NB][2][NS], const u16* __restrict__ A, long lda, long akcs,
                  const u16* __restrict__ B0, const u16* __restrict__ B1, long ldb, int K, char* smem) {
  constexpr int A_BYTES = 256 * 128, B_BYTES = 64 * NS * 128, STAGE = A_BYTES + NB * B_BYTES;
  const int tid = otid(), lane = tid & 63, wave = tid >> 6, wm = wave >> 1, wn = wave & 1;
  const int lr = lane & 31, lh = lane >> 5, c8 = tid & 7, r0 = tid >> 3;
  const int swz = (r0 >> 1) & 7;
  const int nk = K >> 6;
#pragma unroll
  for (int b = 0; b < NB; ++b)
#pragma unroll
    for (int ms = 0; ms < 2; ++ms)
#pragma unroll
      for (int ns = 0; ns < NS; ++ns)
#pragma unroll
        for (int i = 0; i < 16; ++i) acc[b][ms][ns][i] = 0.f;

  uint4 ra0, ra1, ra2, ra3, rb0, rb1, rb2, rb3;
  ra0 = ra1 = ra2 = ra3 = rb0 = rb1 = rb2 = rb3 = make_uint4(0, 0, 0, 0);
#define GEMM_GLOAD(kt_)                                                                        \
  {                                                                                            \
    const u16* ap_ = A + (long)r0 * lda + (long)(kt_) * akcs + c8 * 8;                         \
    ra0 = *(const uint4*)(ap_);                                                                \
    ra1 = *(const uint4*)(ap_ + 64 * lda);                                                     \
    ra2 = *(const uint4*)(ap_ + 128 * lda);                                                    \
    ra3 = *(const uint4*)(ap_ + 192 * lda);                                                    \
    const u16* bp_ = B0 + (long)r0 * ldb + (kt_) * 64 + c8 * 8;                                \
    rb0 = *(const uint4*)(bp_);                                                                \
    if constexpr (NS > 1) rb1 = *(const uint4*)(bp_ + 64 * ldb);                               \
    if constexpr (NB > 1) {                                                                    \
      const u16* bq_ = B1 + (long)r0 * ldb + (kt_) * 64 + c8 * 8;                              \
      rb2 = *(const uint4*)(bq_);                                                              \
      if constexpr (NS > 1) rb3 = *(const uint4*)(bq_ + 64 * ldb);                             \
    }                                                                                          \
  }
#define GEMM_SSTORE(s_)                                                                        \
  {                                                                                            \
    char* base_ = smem + (s_) * STAGE + r0 * 128 + ((c8 ^ swz) << 4);                          \
    *(uint4*)(base_) = ra0;                                                                    \
    *(uint4*)(base_ + 64 * 128) = ra1;                                                         \
    *(uint4*)(base_ + 128 * 128) = ra2;                                                        \
    *(uint4*)(base_ + 192 * 128) = ra3;                                                        \
    *(uint4*)(base_ + A_BYTES) = rb0;                                                          \
    if constexpr (NS > 1) *(uint4*)(base_ + A_BYTES + 64 * 128) = rb1;                         \
    if constexpr (NB > 1) {                                                                    \
      *(uint4*)(base_ + A_BYTES + B_BYTES) = rb2;                                              \
      if constexpr (NS > 1) *(uint4*)(base_ + A_BYTES + B_BYTES + 64 * 128) = rb3;             \
    }                                                                                          \
  }
  __syncthreads();
  GEMM_GLOAD(0)
  GEMM_SSTORE(0)
  if (nk > 1) GEMM_GLOAD(1)
  __syncthreads();
  for (int kt = 0; kt < nk; ++kt) {
    const int s = kt & 1;
    if (kt + 1 < nk) GEMM_SSTORE(s ^ 1)
    if (kt + 2 < nk) GEMM_GLOAD(kt + 2)
    __builtin_amdgcn_sched_barrier(0);
    const char* base = smem + s * STAGE;
#pragma unroll
    for (int kk = 0; kk < 4; ++kk) {
      bf16x8 af[2], bfr[NB][NS];
#pragma unroll
      for (int ms = 0; ms < 2; ++ms) {
        const int row = wm * 64 + ms * 32 + lr, ch = kk * 2 + lh;
        af[ms] = *(const bf16x8*)(base + row * 128 + ((ch ^ ((row >> 1) & 7)) << 4));
      }
#pragma unroll
      for (int b = 0; b < NB; ++b)
#pragma unroll
        for (int ns = 0; ns < NS; ++ns) {
          const int row = wn * (32 * NS) + ns * 32 + lr, ch = kk * 2 + lh;
          bfr[b][ns] = *(const bf16x8*)(base + A_BYTES + b * B_BYTES + row * 128 + ((ch ^ ((row >> 1) & 7)) << 4));
        }
#pragma unroll
      for (int b = 0; b < NB; ++b)
#pragma unroll
        for (int ms = 0; ms < 2; ++ms)
#pragma unroll
          for (int ns = 0; ns < NS; ++ns) acc[b][ms][ns] = MFMA(af[ms], bfr[b][ns], acc[b][ms][ns]);
    }
    __syncthreads();
  }
}

#define EPI_IDS                                                                       \
  const int tid = otid(), lane = tid & 63, wave = tid >> 6, wm = wave >> 1, wn = wave & 1; \
  const int lr = lane & 31, lh = lane >> 5;                                           \
  (void)tid; (void)wm; (void)wn; (void)lr; (void)lh;

struct Job { const float* src; u16* dst; int K, N, ld; const float* ks; };

DI Job get_job(const Params& p, int l, int j) {
  u16* w = WTS(p, l);
  Job o;
  o.ks = nullptr;
  const float* win = p.in[7] + (size_t)l * D * INW;
  switch (j) {
    case 0: o.src = p.in[2] + (size_t)l * D * FF; o.dst = w + W_F1W1; o.K = D; o.N = FF; o.ld = FF; break;
    case 1: o.src = p.in[3] + (size_t)l * D * FF; o.dst = w + W_F1W3; o.K = D; o.N = FF; o.ld = FF; break;
    case 2: o.src = p.in[4] + (size_t)l * D * FF; o.dst = w + W_F1W2; o.K = FF; o.N = D; o.ld = D; break;
    case 3: o.src = p.in[35] + (size_t)l * D * FF; o.dst = w + W_F2W1; o.K = D; o.N = FF; o.ld = FF; break;
    case 4: o.src = p.in[36] + (size_t)l * D * FF; o.dst = w + W_F2W3; o.K = D; o.N = FF; o.ld = FF; break;
    case 5: o.src = p.in[37] + (size_t)l * D * FF; o.dst = w + W_F2W2; o.K = FF; o.N = D; o.ld = D; break;
    case 6: o.src = win; o.dst = w + W_IN; o.K = D; o.N = 2944; o.ld = INW; break;
    case 7: o.src = win + 2976; o.dst = w + W_IN + (size_t)2944 * D; o.K = D; o.N = 1280; o.ld = INW; break;
    case 8: o.src = win + 2944; o.dst = w + W_IN + (size_t)ZC_KROPE * D; o.K = D; o.N = 32; o.ld = INW; break;
    case 9: o.src = win + 4256; o.dst = w + W_IN + (size_t)ZC_GATE * D; o.K = D; o.N = 24; o.ld = INW; break;
    case 10: o.src = win + 4280; o.dst = w + W_IN + (size_t)ZW * D; o.K = D; o.N = 4096; o.ld = INW; break;
    case 11: o.src = p.in[13] + (size_t)l * 512 * D; o.dst = w + W_OUT4; o.K = 512; o.N = D; o.ld = D; break;
    case 12: o.src = p.in[15] + (size_t)l * 512 * D; o.dst = w + W_OUT4 + (size_t)1 * 1024 * 512; o.K = 512; o.N = D; o.ld = D; break;
    case 13: o.src = p.in[20] + (size_t)l * 512 * D; o.dst = w + W_OUT4 + (size_t)2 * 1024 * 512; o.K = 512; o.N = D; o.ld = D; break;
    case 14: o.src = p.in[25] + (size_t)l * 512 * D; o.dst = w + W_OUT4 + (size_t)3 * 1024 * 512; o.K = 512; o.N = D; o.ld = D; break;
    case 15: o.src = p.in[18] + (size_t)l * 256 * 768; o.dst = w + W_UQ; o.K = 256; o.N = 768; o.ld = 768; o.ks = p.in[16] + l * 256; break;
    case 16: o.src = p.in[19] + (size_t)l * 128 * 1024; o.dst = w + W_UKV; o.K = 128; o.N = 1024; o.ld = 1024; o.ks = p.in[17] + l * 128; break;
    case 17: o.src = p.in[26] + (size_t)l * D * D; o.dst = w + W_O; o.K = D; o.N = D; o.ld = D; break;
    case 18: o.src = p.in[29] + (size_t)l * D * 512; o.dst = w + W_XQ; o.K = D; o.N = 512; o.ld = 512; break;
    case 19: o.src = p.in[30] + (size_t)l * D * 512; o.dst = w + W_XKV; o.K = D; o.N = 512; o.ld = 512; break;
    case 20: o.src = p.in[31] + (size_t)l * D * 512; o.dst = w + W_XKV + (size_t)512 * D; o.K = D; o.N = 512; o.ld = 512; break;
    case 21: o.src = p.in[32] + (size_t)l * 512 * D; o.dst = w + W_XO; o.K = 512; o.N = D; o.ld = D; break;
    case 22: o.src = p.in[23] + (size_t)l * 2048 * 64; o.dst = w + W_CK; o.K = 1024; o.N = 64; o.ld = 64; break;
    case 23: o.src = p.in[23] + (size_t)l * 2048 * 64 + 1024 * 64; o.dst = w + W_CK + (size_t)64 * 1024; o.K = 1024; o.N = 64; o.ld = 64; break;
    case 24: o.src = p.in[24] + (size_t)l * 2048 * 64; o.dst = w + W_CV; o.K = 1024; o.N = 64; o.ld = 64; break;
    default: o.src = p.in[24] + (size_t)l * 2048 * 64 + 1024 * 64; o.dst = w + W_CV + (size_t)64 * 1024; o.K = 1024; o.N = 64; o.ld = 64; break;
  }
  return o;
}
constexpr int NJOBS = 26;

DI void conv_tiles4(const Job& jb, int t0, int tstep, int ntiles, int nkt, char* smem) {
  const int tid = otid(), kk = tid >> 3, c = tid & 7;
  float v[4][8];
#pragma unroll
  for (int u = 0; u < 4; ++u) {
    const int t = t0 + u * tstep;
#pragma unroll
    for (int e = 0; e < 8; ++e) v[u][e] = 0.f;
    if (t < ntiles) {
      const int tk = t % nkt, tn = t / nkt;
      const int k = tk * 64 + kk, n0 = tn * 64 + c * 8;
      const float* s = jb.src + (size_t)k * jb.ld + n0;
      if (n0 + 8 <= jb.N) {
        float4 a, b;
        a.x = __builtin_nontemporal_load(s); a.y = __builtin_nontemporal_load(s + 1); a.z = __builtin_nontemporal_load(s + 2); a.w = __builtin_nontemporal_load(s + 3);
        b.x = __builtin_nontemporal_load(s + 4); b.y = __builtin_nontemporal_load(s + 5); b.z = __builtin_nontemporal_load(s + 6); b.w = __builtin_nontemporal_load(s + 7);
        v[u][0] = a.x; v[u][1] = a.y; v[u][2] = a.z; v[u][3] = a.w; v[u][4] = b.x; v[u][5] = b.y; v[u][6] = b.z; v[u][7] = b.w;
      } else {
#pragma unroll
        for (int e = 0; e < 8; ++e) v[u][e] = (n0 + e < jb.N) ? s[e] : 0.f;
      }
    }
  }
#pragma unroll
  for (int u = 0; u < 4; ++u) {
    const int t = t0 + u * tstep;
    if (t < ntiles) {
      u16* Ts = (u16*)smem + u * (64 * 72);
      const float sc = jb.ks ? jb.ks[(t % nkt) * 64 + kk] : 1.f;
#pragma unroll
      for (int e = 0; e < 8; ++e) Ts[(c * 8 + e) * 72 + kk] = f2bf(v[u][e] * sc);
    }
  }
  __syncthreads();
  const int n = tid >> 3, ch = tid & 7;
#pragma unroll
  for (int u = 0; u < 4; ++u) {
    const int t = t0 + u * tstep;
    if (t < ntiles) {
      const int tk = t % nkt, tn = t / nkt;
      if (tn * 64 + n < jb.N) {
        const u16* Ts = (const u16*)smem + u * (64 * 72);
        const uint4 val = *(const uint4*)(Ts + n * 72 + ch * 8);
        *(uint4*)(jb.dst + (size_t)(tn * 64 + n) * jb.K + tk * 64 + ch * 8) = val;
      }
    }
  }
  __syncthreads();
}

DI void phase0(const Params& p, char* smem) {
  const int tid = otid();
  const size_t gtid = (size_t)blockIdx.x * NTHREADS + tid, gsz = (size_t)gridDim.x * NTHREADS;
  for (int l = 0; l < DEPTH; ++l)
    for (int j = 0; j < NJOBS; ++j) {
      Job jb = get_job(p, l, j);
      const int nkt = jb.K / 64, nnt = (jb.N + 63) / 64;
      for (int t = blockIdx.x; t < nkt * nnt; t += 4 * gridDim.x) conv_tiles4(jb, t, gridDim.x, nkt * nnt, nkt, smem);
    }
  for (int l = 0; l < DEPTH; ++l) {
    u16* w = WTS(p, l);
    float* f = F32L(p, l);
    for (size_t i = gtid; i < (size_t)72 * D; i += gsz) w[W_IN + (size_t)4280 * D + i] = 0;
    const float* gws = p.in[11] + (size_t)l * 4 * 128 * 128;
    for (size_t i = gtid; i < (size_t)4 * 128 * 128; i += gsz) {
      const int s = (int)(i & 127), t = (int)((i >> 7) & 127);
      w[W_GWS + i] = (s <= t) ? f2bf(gws[i]) : (u16)0;
    }
    const float* bin = p.in[8] + (size_t)l * INW;
    for (size_t i = gtid; i < (size_t)(ZW + 4096); i += gsz) {
      const int c = (int)i;
      float v;
      if (c < 2944) v = bin[c];
      else if (c < 4224) v = bin[c - 2944 + 2976];
      else if (c < 4256) v = bin[c - 4224 + 2944];
      else if (c < 4280) v = bin[c];
      else if (c < ZW) v = 0.f;
      else v = bin[c - ZW + 4280];
      f[F_BZ + c] = v;
    }
  }
  for (int it = blockIdx.x; it < DEPTH * 2; it += gridDim.x) {
    const int l = it >> 1, kv = it & 1;
    const float* pe = p.in[kv ? 22 : 21] + (size_t)l * 2048;
    const float* wc = p.in[kv ? 24 : 23] + (size_t)l * 2048 * 64;
    float* red = (float*)smem;
    const int e = tid & 63, part = tid >> 6;
    float a = 0.f;
    for (int i = part * 256; i < part * 256 + 256; ++i) a += pe[i] * wc[(size_t)i * 64 + e];
    __syncthreads();
    red[part * 64 + e] = a;
    __syncthreads();
    if (tid < 64) {
      float s = 0.f;
      for (int q = 0; q < 8; ++q) s += red[q * 64 + tid];
      F32L(p, l)[(kv ? F_CV : F_CK) + tid] = s;
    }
    __syncthreads();
  }
  {
    float2* t64 = TAB64(p);
    float2* t32 = TAB32(p);
    for (size_t i = gtid; i < (size_t)4096 * 48; i += gsz) {
      int pos, idx;
      float inv;
      float2* dst;
      if (i < (size_t)4096 * 32) { pos = (int)(i >> 5); idx = (int)(i & 31); inv = powf(10000.f, -(float)idx / 32.f); dst = t64 + i; }
      else { size_t k = i - (size_t)4096 * 32; pos = (int)(k >> 4); idx = (int)(k & 15); inv = powf(10000.f, -(float)idx / 16.f); dst = t32 + k; }
      const float ang = (float)pos * inv;
      const float kq = rintf(ang * 0.15915494309189535f);
      float r = fmaf(-kq, 6.2831854820251465f, ang);
      r = fmaf(-kq, -1.7484555e-7f, r);
      *dst = make_float2(__cosf(r), __sinf(r));
    }
  }
  {
    const float* x = p.in[0];
    u16* xb = XB(p);
    for (size_t i = gtid; i < (size_t)T * D / 8; i += gsz) {
      const float* s8 = x + i * 8;
      float4 a, b;
      a.x = __builtin_nontemporal_load(s8); a.y = __builtin_nontemporal_load(s8 + 1); a.z = __builtin_nontemporal_load(s8 + 2); a.w = __builtin_nontemporal_load(s8 + 3);
      b.x = __builtin_nontemporal_load(s8 + 4); b.y = __builtin_nontemporal_load(s8 + 5); b.z = __builtin_nontemporal_load(s8 + 6); b.w = __builtin_nontemporal_load(s8 + 7);
      uint4 o; o.x = pack2(a.x, a.y); o.y = pack2(a.z, a.w); o.z = pack2(b.x, b.y); o.w = pack2(b.z, b.w);
      *(uint4*)(xb + i * 8) = o;
    }
    const float* mem = p.in[1];
    u16* mb = (u16*)(PWS(p) + WS_MEMB);
    for (size_t i = gtid; i < (size_t)BATCH * MEML * D / 8; i += gsz) {
      float4 a = *(const float4*)(mem + i * 8), b = *(const float4*)(mem + i * 8 + 4);
      uint4 o; o.x = pack2(a.x, a.y); o.y = pack2(a.z, a.w); o.z = pack2(b.x, b.y); o.w = pack2(b.z, b.w);
      *(uint4*)(mb + i * 8) = o;
    }
  }
}

template <class Toff, class Setup, class Epi>
DI void gemm256_stream(int tiles_per_xcd, int K, long ais, long akcs, long bis, Toff toff, Setup setup, Epi epi, char* smem) {
  constexpr int A_BYTES = 256 * 128, STAGE = 2 * A_BYTES;
  const int tid = otid(), lane = tid & 63, wave = tid >> 6, wm = wave >> 2, wn = wave & 3;
  const int lr = lane & 31, lh = lane >> 5, c8 = tid & 7, r0 = tid >> 3, swz = (r0 >> 1) & 7;
  const int xcd = blockIdx.x & 7, jb = blockIdx.x >> 3, nj = gridDim.x >> 3;
  int q = jb;
  if (q >= tiles_per_xcd) return;
  f32x16 acc[4][2];
#pragma unroll
  for (int ms = 0; ms < 4; ++ms)
#pragma unroll
    for (int ns = 0; ns < 2; ++ns)
#pragma unroll
      for (int i = 0; i < 16; ++i) acc[ms][ns][i] = 0.f;
  const u16 *Ac, *Bc, *An = nullptr, *Bn = nullptr;
  int aoff, boff;
  toff(r0, c8, aoff, boff);
  setup(xcd, q, Ac, Bc);
  uint4 ra0, ra1, ra2, ra3, rb0, rb1, rb2, rb3;
#define G256_GLOAD(Ap_, Bp_, kt_)                                 \
  {                                                               \
    const u16* ap_ = (Ap_) + aoff + (long)(kt_) * akcs;           \
    const u16* bp_ = (Bp_) + boff + (kt_) * 64;                   \
    ra0 = *(const uint4*)(ap_);                                   \
    ra1 = *(const uint4*)(ap_ + ais);                             \
    ra2 = *(const uint4*)(ap_ + 2 * ais);                         \
    ra3 = *(const uint4*)(ap_ + 3 * ais);                         \
    rb0 = *(const uint4*)(bp_);                                   \
    rb1 = *(const uint4*)(bp_ + bis);                             \
    rb2 = *(const uint4*)(bp_ + 2 * bis);                         \
    rb3 = *(const uint4*)(bp_ + 3 * bis);                         \
  }
#define G256_SSTORE(s_)                                                       \
  {                                                                           \
    char* base_ = smem + (s_) * STAGE + r0 * 128 + ((c8 ^ swz) << 4);         \
    *(uint4*)(base_) = ra0;                                                   \
    *(uint4*)(base_ + 64 * 128) = ra1;                                        \
    *(uint4*)(base_ + 2 * 64 * 128) = ra2;                                    \
    *(uint4*)(base_ + 3 * 64 * 128) = ra3;                                    \
    *(uint4*)(base_ + A_BYTES) = rb0;                                         \
    *(uint4*)(base_ + A_BYTES + 64 * 128) = rb1;                              \
    *(uint4*)(base_ + A_BYTES + 2 * 64 * 128) = rb2;                          \
    *(uint4*)(base_ + A_BYTES + 3 * 64 * 128) = rb3;                          \
  }
#define G256_ST1(s_, kk_, RA, RB)                                                                        \
  {                                                                                                        \
    char* base_ = smem + (s_) * STAGE + r0 * 128 + ((c8 ^ swz) << 4) + (kk_) * 64 * 128;                   \
    *(uint4*)(base_) = RA;                                                                                 \
    *(uint4*)(base_ + A_BYTES) = RB;                                                                       \
  }
#define G256_LD1(Ap_, Bp_, kt_, kk_, RA, RB)                                                               \
  {                                                                                                        \
    RA = *(const uint4*)((Ap_) + aoff + (long)(kt_) * akcs + (kk_) * ais);                                 \
    RB = *(const uint4*)((Bp_) + boff + (kt_) * 64 + (kk_) * bis);                                         \
  }
#define G256_KSTEP(kk, RA, RB)                                                                             \
  {                                                                                                        \
    bf16x8 af[4], bfr[2];                                                                                  \
    const int ch = kk * 2 + lh;                                                                            \
    _Pragma("unroll") for (int ms = 0; ms < 4; ++ms) {                                                     \
      const int row = wm * 128 + ms * 32 + lr;                                                             \
      af[ms] = *(const bf16x8*)(base + row * 128 + ((ch ^ ((row >> 1) & 7)) << 4));                        \
    }                                                                                                      \
    _Pragma("unroll") for (int ns = 0; ns < 2; ++ns) {                                                     \
      const int row = wn * 64 + ns * 32 + lr;                                                              \
      bfr[ns] = *(const bf16x8*)(base + A_BYTES + row * 128 + ((ch ^ ((row >> 1) & 7)) << 4));            \
    }                                                                                                      \
    if (have1) G256_ST1(s ^ 1, kk, RA, RB)                                                                 \
    if (have2) G256_LD1(Ap2, Bp2, kt2, kk, RA, RB)                                                         \
    __builtin_amdgcn_sched_barrier(0);                                                                     \
    _Pragma("unroll") for (int ms = 0; ms < 4; ++ms)                                                       \
      _Pragma("unroll") for (int ns = 0; ns < 2; ++ns) acc[ms][ns] = MFMA(af[ms], bfr[ns], acc[ms][ns]);   \
  }
  const int nk = K >> 6;
  __syncthreads();
  G256_GLOAD(Ac, Bc, 0)
  G256_SSTORE(0)
  G256_GLOAD(Ac, Bc, 1)
  __syncthreads();
  while (true) {
    const int qn = q + nj;
    const bool has_next = qn < tiles_per_xcd;
    if (has_next) setup(xcd, qn, An, Bn);
    for (int kt = 0; kt < nk; ++kt) {
      const int s = kt & 1;
      const bool have1 = (kt + 1 < nk) || has_next;
      const bool in_cur = (kt + 2 < nk);
      const bool have2 = in_cur || (has_next && kt + 2 == nk);
      const u16* Ap2 = in_cur ? Ac : An;
      const u16* Bp2 = in_cur ? Bc : Bn;
      const int kt2 = in_cur ? kt + 2 : kt + 2 - nk;
      const char* base = smem + s * STAGE;
      G256_KSTEP(0, ra0, rb0)
      G256_KSTEP(1, ra1, rb1)
      G256_KSTEP(2, ra2, rb2)
      G256_KSTEP(3, ra3, rb3)
      __syncthreads();
    }
    epi(xcd, q, acc);
#pragma unroll
    for (int ms = 0; ms < 4; ++ms)
#pragma unroll
      for (int ns = 0; ns < 2; ++ns)
#pragma unroll
        for (int i = 0; i < 16; ++i) acc[ms][ns][i] = 0.f;
    if (!has_next) break;
    q = qn;
    Ac = An;
    Bc = Bn;
    G256_GLOAD(Ac, Bc, 1)
  }
}
#define G256_IDS
#define G256_SETUP_IDS
#define G256_EPI_IDS                                                                          \
  const int tid = otid(), lane = tid & 63, wave = tid >> 6, wm = wave >> 2, wn = wave & 3;    \
  const int lr = lane & 31, lh = lane >> 5;                                                   \
  (void)wm; (void)wn; (void)lr; (void)lh;

DI void phase_ffn_up(const Params& p, const u16* w1t, const u16* w3t, char* smem) {
  G256_IDS
  const u16* xb = XB(p);
  u16* hb = BUF(p, B_H);
  constexpr int MPX = (T / 256) / 8;
  auto setup = [&](int xcd, int q, const u16*& Ap, const u16*& Bp) __attribute__((always_inline)) {
    G256_SETUP_IDS
    const int mt = xcd * MPX + (q / (4 * (FF / 128))) * 4 + (q & 3), nt = (q >> 2) % (FF / 128);
    Ap = xb + (size_t)mt * 256 * D;
    Bp = w1t + (size_t)nt * 128 * D;
  };
  const int w3off = (int)(w3t - w1t);
  auto toff = [&](int r0, int c8, int& aoff, int& boff) __attribute__((always_inline)) {
    aoff = r0 * D + c8 * 8;
    boff = ((r0 < 32) ? 0 : w3off) + (r0 & 31) * D + c8 * 8;
  };
  auto epi = [&](int xcd, int q, f32x16 (&acc)[4][2]) __attribute__((always_inline)) {
    G256_EPI_IDS
    const int mt = xcd * MPX + (q / (4 * (FF / 128))) * 4 + (q & 3), nt = (q >> 2) % (FF / 128);
#pragma unroll
    for (int ms = 0; ms < 4; ++ms)
#pragma unroll
      for (int i = 0; i < 16; ++i) {
        const size_t row = (size_t)mt * 256 + wm * 128 + ms * 32 + crow(i, lh);
        const int col = nt * 128 + wn * 32 + lr;
        const float a = acc[ms][0][i], b = acc[ms][1][i];
        __builtin_nontemporal_store(f2bf(a * sigmoidf(a) * b), &hb[row * FF + col]);
      }
  };
  gemm256_stream(MPX * (FF / 128), D, (long)64 * D, 64, (long)32 * D, toff, setup, epi, smem);
}

DI void phase_gemm_resid(const Params& p, const u16* A, int lda, int K, const u16* Bt, bool last_sub, float scl,
                         int row0, int nrows, char* smem) {
  G256_IDS
  u16* r16 = R16(p, last_sub);
  const u16* xres = XB(p);
  const int mpx = (nrows / 256) / 8;
  auto setup = [&](int xcd, int q, const u16*& Ap, const u16*& Bp) __attribute__((always_inline)) {
    G256_SETUP_IDS
    const int mt = xcd * mpx + (q >> 5) * 8 + (q & 7), nt = (q >> 3) & 3;
    Ap = A + (size_t)mt * 256 * lda;
    Bp = Bt + (size_t)nt * 256 * K;
  };
  auto toff = [&](int r0, int c8, int& aoff, int& boff) __attribute__((always_inline)) {
    aoff = r0 * lda + c8 * 8;
    boff = r0 * K + c8 * 8;
  };
  auto epi = [&](int xcd, int q, f32x16 (&acc)[4][2]) __attribute__((always_inline)) {
    G256_EPI_IDS
    const int mt = xcd * mpx + (q >> 5) * 8 + (q & 7), nt = (q >> 3) & 3;
#pragma unroll
    for (int ms = 0; ms < 4; ++ms)
#pragma unroll
      for (int ns = 0; ns < 2; ++ns)
#pragma unroll
        for (int i = 0; i < 16; ++i) {
          const size_t row = (size_t)row0 + mt * 256 + wm * 128 + ms * 32 + crow(i, lh);
          const int col = nt * 256 + wn * 64 + ns * 32 + lr;
          __builtin_nontemporal_store(__builtin_bit_cast(u16, (_Float16)(ALPHA * bf2f(xres[row * D + col]) + scl * acc[ms][ns][i])), &r16[row * D + col]);
        }
  };
  gemm256_stream(mpx * 4, K, (long)64 * lda, 64, (long)64 * K, toff, setup, epi, smem);
}

DI void phase_ln(const Params& p, const float* g, const float* b, bool final_ln) {
  const int tid_ = otid(); const int lane = tid_ & 63, wave = tid_ >> 6;
  float* X = (float*)launder((char*)p.out);
  const u16* r16 = R16(p, final_ln);
  u16* xb = XB(p);
  float4 gg[4], bb[4];
#pragma unroll
  for (int i = 0; i < 4; ++i) { gg[i] = *(const float4*)(g + i * 256 + lane * 4); bb[i] = *(const float4*)(b + i * 256 + lane * 4); }
  constexpr int NR = 4;
  const int rstep = gridDim.x * 8;
  for (int row0 = blockIdx.x * 8 + wave; row0 < T; row0 += NR * rstep) {
    unsigned long long raw[NR][4];
#pragma unroll
    for (int r = 0; r < NR; ++r) {
      const int row = row0 + r * rstep;
#pragma unroll
      for (int i = 0; i < 4; ++i) {
        raw[r][i] = 0ull;
        if (row < T) raw[r][i] = __builtin_nontemporal_load((const unsigned long long*)(r16 + (size_t)row * D + i * 256 + lane * 4));
      }
    }
#pragma unroll
    for (int r = 0; r < NR; ++r) {
      const int row = row0 + r * rstep;
      if (row < T) {
        float* xr = X + (size_t)row * D;
        float4 v[4];
        float s = 0.f;
#pragma unroll
        for (int i = 0; i < 4; ++i) {
          const unsigned long long rw = raw[r][i];
          v[i].x = (float)__builtin_bit_cast(_Float16, (u16)(rw & 0xffffu));
          v[i].y = (float)__builtin_bit_cast(_Float16, (u16)((rw >> 16) & 0xffffu));
          v[i].z = (float)__builtin_bit_cast(_Float16, (u16)((rw >> 32) & 0xffffu));
          v[i].w = (float)__builtin_bit_cast(_Float16, (u16)(rw >> 48));
          s += v[i].x + v[i].y + v[i].z + v[i].w;
        }
        const float mean = wave_sum(s) * (1.f / D);
        float q = 0.f;
#pragma unroll
        for (int i = 0; i < 4; ++i) {
          v[i].x -= mean; v[i].y -= mean; v[i].z -= mean; v[i].w -= mean;
          q += v[i].x * v[i].x + v[i].y * v[i].y + v[i].z * v[i].z + v[i].w * v[i].w;
        }
        const float rstd = rsqrtf(wave_sum(q) * (1.f / D) + 1e-5f);
#pragma unroll
        for (int i = 0; i < 4; ++i) {
          float4 o;
          o.x = v[i].x * rstd * gg[i].x + bb[i].x; o.y = v[i].y * rstd * gg[i].y + bb[i].y;
          o.z = v[i].z * rstd * gg[i].z + bb[i].z; o.w = v[i].w * rstd * gg[i].w + bb[i].w;
          if (final_ln) *(float4*)(xr + i * 256 + lane * 4) = o;
          uint2 pk; pk.x = pack2(o.x, o.y); pk.y = pack2(o.z, o.w);
          *(uint2*)(xb + (size_t)row * D + i * 256 + lane * 4) = pk;
        }
      }
    }
  }
}

DI void phase_m1(const Params& p, int l, int grp, char* smem) {
  G256_IDS
  const u16* xb = XB(p) + (size_t)grp * TG * D;
  const u16* wt = WTS(p, l) + W_IN;
  const float* bz = F32L(p, l) + F_BZ;
  u16* z = BUF(p, B_Z);
  u16* vst = BUF(p, B_VST);
  u16* vwt = BUF(p, B_VWT);
  const float2* t64 = TAB64(p);
  const float2* t32 = TAB32(p);
  constexpr int MPX = (TG / 256) / 8, NT = ZW / 256;
  auto setup = [&](int xcd, int q, const u16*& Ap, const u16*& Bp) __attribute__((always_inline)) {
    G256_SETUP_IDS
    const int mt = xcd * MPX + q % MPX, nt = q / MPX;
    Ap = xb + (size_t)mt * 256 * D;
    Bp = wt + (size_t)nt * 256 * D;
  };
  auto toff = [&](int r0, int c8, int& aoff, int& boff) __attribute__((always_inline)) {
    aoff = r0 * D + c8 * 8;
    boff = r0 * D + c8 * 8;
  };
  auto epi = [&](int xcd, int q, f32x16 (&acc)[4][2]) __attribute__((always_inline)) {
    G256_EPI_IDS
    const int mt = xcd * MPX + q % MPX, nt = q / MPX;
    const int cb0 = nt * 256 + wn * 64;
    const int sec = cb0 >> 7, kvg = (cb0 >> 6) & 1;
    const float bias0 = bz[cb0 + lr], bias1 = bz[cb0 + 32 + lr];
    const bool rope64 = (sec >= 23 && sec < 27) || sec == 29 || sec == 31;
    const bool vtr = (sec == 30) || (sec == 32);
    if (vtr) {
      u16* vt = (sec == 30) ? vst : vwt;
#pragma unroll
      for (int ms = 0; ms < 4; ++ms)
#pragma unroll
        for (int ns = 0; ns < 2; ++ns)
#pragma unroll
          for (int gq = 0; gq < 4; ++gq) {
            const int row = mt * 256 + wm * 128 + ms * 32 + 8 * gq + 4 * lh;
            const int bl = row >> 12, s = row & 4095;
            const int dv = ns * 32 + lr;
            const float bs = ns ? bias1 : bias0;
            uint2 pk;
            pk.x = pack2(acc[ms][ns][4 * gq] + bs, acc[ms][ns][4 * gq + 1] + bs);
            pk.y = pack2(acc[ms][ns][4 * gq + 2] + bs, acc[ms][ns][4 * gq + 3] + bs);
            *(uint2*)(vt + ((size_t)(bl * 2 + kvg) * 64 + dv) * SEQ + s) = pk;
          }
    } else if (rope64) {
#pragma unroll
      for (int ms = 0; ms < 4; ++ms)
#pragma unroll
        for (int i = 0; i < 16; ++i) {
          const int row = mt * 256 + wm * 128 + ms * 32 + crow(i, lh);
          const int pos = row & 4095;
          const float2 cs = t64[pos * 32 + lr];
          const float x1 = acc[ms][0][i] + bias0, x2 = acc[ms][1][i] + bias1;
          z[(size_t)row * ZW + cb0 + lr] = f2bf(x1 * cs.x - x2 * cs.y);
          z[(size_t)row * ZW + cb0 + 32 + lr] = f2bf(x1 * cs.y + x2 * cs.x);
        }
    } else {
      const bool rope32 = (cb0 == ZC_KROPE);
#pragma unroll
      for (int ms = 0; ms < 4; ++ms)
#pragma unroll
        for (int ns = 0; ns < 2; ++ns)
#pragma unroll
          for (int i = 0; i < 16; ++i) {
            const int row = mt * 256 + wm * 128 + ms * 32 + crow(i, lh);
            float v = acc[ms][ns][i] + (ns ? bias1 : bias0);
            if (rope32 && ns == 0) {
              const float pr = __shfl_xor(v, 16);
              const float2 cs = t32[(row & 4095) * 16 + (lr & 15)];
              v = (lr < 16) ? (v * cs.x - pr * cs.y) : (pr * cs.y + v * cs.x);
            }
            z[(size_t)row * ZW + cb0 + ns * 32 + lr] = f2bf(v);
          }
    }
  };
  gemm256_stream(MPX * NT, D, (long)64 * D, 64, (long)64 * D, toff, setup, epi, smem);
}

DI void m2_gmlp_ln(const Params& p, int l, int chunk, char* smem) {
  const int tid = otid(), s = tid & 127, cgi = tid >> 7;
  const u16* z = BUF(p, B_Z);
  u16* vl = BUF(p, B_VLNT);
  const float* lg = p.in[9] + (size_t)l * 512 + cgi * 128;
  const float* lb = p.in[10] + (size_t)l * 512 + cgi * 128;
  float* red = (float*)smem;
  const u16* src = z + (size_t)(chunk * 128 + s) * ZW + ZC_V + cgi * 128;
  uint4 v[16];
  float sm = 0.f, sq = 0.f;
#pragma unroll
  for (int i = 0; i < 16; ++i) {
    v[i] = *(const uint4*)(src + i * 8);
    const unsigned w[4] = {v[i].x, v[i].y, v[i].z, v[i].w};
#pragma unroll
    for (int e = 0; e < 4; ++e) {
      const float a = __uint_as_float(w[e] << 16), b = __uint_as_float(w[e] & 0xffff0000u);
      sm += a + b; sq += a * a + b * b;
    }
  }
  __syncthreads();
  red[cgi * 128 + s] = sm;
  red[512 + cgi * 128 + s] = sq;
  __syncthreads();
  const float ts = red[s] + red[128 + s] + red[256 + s] + red[384 + s];
  const float tq = red[512 + s] + red[640 + s] + red[768 + s] + red[896 + s];
  const float mean = ts * (1.f / 512.f);
  const float var = fmaxf(tq * (1.f / 512.f) - mean * mean, 0.f);
  const float rstd = rsqrtf(var + 1e-5f);
  u16* dst = vl + ((size_t)cgi * TG + (size_t)chunk * 128) * 128 + s;
#pragma unroll
  for (int i = 0; i < 16; ++i) {
    const unsigned w[4] = {v[i].x, v[i].y, v[i].z, v[i].w};
#pragma unroll
    for (int e = 0; e < 4; ++e) {
      const float a = __uint_as_float(w[e] << 16), b = __uint_as_float(w[e] & 0xffff0000u);
      const int d0 = i * 8 + e * 2;
      dst[(size_t)d0 * 128] = f2bf((a - mean) * rstd * lg[d0] + lb[d0]);
      dst[(size_t)(d0 + 1) * 128] = f2bf((b - mean) * rstd * lg[d0 + 1] + lb[d0 + 1]);
    }
  }
  __syncthreads();
}

DI void m2_conv(const Params& p, int l, int item) {
  const int tid = otid();
  const u16* z = BUF(p, B_Z);
  u16* P = BUF(p, B_P);
  const float* cw = p.in[14] + (size_t)l * 3 * 512;
#pragma unroll 1
  for (int i = 0; i < 8; ++i) {
    const int vi = tid + 512 * i, tok = item * 64 + (vi >> 6), c0 = (vi & 63) * 8;
    const int s = tok & 4095;
    float y[8];
#pragma unroll
    for (int e = 0; e < 8; ++e) y[e] = 0.f;
#pragma unroll
    for (int k = 0; k < 3; ++k) {
      if (s - 2 + k >= 0) {
        const u16* zr = z + (size_t)(tok - 2 + k) * ZW;
        const uint4 c = *(const uint4*)(zr + ZC_CC + c0), h = *(const uint4*)(zr + ZC_CH + c0);
        const unsigned cwd[4] = {c.x, c.y, c.z, c.w}, hwd[4] = {h.x, h.y, h.z, h.w};
#pragma unroll
        for (int e = 0; e < 4; ++e) {
          const float c_lo = __uint_as_float(cwd[e] << 16), c_hi = __uint_as_float(cwd[e] & 0xffff0000u);
          const float h_lo = __uint_as_float(hwd[e] << 16), h_hi = __uint_as_float(hwd[e] & 0xffff0000u);
          y[2 * e] += c_lo * h_lo * cw[k * 512 + c0 + 2 * e];
          y[2 * e + 1] += c_hi * h_hi * cw[k * 512 + c0 + 2 * e + 1];
        }
      }
    }
    const uint4 b = *(const uint4*)(z + (size_t)tok * ZW + ZC_CB + c0);
    const unsigned bwd[4] = {b.x, b.y, b.z, b.w};
    uint4 o;
    unsigned ow[4];
#pragma unroll
    for (int e = 0; e < 4; ++e)
      ow[e] = pack2(__uint_as_float(bwd[e] << 16) * y[2 * e], __uint_as_float(bwd[e] & 0xffff0000u) * y[2 * e + 1]);
    o.x = ow[0]; o.y = ow[1]; o.z = ow[2]; o.w = ow[3];
    *(uint4*)(P + (size_t)tok * 2048 + 512 + c0) = o;
  }
}

constexpr int RS_OFF = 132 * 1024;
template <int W>
DI void row_rstd(const u16* z, int m0, int c0, char* smem) {
  const int tid = otid(), r = tid >> 1, hf = tid & 1;
  const u16* src = z + (size_t)(m0 + r) * ZW + c0 + hf * (W / 2);
  float sq = 0.f;
#pragma unroll
  for (int i = 0; i < W / 16; ++i) {
    const uint4 v = *(const uint4*)(src + i * 8);
    const unsigned w[4] = {v.x, v.y, v.z, v.w};
#pragma unroll
    for (int e = 0; e < 4; ++e) {
      const float a = __uint_as_float(w[e] << 16), b = __uint_as_float(w[e] & 0xffff0000u);
      sq += a * a + b * b;
    }
  }
  sq += __shfl_xor(sq, 1);
  __syncthreads();
  if (hf == 0) ((float*)(smem + RS_OFF))[r] = rsqrtf(sq * (1.f / W) + 1e-6f);
  __syncthreads();
}

DI void m2_mla_q(const Params& p, int l, int mt, int nt, char* smem) {
  EPI_IDS
  const u16* z = BUF(p, B_Z);
  u16* qb = BUF(p, B_QB);
  const float2* t32 = TAB32(p);
  row_rstd<256>(z, mt * 256, ZC_QLAT, smem);
  f32x16 acc[1][2][2];
  gemm_core<1, 2>(acc, z + (size_t)mt * 256 * ZW + ZC_QLAT, ZW, 64, WTS(p, l) + W_UQ + (size_t)nt * 128 * 256, nullptr, 256, 256, smem);
  const float* rs = (const float*)(smem + RS_OFF);
#pragma unroll
  for (int ms = 0; ms < 2; ++ms)
#pragma unroll
    for (int ns = 0; ns < 2; ++ns) {
      const int cbase = nt * 128 + wn * 64 + ns * 32;
      const bool rope = ((cbase >> 5) % 3) == 2;
#pragma unroll
      for (int i = 0; i < 16; ++i) {
        const int rl = wm * 64 + ms * 32 + crow(i, lh), row = mt * 256 + rl;
        float v = acc[0][ms][ns][i] * rs[rl];
        if (rope) {
          const float pr = __shfl_xor(v, 16);
          const float2 cs = t32[(row & 4095) * 16 + (lr & 15)];
          v = (lr < 16) ? (v * cs.x - pr * cs.y) : (pr * cs.y + v * cs.x);
        }
        qb[(size_t)row * 768 + cbase + lr] = f2bf(v);
      }
    }
}

DI void m2_mla_kv(const Params& p, int l, int mt, int nt, char* smem) {
  EPI_IDS
  const u16* z = BUF(p, B_Z);
  u16* kb = BUF(p, B_KB);
  u16* vt = BUF(p, B_VT);
  row_rstd<128>(z, mt * 256, ZC_KVLAT, smem);
  f32x16 acc[1][2][2];
  gemm_core<1, 2>(acc, z + (size_t)mt * 256 * ZW + ZC_KVLAT, ZW, 64, WTS(p, l) + W_UKV + (size_t)nt * 128 * 128, nullptr, 128, 128, smem);
  const float* rs = (const float*)(smem + RS_OFF);
  if (wn == 0) {
#pragma unroll
    for (int ms = 0; ms < 2; ++ms)
#pragma unroll
      for (int ns = 0; ns < 2; ++ns)
#pragma unroll
        for (int i = 0; i < 16; ++i) {
          const int rl = wm * 64 + ms * 32 + crow(i, lh), row = mt * 256 + rl;
          kb[(size_t)row * 768 + nt * 96 + ns * 32 + lr] = f2bf(acc[0][ms][ns][i] * rs[rl]);
        }
  } else {
#pragma unroll
    for (int ms = 0; ms < 2; ++ms)
#pragma unroll
      for (int ns = 0; ns < 2; ++ns)
#pragma unroll
        for (int gq = 0; gq < 4; ++gq) {
          const int rl = wm * 64 + ms * 32 + 8 * gq + 4 * lh, row = mt * 256 + rl;
          const int bl = row >> 12, s = row & 4095, dv = ns * 32 + lr;
          uint2 pk;
          pk.x = pack2(acc[0][ms][ns][4 * gq] * rs[rl], acc[0][ms][ns][4 * gq + 1] * rs[rl + 1]);
          pk.y = pack2(acc[0][ms][ns][4 * gq + 2] * rs[rl + 2], acc[0][ms][ns][4 * gq + 3] * rs[rl + 3]);
          *(uint2*)(vt + ((size_t)(bl * 8 + nt) * 64 + dv) * SEQ + s) = pk;
        }
  }
#pragma unroll
  for (int i = 0; i < 2; ++i) {
    const int ci = tid + 512 * i, r = ci >> 2, c = ci & 3;
    const size_t row = (size_t)mt * 256 + r;
    *(uint4*)(kb + row * 768 + nt * 96 + 64 + c * 8) = *(const uint4*)(z + row * ZW + ZC_KROPE + c * 8);
  }
}

DI void m2_uv(const Params& p, int l, int it, char* smem) {
  EPI_IDS
  const int kv = it >> 3, g = (it >> 2) & 1, mt = it & 3;
  const u16* z = BUF(p, B_Z);
  float* uv = (float*)(PWS(p) + WS_BIG + B_UV) + ((size_t)(kv * 2 + g) * (TG / 16)) * 128;
  f32x16 acc[1][2][2];
  gemm_core<1, 2>(acc, z + (size_t)mt * 256 * 16 * ZW + (kv ? ZC_NVC : ZC_NKC) + g * 64, (long)16 * ZW, ZW,
                  WTS(p, l) + (kv ? W_CV : W_CK), nullptr, 1024, 1024, smem);
#pragma unroll
  for (int ms = 0; ms < 2; ++ms)
#pragma unroll
    for (int ns = 0; ns < 2; ++ns)
#pragma unroll
      for (int i = 0; i < 16; ++i) {
        const int seg = mt * 256 + wm * 64 + ms * 32 + crow(i, lh), col = wn * 64 + ns * 32 + lr;
        uv[(size_t)seg * 128 + col] = acc[0][ms][ns][i];
      }
}

DI void m2_xkv(const Params& p, int l, int it, char* smem) {
  EPI_IDS
  const int mt = it >> 3, nt = it & 7;
  const u16* mb = (const u16*)(PWS(p) + WS_MEMB);
  u16* kx = (u16*)(PWS(p) + WS_KX);
  u16* vxt = (u16*)(PWS(p) + WS_VXT);
  f32x16 acc[1][2][2];
  gemm_core<1, 2>(acc, mb + (size_t)mt * 256 * D, D, 64, WTS(p, l) + W_XKV + (size_t)nt * 128 * D, nullptr, D, D, smem);
  if (nt < 4) {
#pragma unroll
    for (int ms = 0; ms < 2; ++ms)
#pragma unroll
      for (int ns = 0; ns < 2; ++ns)
#pragma unroll
        for (int i = 0; i < 16; ++i) {
          const size_t row = (size_t)mt * 256 + wm * 64 + ms * 32 + crow(i, lh);
          kx[row * 512 + nt * 128 + wn * 64 + ns * 32 + lr] = f2bf(acc[0][ms][ns][i]);
        }
  } else {
    const int hx = nt - 4;
#pragma unroll
    for (int ms = 0; ms < 2; ++ms)
#pragma unroll
      for (int ns = 0; ns < 2; ++ns)
#pragma unroll
        for (int gq = 0; gq < 4; ++gq) {
          const int mrow = wm * 64 + ms * 32 + 8 * gq + 4 * lh;
          const int dv = wn * 64 + ns * 32 + lr;
          uint2 pk;
          pk.x = pack2(acc[0][ms][ns][4 * gq], acc[0][ms][ns][4 * gq + 1]);
          pk.y = pack2(acc[0][ms][ns][4 * gq + 2], acc[0][ms][ns][4 * gq + 3]);
          *(uint2*)(vxt + ((size_t)(mt * 4 + hx) * 128 + dv) * MEML + mrow) = pk;
        }
  }
}

constexpr int M2_NQ = (TG / 256) * 6, M2_NKV = (TG / 256) * 8, M2_NUV = 16, M2_NLN = TG / 128, M2_NCONV = TG / 64;
DI void phase_m2(const Params& p, int l, int grp, char* smem) {
  constexpr int TOT = M2_NKV + M2_NQ + M2_NUV + M2_NLN + M2_NCONV;
  const int nx = (grp == 0) ? 64 : 0;
  for (int t = blockIdx.x; t < TOT + nx; t += gridDim.x) {
    int it = t;
    if (it >= TOT) { m2_xkv(p, l, it - TOT, smem); continue; }
    if (it < M2_NUV) { m2_uv(p, l, it, smem); continue; }
    it -= M2_NUV;
    if (it < M2_NQ) { m2_mla_q(p, l, it / 6, it % 6, smem); continue; }
    it -= M2_NQ;
    if (it < M2_NKV) { m2_mla_kv(p, l, it >> 3, it & 7, smem); continue; }
    it -= M2_NKV;
    if (it < M2_NLN) { m2_gmlp_ln(p, l, it, smem); continue; }
    it -= M2_NLN;
    m2_conv(p, l, it);
  }
}

template <int DK, int DV>
struct FA {
  static constexpr int KSTR = DK * 2 + 16, VSTR = 144, KBYTES = 64 * KSTR, VBYTES = DV * VSTR, STAGE = KBYTES + VBYTES;
  static constexpr int KCH = 64 * DK / 8, VCH = DV * 8, KN = (KCH + 511) / 512, VN = (VCH + 511) / 512;
};
template <int DK, int DV, int MODE>
DI bool fa_active(int kb, int wave_qmax, unsigned long long sel) {
  bool active = true;
  if (MODE != 0) active = (kb * 64 <= wave_qmax);
  if (MODE == 2) {
    const bool selbit = (sel >> kb) & 1ull;
    if (__ballot(selbit) == 0ull) active = false;
  }
  return active;
}
template <int DK, int DV, int MODE>
DI void fa_qk(f32x16 (&S)[2], const bf16x8 (&q)[DK / 16], const char* base, int lr, int lh) {
  using C = FA<DK, DV>;
#pragma unroll
  for (int ks = 0; ks < 2; ++ks) {
#pragma unroll
    for (int kk = 0; kk < DK / 16; ++kk) {
      const bf16x8 kf = *(const bf16x8*)(base + (ks * 32 + lr) * C::KSTR + (kk * 2 + lh) * 16);
      if (kk == 0) {
#pragma unroll
        for (int i = 0; i < 16; ++i) S[ks][i] = 0.f;
      }
      S[ks] = MFMA(kf, q[kk], S[ks]);
    }
  }
}
template <int DK, int DV, int MODE>
DI void fa_softmax_pv(f32x16 (&S)[2], float& m, float& l, f32x16 (&O)[DV / 32], float scale, const char* base, int kb,
                      int qpos, int wave_qmax, unsigned long long sel, int lr, int lh, int variant = 0) {
  using C = FA<DK, DV>;
  bool selbit = true;
  bool need_mask = false;
  if (MODE != 0) need_mask = (kb * 64 + 63 > wave_qmax - 31);
  if (MODE == 2) selbit = (sel >> kb) & 1ull;
  if (MODE == 3) need_mask = need_mask || (kb * 64 <= wave_qmax - 512);
  const float c2 = scale * 1.4426950408889634f;
  if (need_mask) {
#pragma unroll
    for (int ks = 0; ks < 2; ++ks)
#pragma unroll
      for (int i = 0; i < 16; ++i) {
        const int key = kb * 64 + ks * 32 + crow(i, lh);
        bool valid = key <= qpos;
        if (MODE == 2) valid = valid && selbit;
        if (MODE == 3) valid = valid && (qpos - key < 512);
        S[ks][i] = valid ? S[ks][i] : -1e30f;
      }
  }
  float mx = fmaxf(S[0][0], S[0][1]);
#pragma unroll
  for (int ks = 0; ks < 2; ++ks)
#pragma unroll
    for (int i = (ks ? 0 : 2); i < 16; i += 2) mx = fmaxf(fmaxf(mx, S[ks][i]), S[ks][i + 1]);
  mx = fmaxf(mx, __shfl_xor(mx, 32));
  if (MODE == 2) mx = selbit ? mx : -1e30f;
  const float mn = fmaxf(m, mx);
  if (__any((mn - m) * c2 > 8.f)) {
    const float alpha = __builtin_amdgcn_exp2f((m - mn) * c2);
    m = mn;
    l *= alpha;
#pragma unroll
    for (int d = 0; d < DV / 32; ++d) O[d] = O[d] * alpha;
  }
  float mc = m * c2;
  if (MODE == 2) mc = selbit ? mc : 1e30f;
  const f32x2v c2v = {c2, c2}, mcv = {-mc, -mc};
  f32x2v rs2 = {0.f, 0.f};
#pragma unroll
  for (int ks = 0; ks < 2; ++ks)
#pragma unroll
    for (int st = 0; st < 2; ++st) {
      union { unsigned u[4]; bf16x8 v; } pf;
#pragma unroll
      for (int j = 0; j < 4; ++j) {
        const int i0 = 8 * st + 2 * j;
        f32x2v t = {S[ks][i0], S[ks][i0 + 1]};
        t = __builtin_elementwise_fma(t, c2v, mcv);
        f32x2v pv;
        if (variant == 1) { pv = t; } else {
        pv.x = __builtin_amdgcn_exp2f(t.x);
        pv.y = __builtin_amdgcn_exp2f(t.y);
        }
        if (MODE != 0) {
          if (need_mask) {
            pv.x = (S[ks][i0] > -1e29f) ? pv.x : 0.f;
            pv.y = (S[ks][i0 + 1] > -1e29f) ? pv.y : 0.f;
          }
        }
        rs2 += pv;
        pf.u[j] = __builtin_bit_cast(unsigned, __builtin_convertvector(pv, hwbf16x2));
      }
#pragma unroll
      for (int d = 0; d < DV / 32; ++d) {
        const char* vp = base + C::KBYTES + (d * 32 + lr) * C::VSTR + (ks * 32 + 16 * st + 4 * lh) * 2;
        const s16x4 lo = *(const s16x4*)vp, hi = *(const s16x4*)(vp + 16);
        const bf16x8 vf = __builtin_shufflevector(lo, hi, 0, 1, 2, 3, 4, 5, 6, 7);
        O[d] = MFMA(vf, pf.v, O[d]);
      }
    }
  float rs = rs2.x + rs2.y;
  rs += __shfl_xor(rs, 32);
  l += rs;
}

template <int N> DI void wait_vmcnt() { asm volatile("s_waitcnt vmcnt(%0)" ::"n"(N) : "memory"); }
DI void raw_barrier() {
  asm volatile("s_waitcnt lgkmcnt(0)" ::: "memory");
  __builtin_amdgcn_s_barrier();
  asm volatile("" ::: "memory");
}
template <int DK, int DV, int MODE>
DI void flash_loop(float& m, float& l, f32x16 (&O)[DV / 32], const bf16x8 (&q)[DK / 16], float scale,
                   const u16* __restrict__ Kp, long ldk, const u16* __restrict__ VTp, long ldvt, int kb0, int kb1,
                   int qpos, int wave_qmax, unsigned long long sel, char* smem, int variant = 0) {
  using C = FA<DK, DV>;
  constexpr int KC = C::KSTR / 16, NCH = C::STAGE / 16, NW = NCH / 64, NI = (NW + 7) / 8;
  constexpr int NST = (C::STAGE * 4 <= 100 * 1024) ? 4 : 3;
  static_assert(NCH % 64 == 0 && (64 * KC) % 64 == 0 && NI <= 5, "piece layout");
  const int tid = otid(), lane = tid & 63, wave = tid >> 6, lr = lane & 31, lh = lane >> 5;
  const int ntile = kb1 - kb0;
  __syncthreads();
  if (ntile <= 0) return;
  const u16* src[5];
  long stp[5];
  int ldo[5];
#pragma unroll
  for (int i = 0; i < 5; ++i) {
    src[i] = Kp; stp[i] = 0; ldo[i] = 0;
    if (i < NI) {
      int w_ = i * 8 + wave;
      if (w_ > NW - 1) w_ = NW - 1;
      const int L = w_ * 64 + lane;
      if (w_ < KC) {
        const int row = L / KC;
        int c = L % KC;
        if (c > DK / 8 - 1) c = DK / 8 - 1;
        src[i] = Kp + (long)(kb0 * 64 + row) * ldk + c * 8;
        stp[i] = 64 * ldk;
      } else {
        const int L2 = L - 64 * KC, row = L2 / 9;
        int c = L2 % 9;
        if (c > 7) c = 7;
        src[i] = VTp + (long)row * ldvt + kb0 * 64 + c * 8;
        stp[i] = 64;
      }
      ldo[i] = w_ * 1024;
    }
  }
#define FA_ISSUE(t_, stage_)                                                                              \
  {                                                                                                       \
    _Pragma("unroll") for (int i = 0; i < NI; ++i)                                                        \
        __builtin_amdgcn_global_load_lds((const unsigned*)(src[i] + (long)(t_) * stp[i]),                 \
                                         (unsigned*)(smem + (stage_) * C::STAGE + ldo[i]), 16, 0, 0);      \
  }
  asm volatile("s_waitcnt vmcnt(0)" ::: "memory");
#pragma unroll
  for (int t = 0; t < NST - 1; ++t)
    if (t < ntile) FA_ISSUE(t, t)
  int stage = 0;
  for (int t = 0; t < ntile; ++t) {
    int ahead = ((ntile < t + NST - 1) ? ntile : t + NST - 1) - (t + 1);
    if (NST == 4 && ahead >= 2) wait_vmcnt<2 * NI>();
    else if (ahead >= 1) wait_vmcnt<NI>();
    else wait_vmcnt<0>();
    raw_barrier();
    if (t + NST - 1 < ntile) {
      const int sn = (stage == 0) ? NST - 1 : stage - 1;
      FA_ISSUE(t + NST - 1, sn)
    }
    const int kb = kb0 + t;
    if (fa_active<DK, DV, MODE>(kb, wave_qmax, sel)) {
      f32x16 S[2];
      const char* base = smem + stage * C::STAGE;
      fa_qk<DK, DV, MODE>(S, q, base, lr, lh);
      fa_softmax_pv<DK, DV, MODE>(S, m, l, O, scale, base, kb, qpos, wave_qmax, sel, lr, lh, variant);
    }
    stage = (stage == NST - 1) ? 0 : stage + 1;
  }
  raw_barrier();
}

DI void mla_item(const Params& p, int bl, int h, int qt, char* smem, int variant = 0) {
  const int tid = otid(), lane = tid & 63, wave = tid >> 6, lr = lane & 31, lh = lane >> 5;
  const u16* qb = BUF(p, B_QB);
  const u16* kb = BUF(p, B_KB);
  const u16* vt = BUF(p, B_VT);
  u16* P = BUF(p, B_P);
  const int wq0 = qt * 256 + wave * 32, qpos = wq0 + lr;
  const size_t tok = (size_t)bl * SEQ + qpos;
  bf16x8 q[6];
#pragma unroll
  for (int kk = 0; kk < 6; ++kk) q[kk] = *(const bf16x8*)(qb + tok * 768 + h * 96 + kk * 16 + lh * 8);
  float m = -1e30f, l = 0.f;
  f32x16 O[2];
#pragma unroll
  for (int d = 0; d < 2; ++d)
#pragma unroll
    for (int i = 0; i < 16; ++i) O[d][i] = 0.f;
  flash_loop<96, 64, 1>(m, l, O, q, 0.10206207261596577f, kb + (size_t)bl * SEQ * 768 + h * 96, 768,
                        vt + ((size_t)(bl * 8 + h) * 64) * SEQ, SEQ, 0, 4 * (qt + 1), qpos, wq0 + 31, 0ull, smem, variant);
  if (variant != 0 && l > -1e38f) return;
  const float inv = 1.f / l;
#pragma unroll
  for (int d = 0; d < 2; ++d)
#pragma unroll
    for (int gq = 0; gq < 4; ++gq) {
      uint2 pk;
      pk.x = pack2(O[d][4 * gq] * inv, O[d][4 * gq + 1] * inv);
      pk.y = pack2(O[d][4 * gq + 2] * inv, O[d][4 * gq + 3] * inv);
      *(uint2*)(P + tok * 2048 + 1024 + h * 64 + d * 32 + 8 * gq + 4 * lh) = pk;
    }
}

constexpr int NSA_KC_OFF = 0, NSA_VC_OFF = 36864, NSA_IMP_OFF = 36864 + 33792, NSA_SEL_OFF = 137216;
constexpr int VCSTR = 528;
DI void nsa_item(const Params& p, int l, int bl, int g, int jq, char* smem) {
  const int tid = otid(), lane = tid & 63, wave = tid >> 6, lr = lane & 31, lh = lane >> 5;
  const int hh = wave & 3, qs = wave >> 2;
  const int q0 = jq * 64, qloc = qs * 32 + lr, qpos = q0 + qloc;
  const int head = g * 4 + hh;
  const size_t tokbase = (size_t)bl * SEQ;
  const u16* z = BUF(p, B_Z);
  u16* P = BUF(p, B_P);
  const float scale = 0.125f;
  char* sKc = smem + NSA_KC_OFF;
  char* sVc = smem + NSA_VC_OFF;
  float* sImp = (float*)(smem + NSA_IMP_OFF);
  unsigned char* sSel = (unsigned char*)(smem + NSA_SEL_OFF);

  bf16x8 q[4];
#pragma unroll
  for (int kk = 0; kk < 4; ++kk) q[kk] = *(const bf16x8*)(z + (tokbase + qpos) * ZW + ZC_NQ + head * 64 + kk * 16 + lh * 8);

  const int ncnt = min(255, (q0 + 32) / 16 + 1);
  const int ntile = (ncnt + 63) >> 6;
  __syncthreads();
  {
    const float* uvb = (const float*)(PWS(p) + WS_BIG + B_UV);
    const float* UVk = uvb + ((size_t)(0 * 2 + g) * (TG / 16) + (size_t)bl * 256) * 128;
    const float* UVv = uvb + ((size_t)(1 * 2 + g) * (TG / 16) + (size_t)bl * 256) * 128;
    const float* ck = F32L(p, l) + F_CK;
    const float* cv = F32L(p, l) + F_CV;
    const float2* t64 = TAB64(p);
    for (int idx = tid; idx < ntile * 64 * 32; idx += NTHREADS) {
      const int n = idx >> 5, e = idx & 31;
      float r1 = 0.f, r2 = 0.f, v1 = 0.f, v2 = 0.f;
      if (n < 255) {
        const float k1 = UVk[n * 128 + e] + UVk[(n + 1) * 128 + 64 + e] + ck[e];
        const float k2 = UVk[n * 128 + e + 32] + UVk[(n + 1) * 128 + 96 + e] + ck[e + 32];
        v1 = UVv[n * 128 + e] + UVv[(n + 1) * 128 + 64 + e] + cv[e];
        v2 = UVv[n * 128 + e + 32] + UVv[(n + 1) * 128 + 96 + e] + cv[e + 32];
        const float2 cs = t64[(16 * n + 31) * 32 + e];
        r1 = k1 * cs.x - k2 * cs.y;
        r2 = k1 * cs.y + k2 * cs.x;
      }
      *(u16*)(sKc + n * 144 + e * 2) = f2bf(r1);
      *(u16*)(sKc + n * 144 + (e + 32) * 2) = f2bf(r2);
      *(u16*)(sVc + e * VCSTR + n * 2) = f2bf(v1);
      *(u16*)(sVc + (e + 32) * VCSTR + n * 2) = f2bf(v2);
    }
    for (int idx = tid; idx < 4 * 64 * 65; idx += NTHREADS) sImp[idx] = 0.f;
  }
  __syncthreads();

  float mc = -1e30f, lc = 0.f;
#pragma unroll 1
  for (int t = 0; t < ntile; ++t) {
    f32x16 S[2];
    float mx = -1e30f;
#pragma unroll
    for (int ks = 0; ks < 2; ++ks) {
#pragma unroll
      for (int i = 0; i < 16; ++i) S[ks][i] = 0.f;
#pragma unroll
      for (int kk = 0; kk < 4; ++kk) {
        const bf16x8 kf = *(const bf16x8*)(sKc + (t * 64 + ks * 32 + lr) * 144 + (kk * 2 + lh) * 16);
        S[ks] = MFMA(kf, q[kk], S[ks]);
      }
#pragma unroll
      for (int i = 0; i < 16; ++i) {
        const int n = t * 64 + ks * 32 + crow(i, lh);
        const float tv = (16 * n + 31 <= qpos) ? S[ks][i] * scale : -1e30f;
        S[ks][i] = tv;
        mx = fmaxf(mx, tv);
      }
    }
    mx = fmaxf(mx, __shfl_xor(mx, 32));
    const float mn = fmaxf(mc, mx);
    float rs = 0.f;
#pragma unroll
    for (int ks = 0; ks < 2; ++ks)
#pragma unroll
      for (int i = 0; i < 16; ++i) rs += (S[ks][i] > -1e29f) ? __expf(S[ks][i] - mn) : 0.f;
    rs += __shfl_xor(rs, 32);
    lc = lc * __expf(mc - mn) + rs;
    mc = mn;
  }
  const float invl = (lc > 0.f) ? 1.f / lc : 0.f;

  f32x16 Oo[2];
#pragma unroll
  for (int d = 0; d < 2; ++d)
#pragma unroll
    for (int i = 0; i < 16; ++i) Oo[d][i] = 0.f;
#pragma unroll
  for (int t = 0; t < 4; ++t) {
    if (t < ntile) {
#pragma unroll
      for (int ks = 0; ks < 2; ++ks) {
        f32x16 S;
#pragma unroll
        for (int i = 0; i < 16; ++i) S[i] = 0.f;
#pragma unroll
        for (int kk = 0; kk < 4; ++kk) {
          const bf16x8 kf = *(const bf16x8*)(sKc + (t * 64 + ks * 32 + lr) * 144 + (kk * 2 + lh) * 16);
          S = MFMA(kf, q[kk], S);
        }
#pragma unroll
        for (int i = 0; i < 16; ++i) {
          const int n = t * 64 + ks * 32 + crow(i, lh);
          S[i] = (16 * n + 31 <= qpos) ? __expf(S[i] * scale - mc) * invl : 0.f;
        }
#pragma unroll
        for (int gq = 0; gq < 4; ++gq) {
          const int j = t * 16 + ks * 8 + 2 * gq + lh;
          atomicAdd(&sImp[(hh * 64 + qloc) * 65 + j], S[4 * gq] + S[4 * gq + 1] + S[4 * gq + 2] + 0.5f * S[4 * gq + 3]);
          if (j + 1 < 64) atomicAdd(&sImp[(hh * 64 + qloc) * 65 + j + 1], 0.5f * S[4 * gq + 3]);
        }
#pragma unroll
        for (int st = 0; st < 2; ++st) {
          union { unsigned u[4]; bf16x8 v; } pf;
#pragma unroll
          for (int j = 0; j < 4; ++j) pf.u[j] = pack2(S[8 * st + 2 * j], S[8 * st + 2 * j + 1]);
#pragma unroll
          for (int d = 0; d < 2; ++d) {
            const char* vp = sVc + (d * 32 + lr) * VCSTR + (t * 64 + ks * 32 + 16 * st + 4 * lh) * 2;
            const s16x4 lo = *(const s16x4*)vp, hi = *(const s16x4*)(vp + 16);
            const bf16x8 vf = __builtin_shufflevector(lo, hi, 0, 1, 2, 3, 4, 5, 6, 7);
            Oo[d] = MFMA(vf, pf.v, Oo[d]);
          }
        }
      }
    }
  }
  __syncthreads();

  {
    const int qq = tid >> 3, part = tid & 7;
    float v[8];
#pragma unroll
    for (int k = 0; k < 8; ++k) {
      const int j = part * 8 + k;
      float val = sImp[(0 * 64 + qq) * 65 + j] + sImp[(1 * 64 + qq) * 65 + j] + sImp[(2 * 64 + qq) * 65 + j] + sImp[(3 * 64 + qq) * 65 + j];
      const bool forced = (j == 0) || (j == jq) || (j == jq - 1);
      val = forced ? 1e9f : val;
      val = (j <= jq) ? val : -1.f;
      v[k] = val;
    }
    unsigned taken = 0, selb = 0;
#pragma unroll 1
    for (int r = 0; r < 8; ++r) {
      float best = -2.f;
      int bidx = 1000;
#pragma unroll
      for (int k = 0; k < 8; ++k)
        if (!((taken >> k) & 1u) && v[k] > best) { best = v[k]; bidx = part * 8 + k; }
#pragma unroll
      for (int off = 1; off < 8; off <<= 1) {
        const float ob = __shfl_xor(best, off);
        const int oi = __shfl_xor(bidx, off);
        if (ob > best || (ob == best && oi < bidx)) { best = ob; bidx = oi; }
      }
      if ((bidx >> 3) == part) {
        taken |= 1u << (bidx & 7);
        if (best >= 0.f) selb |= 1u << (bidx & 7);
      }
    }
    sSel[qq * 8 + part] = (unsigned char)selb;
  }
  __syncthreads();
  const unsigned long long sel = *(const unsigned long long*)(sSel + qloc * 8);

  const u16* gz = z + (tokbase + qpos) * ZW + ZC_GATE + head * 3;
  const float g0 = sigmoidf(bf2f(gz[0])), g1 = sigmoidf(bf2f(gz[1])), g2 = sigmoidf(bf2f(gz[2]));
#pragma unroll
  for (int d = 0; d < 2; ++d)
#pragma unroll
    for (int i = 0; i < 16; ++i) Oo[d][i] *= g0;

  {
    float m = -1e30f, ls = 0.f;
    f32x16 O[2];
#pragma unroll
    for (int d = 0; d < 2; ++d)
#pragma unroll
      for (int i = 0; i < 16; ++i) O[d][i] = 0.f;
    flash_loop<64, 64, 2>(m, ls, O, q, scale, z + tokbase * ZW + ZC_NKS + g * 64, ZW,
                          BUF(p, B_VST) + ((size_t)(bl * 2 + g) * 64) * SEQ, SEQ, 0, jq + 1, qpos, q0 + 63, sel, smem);
    const float f = (ls > 0.f) ? g1 / ls : 0.f;
#pragma unroll
    for (int d = 0; d < 2; ++d)
#pragma unroll
      for (int i = 0; i < 16; ++i) Oo[d][i] += f * O[d][i];
  }
  {
    float m = -1e30f, lw = 0.f;
    f32x16 O[2];
#pragma unroll
    for (int d = 0; d < 2; ++d)
#pragma unroll
      for (int i = 0; i < 16; ++i) O[d][i] = 0.f;
    flash_loop<64, 64, 3>(m, lw, O, q, scale, z + tokbase * ZW + ZC_NKW + g * 64, ZW,
                          BUF(p, B_VWT) + ((size_t)(bl * 2 + g) * 64) * SEQ, SEQ, max(0, jq - 8), jq + 1, qpos, q0 + 63, 0ull, smem);
    const float f = (lw > 0.f) ? g2 / lw : 0.f;
#pragma unroll
    for (int d = 0; d < 2; ++d)
#pragma unroll
      for (int i = 0; i < 16; ++i) Oo[d][i] += f * O[d][i];
  }
#pragma unroll
  for (int d = 0; d < 2; ++d)
#pragma unroll
    for (int gq = 0; gq < 4; ++gq) {
      uint2 pk;
      pk.x = pack2(Oo[d][4 * gq], Oo[d][4 * gq + 1]);
      pk.y = pack2(Oo[d][4 * gq + 2], Oo[d][4 * gq + 3]);
      *(uint2*)(P + (tokbase + qpos) * 2048 + 1536 + head * 64 + d * 32 + 8 * gq + 4 * lh) = pk;
    }
  __syncthreads();
}

DI void gmlp_tile(const Params& p, int l, int mt, int g, char* smem) {
  EPI_IDS
  const u16* vl = BUF(p, B_VLNT) + (size_t)g * TG * 128;
  const u16* z = BUF(p, B_Z);
  u16* P = BUF(p, B_P);
  const float* bs = p.in[12] + (size_t)l * 512 + g * 128;
  f32x16 acc[1][2][2];
  gemm_core<1, 2>(acc, vl + (size_t)mt * 256 * 128, 128, 64, WTS(p, l) + W_GWS + (size_t)g * 128 * 128, nullptr, 128, 128, smem);
#pragma unroll
  for (int ms = 0; ms < 2; ++ms)
#pragma unroll
    for (int ns = 0; ns < 2; ++ns) {
      const int t = wn * 64 + ns * 32 + lr;
      const float bias = bs[t];
#pragma unroll
      for (int gq = 0; gq < 4; ++gq) {
        const int R = mt * 256 + wm * 64 + ms * 32 + 8 * gq + 4 * lh;
        const int chunk = R >> 7, d = R & 127;
        const size_t tok = (size_t)chunk * 128 + t;
        const uint2 u = *(const uint2*)(z + tok * ZW + ZC_U + g * 128 + d);
        uint2 pk;
        pk.x = pack2(__uint_as_float(u.x << 16) * (acc[0][ms][ns][4 * gq] + bias),
                     __uint_as_float(u.x & 0xffff0000u) * (acc[0][ms][ns][4 * gq + 1] + bias));
        pk.y = pack2(__uint_as_float(u.y << 16) * (acc[0][ms][ns][4 * gq + 2] + bias),
                     __uint_as_float(u.y & 0xffff0000u) * (acc[0][ms][ns][4 * gq + 3] + bias));
        *(uint2*)(P + tok * 2048 + g * 128 + d) = pk;
      }
    }
}

DI void phase_m3(const Params& p, int l, char* smem, int only = 0) {
  const int xcd = blockIdx.x & 7, nj = gridDim.x >> 3;
  for (int vj = blockIdx.x >> 3; vj < 32; vj += nj) {
    const int hsel = vj >> 4, f = vj & 15;
    const int hd0 = 4 * xcd + hsel, hd1 = 4 * xcd + 2 + hsel;
    if (only == 0 || only == 1 || only >= 10) mla_item(p, hd0 >> 3, hd0 & 7, f, smem, only >= 10 ? only - 10 : 0);
    if (only == 0 || only == 2) nsa_item(p, l, xcd >> 1, xcd & 1, 63 - vj, smem);
    if (only == 0 || only == 1 || only >= 10) mla_item(p, hd1 >> 3, hd1 & 7, 15 - f, smem, only >= 10 ? only - 10 : 0);
    if (only == 0 || only == 2) nsa_item(p, l, xcd >> 1, xcd & 1, vj, smem);
  }
  if (only == 0 || only == 3)
    for (int it = blockIdx.x; it < (TG / 256) * 4; it += gridDim.x) gmlp_tile(p, l, it >> 2, it & 3, smem);
}

DI size_t gate_off(size_t row4, int col) { return (((row4 >> 2) * 128 + (size_t)(col >> 5)) * 32 + (size_t)(col & 31)) * 4; }
DI void phase_m4a(const Params& p, int l, int grp, char* smem) {
  G256_IDS
  const u16* xb = XB(p) + (size_t)grp * TG * D;
  const u16* wt = WTS(p, l) + W_IN + (size_t)ZW * D;
  const float* bgate = F32L(p, l) + F_BGATE;
  u16* gt = BUF(p, B_Z);
  constexpr int MPX = (TG / 256) / 8;
  auto setup = [&](int xcd, int q, const u16*& Ap, const u16*& Bp) __attribute__((always_inline)) {
    G256_SETUP_IDS
    const int mt = xcd * MPX + q % MPX, nt = q / MPX;
    Ap = xb + (size_t)mt * 256 * D;
    Bp = wt + (size_t)nt * 256 * D;
  };
  auto toff = [&](int r0, int c8, int& aoff, int& boff) __attribute__((always_inline)) {
    aoff = r0 * D + c8 * 8;
    boff = r0 * D + c8 * 8;
  };
  auto epi = [&](int xcd, int q, f32x16 (&acc)[4][2]) __attribute__((always_inline)) {
    G256_EPI_IDS
    const int mt = xcd * MPX + q % MPX, nt = q / MPX;
    const int col0 = nt * 256 + wn * 64 + lr;
    const float bias0 = bgate[col0], bias1 = bgate[col0 + 32];
#pragma unroll
    for (int ms = 0; ms < 4; ++ms)
#pragma unroll
      for (int gq = 0; gq < 4; ++gq) {
        const size_t row = (size_t)mt * 256 + wm * 128 + ms * 32 + 8 * gq + 4 * lh;
        uint2 pk0, pk1;
        pk0.x = pack2(sigmoidf(acc[ms][0][4 * gq] + bias0), sigmoidf(acc[ms][0][4 * gq + 1] + bias0));
        pk0.y = pack2(sigmoidf(acc[ms][0][4 * gq + 2] + bias0), sigmoidf(acc[ms][0][4 * gq + 3] + bias0));
        pk1.x = pack2(sigmoidf(acc[ms][1][4 * gq] + bias1), sigmoidf(acc[ms][1][4 * gq + 1] + bias1));
        pk1.y = pack2(sigmoidf(acc[ms][1][4 * gq + 2] + bias1), sigmoidf(acc[ms][1][4 * gq + 3] + bias1));
        *(uint2*)(gt + gate_off(row, col0)) = pk0;
        *(uint2*)(gt + gate_off(row, col0 + 32)) = pk1;
      }
  };
  gemm256_stream(MPX * 16, D, (long)64 * D, 64, (long)64 * D, toff, setup, epi, smem);
}

DI void phase_m4b(const Params& p, int l, char* smem) {
  const u16* P = BUF(p, B_P);
  const u16* gt = BUF(p, B_Z);
  u16* mg = BUF(p, B_MG);
  const u16* w = WTS(p, l);
  for (int qq = blockIdx.x >> 3; qq < 64; qq += (gridDim.x >> 3)) {
    const int mt = (blockIdx.x & 7) * ((TG / 256) / 8) + (qq & 7), nt = qq >> 3;
    f32x16 accm[2][2];
#pragma unroll
    for (int ms = 0; ms < 2; ++ms)
#pragma unroll
      for (int ns = 0; ns < 2; ++ns)
#pragma unroll
        for (int i = 0; i < 16; ++i) accm[ms][ns][i] = 0.f;
#pragma unroll 1
    for (int br = 0; br < 4; ++br) {
      f32x16 ay[1][2][2];
      gemm_core<1, 2>(ay, P + (size_t)mt * 256 * 2048 + br * 512, 2048, 64, w + W_OUT4 + (size_t)br * 1024 * 512 + (size_t)nt * 128 * 512, nullptr, 512, 512, smem);
      EPI_IDS
#pragma unroll
      for (int ms = 0; ms < 2; ++ms)
#pragma unroll
        for (int ns = 0; ns < 2; ++ns)
#pragma unroll
          for (int gq = 0; gq < 4; ++gq) {
            const size_t row = (size_t)mt * 256 + wm * 64 + ms * 32 + 8 * gq + 4 * lh;
            const int col = nt * 128 + wn * 64 + ns * 32 + lr;
            const unsigned long long gq64 = __builtin_nontemporal_load((const unsigned long long*)(gt + gate_off(row, br * 1024 + col)));
            uint2 gv; gv.x = (unsigned)gq64; gv.y = (unsigned)(gq64 >> 32);
            accm[ms][ns][4 * gq] += __uint_as_float(gv.x << 16) * ay[0][ms][ns][4 * gq];
            accm[ms][ns][4 * gq + 1] += __uint_as_float(gv.x & 0xffff0000u) * ay[0][ms][ns][4 * gq + 1];
            accm[ms][ns][4 * gq + 2] += __uint_as_float(gv.y << 16) * ay[0][ms][ns][4 * gq + 2];
            accm[ms][ns][4 * gq + 3] += __uint_as_float(gv.y & 0xffff0000u) * ay[0][ms][ns][4 * gq + 3];
          }
    }
    EPI_IDS
#pragma unroll
    for (int ms = 0; ms < 2; ++ms)
#pragma unroll
      for (int ns = 0; ns < 2; ++ns)
#pragma unroll
        for (int i = 0; i < 16; ++i) {
          const size_t row = (size_t)mt * 256 + wm * 64 + ms * 32 + crow(i, lh);
          mg[row * D + nt * 128 + wn * 64 + ns * 32 + lr] = f2bf(accm[ms][ns][i]);
        }
  }
}

DI void phase_x1(const Params& p, int l, char* smem) {
  G256_IDS
  const u16* xb = XB(p);
  const u16* w = WTS(p, l);
  u16* xq = BUF(p, B_XQ);
  constexpr int MPX = (T / 256) / 8;
  {
    auto setup = [&](int xcd, int q, const u16*& Ap, const u16*& Bp) __attribute__((always_inline)) {
    G256_SETUP_IDS
      const int mt = xcd * MPX + q % MPX, nt = q / MPX;
      Ap = xb + (size_t)mt * 256 * D;
      Bp = w + W_XQ + (size_t)nt * 256 * D;
    };
    auto toff = [&](int r0, int c8, int& aoff, int& boff) __attribute__((always_inline)) {
      aoff = r0 * D + c8 * 8;
      boff = r0 * D + c8 * 8;
    };
    auto epi = [&](int xcd, int q, f32x16 (&acc)[4][2]) __attribute__((always_inline)) {
    G256_EPI_IDS
      const int mt = xcd * MPX + q % MPX, nt = q / MPX;
#pragma unroll
      for (int ms = 0; ms < 4; ++ms)
#pragma unroll
        for (int ns = 0; ns < 2; ++ns)
#pragma unroll
          for (int i = 0; i < 16; ++i) {
            const size_t row = (size_t)mt * 256 + wm * 128 + ms * 32 + crow(i, lh);
            xq[row * 512 + nt * 256 + wn * 64 + ns * 32 + lr] = f2bf(acc[ms][ns][i]);
          }
    };
    gemm256_stream(2 * MPX, D, (long)64 * D, 64, (long)64 * D, toff, setup, epi, smem);
  }
}

DI void phase_x2(const Params& p, char* smem) {
  const int tid = otid(), lane = tid & 63, wave = tid >> 6, lr = lane & 31, lh = lane >> 5;
  const u16* xq = BUF(p, B_XQ);
  u16* xo = BUF(p, B_XO);
  const u16* kx = (const u16*)(PWS(p) + WS_KX);
  const u16* vxt = (const u16*)(PWS(p) + WS_VXT);
  for (int t = blockIdx.x; t < BATCH * 4 * 16; t += gridDim.x) {
    const int b = t >> 6, h = (t >> 4) & 3, qt = t & 15;
    const size_t tok = (size_t)b * SEQ + qt * 256 + wave * 32 + lr;
    bf16x8 q[8];
#pragma unroll
    for (int kk = 0; kk < 8; ++kk) q[kk] = *(const bf16x8*)(xq + tok * 512 + h * 128 + kk * 16 + lh * 8);
    float m = -1e30f, l = 0.f;
    f32x16 O[4];
#pragma unroll
    for (int d = 0; d < 4; ++d)
#pragma unroll
      for (int i = 0; i < 16; ++i) O[d][i] = 0.f;
    flash_loop<128, 128, 0>(m, l, O, q, 0.08838834764831845f, kx + (size_t)b * MEML * 512 + h * 128, 512,
                            vxt + ((size_t)(b * 4 + h) * 128) * MEML, MEML, 0, 4, 0, 0, 0ull, smem);
    const float inv = 1.f / l;
#pragma unroll
    for (int d = 0; d < 4; ++d)
#pragma unroll
      for (int gq = 0; gq < 4; ++gq) {
        uint2 pk;
        pk.x = pack2(O[d][4 * gq] * inv, O[d][4 * gq + 1] * inv);
        pk.y = pack2(O[d][4 * gq + 2] * inv, O[d][4 * gq + 3] * inv);
        *(uint2*)(xo + tok * 512 + h * 128 + d * 32 + 8 * gq + 4 * lh) = pk;
      }
  }
}

#define XB_TMO      128
#define XB_XCNT(j)  (256  + 64 * (j))
#define XB_XSUB(j)  (1280 + 64 * (j))
#define XB_XGEN(j)  (2304 + 64 * (j))
#define XB_TOP      3328
#define XB_TOPGEN   3392
#define XCD_BAR_WORDS 3456
#define XB_SPIN_CAP (1u << 22)
#define LAS __attribute__((address_space(3)))
DI unsigned xb_ld(unsigned* p) { return __hip_atomic_load(p, __ATOMIC_RELAXED, __HIP_MEMORY_SCOPE_AGENT); }
DI unsigned xb_add(unsigned* p, unsigned v) { return __hip_atomic_fetch_add(p, v, __ATOMIC_RELAXED, __HIP_MEMORY_SCOPE_AGENT); }
DI unsigned xb_xcc_id() { return (unsigned)__builtin_amdgcn_s_getreg((3 << 11) | 20) & 0xFu; }
#define XB_SPIN(cond, bar) do { unsigned _sp = 0; while (cond) { __builtin_amdgcn_s_sleep(1); \
    if ((++_sp & 255u) == 0u) { if (xb_ld(&(bar)[XB_TMO])) break; if (_sp > XB_SPIN_CAP) { atomicAdd(&(bar)[XB_TMO], 1u); break; } } } } while (0)
struct XcdBarrier { unsigned* bar; unsigned x; volatile LAS unsigned* st; };
DI XcdBarrier xcd_barrier_post(unsigned* bar, volatile LAS unsigned* st) {
  XcdBarrier b; b.bar = bar; b.x = xb_xcc_id(); b.st = st;
  if (threadIdx.x == 0) (void)xb_add(&bar[XB_XCNT(b.x)], 1u);
  return b;
}
DI void xcd_barrier_complete(unsigned* bar, unsigned x, unsigned& nloc, unsigned& nx) {
  const unsigned G = gridDim.x * gridDim.y * gridDim.z;
  unsigned sum, cnt, mine, sp = 0u;
  for (;;) {
    sum = 0u; cnt = 0u; mine = 0u;
#pragma unroll
    for (unsigned j = 0; j < 16; ++j) { const unsigned c = xb_ld(&bar[XB_XCNT(j)]); sum += c; cnt += (c > 0u) ? 1u : 0u; mine = (j == x) ? c : mine; }
    if (sum == G) break;
    __builtin_amdgcn_s_sleep(1);
    if ((++sp & 255u) == 0u) { if (xb_ld(&bar[XB_TMO])) break; if (sp > XB_SPIN_CAP) { atomicAdd(&bar[XB_TMO], 1u); break; } }
  }
  nloc = mine > 0u ? mine : 1u; nx = cnt > 0u ? cnt : 1u;
}
DI void xcd_barrier(const XcdBarrier& b) {
  asm volatile("s_waitcnt vmcnt(0)" ::: "memory");
  __syncthreads();
  if (threadIdx.x == 0) {
    unsigned* bar = b.bar;
    __builtin_amdgcn_s_waitcnt(0);
    unsigned nloc = b.st[0], nx = b.st[1];
    if (nloc == 0u) { xcd_barrier_complete(bar, b.x, nloc, nx); b.st[0] = nloc; b.st[1] = nx; }
    const unsigned old = xb_add(&bar[XB_XSUB(b.x)], 1u);
    const unsigned gen = old / nloc;
    if (old + 1u == (gen + 1u) * nloc) {
      __builtin_amdgcn_fence(__ATOMIC_RELEASE, "agent");
      asm volatile("s_waitcnt vmcnt(0)" ::: "memory");
      const unsigned og = xb_add(&bar[XB_TOP], 1u);
      const unsigned tg = og / nx;
      if (og + 1u == (tg + 1u) * nx) xb_add(&bar[XB_TOPGEN], 1u);
      else XB_SPIN(xb_ld(&bar[XB_TOPGEN]) == tg, bar);
      __builtin_amdgcn_fence(__ATOMIC_ACQUIRE, "agent");
      xb_add(&bar[XB_XGEN(b.x)], 1u);
      asm volatile("s_waitcnt vmcnt(0)" ::: "memory");
    } else {
      XB_SPIN(xb_ld(&bar[XB_XGEN(b.x)]) == gen, bar);
      __builtin_amdgcn_fence(__ATOMIC_ACQUIRE, "agent");
      asm volatile("s_waitcnt vmcnt(0)" ::: "memory");
    }
  }
  __syncthreads();
}
DI XcdBarrier mk_bar(const Params& p, char* smem) {
  XcdBarrier b;
  b.bar = (unsigned*)(PWS(p) + WS_BAR);
  b.x = xb_xcc_id();
  b.st = (volatile LAS unsigned*)(smem + XB_LDS_OFF);
  return b;
}

enum { PH_INIT, PH_FFN_UP, PH_RESID, PH_LN, PH_M1, PH_M2, PH_M3, PH_M4A, PH_M4B, PH_X1, PH_X2 };
constexpr int STEPS_PER_LAYER = 3 + NGRP * 6 + 8;
constexpr int NSTEPS = 1 + DEPTH * STEPS_PER_LAYER;
#define PROBE_PH (-1)
#define PROBE_SUB 0
__global__ void __launch_bounds__(NTHREADS) k_mega(Params p) {
  extern __shared__ __attribute__((aligned(16))) char smem[];
  cg::grid_group grid = cg::this_grid();
  {
    volatile LAS unsigned* st = (volatile LAS unsigned*)(smem + XB_LDS_OFF);
    if (threadIdx.x == 0) { st[0] = 0u; st[1] = 0u; }
    __syncthreads();
    (void)xcd_barrier_post((unsigned*)(PWS(p) + WS_BAR), st);
  }
#pragma unroll 1
  for (int step = 0; step < NSTEPS; ++step) {
    int ph = PH_INIT, l = 0, grp = 0, var = 0;
    if (step > 0) {
      const int s1 = step - 1;
      l = s1 / STEPS_PER_LAYER;
      const int r = s1 % STEPS_PER_LAYER;
      constexpr int MIXEND = 3 + NGRP * 6;
      if (r == 0) { ph = PH_FFN_UP; var = 0; }
      else if (r == 1) { ph = PH_RESID; var = 0; }
      else if (r == 2) { ph = PH_LN; var = 0; }
      else if (r < MIXEND) {
        const int m = r - 3, k = m % 6;
        grp = m / 6;
        ph = (k == 0) ? PH_M1 : (k == 1) ? PH_M2 : (k == 2) ? PH_M3 : (k == 3) ? PH_M4A : (k == 4) ? PH_M4B : PH_RESID;
        var = 1;
      }
      else if (r == MIXEND) { ph = PH_LN; var = 1; }
      else if (r == MIXEND + 1) { ph = PH_X1; }
      else if (r == MIXEND + 2) { ph = PH_X2; }
      else if (r == MIXEND + 3) { ph = PH_RESID; var = 2; }
      else if (r == MIXEND + 4) { ph = PH_LN; var = 2; }
      else if (r == MIXEND + 5) { ph = PH_FFN_UP; var = 1; }
      else if (r == MIXEND + 6) { ph = PH_RESID; var = 3; }
      else { ph = PH_LN; var = 3; }
    }
    const u16* w = WTS(p, l);
#pragma unroll 1
    for (int rep = 0; rep < ((ph == PROBE_PH) ? 2 : 1); ++rep) {
    switch (ph) {
      case PH_INIT: phase0(p, smem); break;
      case PH_FFN_UP: phase_ffn_up(p, w + (var ? W_F2W1 : W_F1W1), w + (var ? W_F2W3 : W_F1W3), smem); break;
      case PH_RESID: {
        const u16* A; const u16* Bt; const float* res = p.out; int lda, K, row0 = 0, nrows = T; float scl = 1.f;
        if (var == 0) { A = BUF(p, B_H); lda = FF; K = FF; Bt = w + W_F1W2; scl = 0.5f; if (l == 0) res = p.in[0]; }
        else if (var == 1) { A = BUF(p, B_MG); lda = D; K = D; Bt = w + W_O; row0 = grp * TG; nrows = TG; }
        else if (var == 2) { A = BUF(p, B_XO); lda = 512; K = 512; Bt = w + W_XO; }
        else { A = BUF(p, B_H); lda = FF; K = FF; Bt = w + W_F2W2; scl = 0.5f; }
        (void)res;
        phase_gemm_resid(p, A, lda, K, Bt, (l == DEPTH - 1) && (var == 3), scl, row0, nrows, smem);
      } break;
      case PH_LN: {
        const int gi = (var == 0) ? 5 : (var == 1) ? 27 : (var == 2) ? 33 : 38;
        phase_ln(p, p.in[gi] + l * D, p.in[gi + 1] + l * D, (l == DEPTH - 1) && (var == 3));
      } break;
      case PH_M1: phase_m1(p, l, grp, smem); break;
      case PH_M2: phase_m2(p, l, grp, smem); break;
      case PH_M3: phase_m3(p, l, smem, rep ? PROBE_SUB : 0); break;
      case PH_M4A: phase_m4a(p, l, grp, smem); break;
      case PH_M4B: phase_m4b(p, l, smem); break;
      case PH_X1: phase_x1(p, l, smem); break;
      default: phase_x2(p, smem); break;
    }
    if (step == 0) grid.sync();
    else xcd_barrier(mk_bar(p, smem));
    }
  }
}

extern "C" void kernel_launch(void* const* d_in, const int* in_sizes, int n_in, void* d_out, int out_size, void* d_ws,
                              size_t ws_size, hipStream_t stream) {
  (void)in_sizes; (void)out_size;
  if (n_in < 40 || ws_size < WS_TOTAL) {
    fprintf(stderr, "kernel_launch: unexpected inputs (n_in %d, ws %zu < %zu)\n", n_in, ws_size, (size_t)WS_TOTAL);
    return;
  }
  static int grid_blocks = 0;
  if (!grid_blocks) {
    hipFuncSetAttribute((const void*)k_mega, hipFuncAttributeMaxDynamicSharedMemorySize, SMEM_BYTES);
    int dev = 0, cus = 0, per_cu = 0;
    hipGetDevice(&dev);
    hipDeviceGetAttribute(&cus, hipDeviceAttributeMultiprocessorCount, dev);
    hipOccupancyMaxActiveBlocksPerMultiprocessor(&per_cu, k_mega, NTHREADS, SMEM_BYTES);
    if (per_cu < 1) per_cu = 1;
    grid_blocks = cus * per_cu;
  }
  Params p{};
  for (int i = 0; i < 40; ++i) p.in[i] = (const float*)d_in[i];
  p.out = (float*)d_out;
  p.ws = (char*)d_ws;
  hipMemsetAsync((char*)d_ws + WS_BAR, 0, (size_t)XCD_BAR_WORDS * 4, stream);
  void* args[] = {&p};
  hipError_t e = hipLaunchCooperativeKernel((const void*)k_mega, dim3(grid_blocks), dim3(NTHREADS), args, SMEM_BYTES, stream);
  if (e != hipSuccess) fprintf(stderr, "cooperative launch failed: %s (grid %d)\n", hipGetErrorString(e), grid_blocks);
}
```

```cpp
#include <hip/hip_runtime.h>
#include <hip/hip_cooperative_groups.h>
#include <cstdio>
#include <cstdint>
namespace cg = cooperative_groups;

typedef unsigned short u16;
using bf16x8 = __attribute__((ext_vector_type(8))) short;
using s16x4 = __attribute__((ext_vector_type(4))) short;
using f32x16 = __attribute__((ext_vector_type(16))) float;
#define DI __device__ __forceinline__
#define MFMA(a, b, c) __builtin_amdgcn_mfma_f32_32x32x16_bf16((a), (b), (c), 0, 0, 0)

constexpr int D = 1024, BATCH = 8, SEQ = 4096, T = BATCH * SEQ, DEPTH = 2, MEML = 256, FF = 2816;
constexpr int BG = 4;
constexpr int TG = BG * SEQ;
constexpr int NGRP = BATCH / BG;
constexpr int ZW = 4352;
constexpr int INW = 8376;
constexpr int ZC_U = 0, ZC_V = 512, ZC_CB = 1024, ZC_CC = 1536, ZC_CH = 2048, ZC_QLAT = 2560, ZC_KVLAT = 2816,
              ZC_NQ = 2944, ZC_NKC = 3456, ZC_NVC = 3584, ZC_NKS = 3712, ZC_NVS = 3840, ZC_NKW = 3968,
              ZC_NVW = 4096, ZC_KROPE = 4224, ZC_GATE = 4256;
constexpr float ALPHA = 1.4142135623730951f;
constexpr int NTHREADS = 512;
constexpr int SMEM_BYTES = 140 * 1024;
constexpr int XB_LDS_OFF = 138 * 1024;

constexpr size_t W_F1W1 = 0;
constexpr size_t W_F1W3 = W_F1W1 + (size_t)FF * D;
constexpr size_t W_F1W2 = W_F1W3 + (size_t)FF * D;
constexpr size_t W_F2W1 = W_F1W2 + (size_t)FF * D;
constexpr size_t W_F2W3 = W_F2W1 + (size_t)FF * D;
constexpr size_t W_F2W2 = W_F2W3 + (size_t)FF * D;
constexpr size_t W_IN = W_F2W2 + (size_t)FF * D;
constexpr size_t W_OUT4 = W_IN + (size_t)(ZW + 4096) * D;
constexpr size_t W_UQ = W_OUT4 + (size_t)4 * 1024 * 512;
constexpr size_t W_UKV = W_UQ + (size_t)768 * 256;
constexpr size_t W_O = W_UKV + (size_t)1024 * 128;
constexpr size_t W_XQ = W_O + (size_t)1024 * 1024;
constexpr size_t W_XKV = W_XQ + (size_t)512 * 1024;
constexpr size_t W_XO = W_XKV + (size_t)1024 * 1024;
constexpr size_t W_CK = W_XO + (size_t)1024 * 512;
constexpr size_t W_CV = W_CK + (size_t)128 * 1024;
constexpr size_t W_GWS = W_CV + (size_t)128 * 1024;
constexpr size_t LAYER_W = W_GWS + (size_t)4 * 128 * 128;

constexpr int F_BZ = 0, F_BGATE = ZW, F_CK = ZW + 4096, F_CV = F_CK + 64, F32_PER_LAYER = F_CV + 64;

constexpr size_t al256(size_t x) { return (x + 255) & ~(size_t)255; }
constexpr size_t cmax(size_t a, size_t b) { return a > b ? a : b; }
constexpr size_t WS_WTS = 0;
constexpr size_t WS_F32 = al256(WS_WTS + 2 * LAYER_W * 2);
constexpr size_t WS_BAR = al256(WS_F32 + (size_t)2 * F32_PER_LAYER * 4);
constexpr size_t WS_TAB64 = al256(WS_BAR + (size_t)4096 * 4);
constexpr size_t WS_TAB32 = al256(WS_TAB64 + (size_t)4096 * 32 * 8);
constexpr size_t WS_XB = al256(WS_TAB32 + (size_t)4096 * 16 * 8);
constexpr size_t WS_MEMB = al256(WS_XB + (size_t)T * D * 2);
constexpr size_t WS_KX = al256(WS_MEMB + (size_t)BATCH * MEML * D * 2);
constexpr size_t WS_VXT = al256(WS_KX + (size_t)BATCH * MEML * 512 * 2);
constexpr size_t WS_BIG = al256(WS_VXT + (size_t)BATCH * MEML * 512 * 2);
constexpr size_t B_H = 0;
constexpr size_t B_Z = 0;
constexpr size_t B_P = al256(B_Z + (size_t)TG * ZW * 2);
constexpr size_t B_QB = al256(B_P + (size_t)TG * 2048 * 2);
constexpr size_t B_KB = al256(B_QB + (size_t)TG * 768 * 2);
constexpr size_t B_MG = B_QB;
constexpr size_t B_VT = al256(B_KB + (size_t)TG * 768 * 2);
constexpr size_t B_VST = al256(B_VT + (size_t)TG * 512 * 2);
constexpr size_t B_VWT = al256(B_VST + (size_t)TG * 128 * 2);
constexpr size_t B_VLNT = al256(B_VWT + (size_t)TG * 128 * 2);
constexpr size_t B_UV = al256(B_VLNT + (size_t)TG * 512 * 2);
constexpr size_t B_END = al256(B_UV + (size_t)4 * (TG / 16) * 128 * 4);
constexpr size_t B_XQ = 0;
constexpr size_t B_XO = al256((size_t)T * 512 * 2);
constexpr size_t WS_TOTAL = WS_BIG + cmax(B_END, (size_t)T * FF * 2);
static_assert(WS_TOTAL <= (size_t)512 * 1024 * 1024, "workspace too large");

struct Params {
  const float* in[40];
  float* out;
  char* ws;
};

DI char* launder(char* x) {
  unsigned lo = (unsigned)(uintptr_t)x, hi = (unsigned)((uintptr_t)x >> 32);
  unsigned vlo, vhi;
  asm volatile("v_mov_b32 %0, %2\n\tv_mov_b32 %1, %3" : "=v"(vlo), "=v"(vhi) : "s"(lo), "s"(hi));
  lo = __builtin_amdgcn_readfirstlane(vlo);
  hi = __builtin_amdgcn_readfirstlane(vhi);
  return (char*)(__attribute__((address_space(1))) char*)(((uintptr_t)hi << 32) | (uintptr_t)lo);
}
#define PWS(p) launder((p).ws)
DI u16* WTS(const Params& p, int l) { return (u16*)(PWS(p) + WS_WTS) + (size_t)l * LAYER_W; }
DI float* F32L(const Params& p, int l) { return (float*)(PWS(p) + WS_F32) + (size_t)l * F32_PER_LAYER; }
DI float2* TAB64(const Params& p) { return (float2*)(PWS(p) + WS_TAB64); }
DI float2* TAB32(const Params& p) { return (float2*)(PWS(p) + WS_TAB32); }
DI u16* XB(const Params& p) { return (u16*)(PWS(p) + WS_XB); }
constexpr size_t B_R16_LAST = (size_t)192 * 1024 * 1024;
static_assert(B_R16_LAST >= (size_t)T * FF * 2 && B_R16_LAST + (size_t)T * D * 2 <= cmax(B_END, (size_t)T * FF * 2), "r16 placement");
DI u16* R16(const Params& p, bool last) { return last ? (u16*)(PWS(p) + WS_BIG + B_R16_LAST) : (u16*)launder((char*)p.out); }
DI u16* BUF(const Params& p, size_t off) { return (u16*)(PWS(p) + WS_BIG + off); }

typedef __bf16 hwbf16x2 __attribute__((ext_vector_type(2)));
typedef float f32x2v __attribute__((ext_vector_type(2)));
DI unsigned pack2(float a, float b) { f32x2v v = {a, b}; hwbf16x2 r = __builtin_convertvector(v, hwbf16x2); return __builtin_bit_cast(unsigned, r); }
DI u16 f2bf(float x) { return (u16)(pack2(x, 0.f) & 0xffffu); }
DI float bf2f(u16 v) { return __uint_as_float(((unsigned)v) << 16); }
DI int otid() { int t = threadIdx.x; asm volatile("" : "+v"(t)); return t; }
DI int crow(int i, int h) { return (i & 3) + 8 * (i >> 2) + 4 * h; }
DI float sigmoidf(float x) { return __builtin_amdgcn_rcpf(1.f + __expf(-x)); }
DI float wave_sum(float v) {
#pragma unroll
  for (int o = 32; o >= 1; o >>= 1) v += __shfl_xor(v, o);
  return v;
}

template <int NB, int NS>
DI void gemm_core(f32x16 (&acc)[NB][2][NS], const u16* __restrict__ A, long lda, long akcs,
                  const u16* __restrict__ B0, const u16* __restrict__ B1, long ldb, int K, char* smem) {
  constexpr int A_BYTES = 256 * 128, B_BYTES = 64 * NS * 128, STAGE = A_BYTES + NB * B_BYTES;
  const int tid = otid(), lane = tid & 63, wave = tid >> 6, wm = wave >> 1, wn = wave & 1;
  const int lr = lane & 31, lh = lane >> 5, c8 = tid & 7, r0 = tid >> 3;
  const int swz = (r0 >> 1) & 7;
  const int nk = K >> 6;
#pragma unroll
  for (int b = 0; b < NB; ++b)
#pragma unroll
    for (int ms = 0; ms < 2; ++ms)
#pragma unroll
      for (int ns = 0; ns < NS; ++ns)
#pragma unroll
        for (int i = 0; i < 16; ++i) acc[b][ms][ns][i] = 0.f;

  uint4 ra0, ra1, ra2, ra3, rb0, rb1, rb2, rb3;
  ra0 = ra1 = ra2 = ra3 = rb0 = rb1 = rb2 = rb3 = make_uint4(0, 0, 0, 0);
#define GEMM_GLOAD(kt_)                                                                        \
  {                                                                                            \
    const u16* ap_ = A + (long)r0 * lda + (long)(kt_) * akcs + c8 * 8;                         \
    ra0 = *(const uint4*)(ap_);                                                                \
    ra1 = *(const uint4*)(ap_ + 64 * lda);                                                     \
    ra2 = *(const uint4*)(ap_ + 128 * lda);                                                    \
    ra3 = *(const uint4*)(ap_ + 192 * lda);                                                    \
    const u16* bp_ = B0 + (long)r0 * ldb + (kt_) * 64 + c8 * 8;                                \
    rb0 = *(const uint4*)(bp_);                                                                \
    if constexpr (NS > 1) rb1 = *(const uint4*)(bp_ + 64 * ldb);                               \
    if constexpr (NB > 1) {                                                                    \
      const u16* bq_ = B1 + (long)r0 * ldb + (kt_) * 64 + c8 * 8;                              \
      rb2 = *(const uint4*)(bq_);                                                              \
      if constexpr (NS > 1) rb3 = *(const uint4*)(bq_ + 64 * ldb);                             \
    }                                                                                          \
  }
#define GEMM_SSTORE(s_)                                                                        \
  {                                                                                            \
    char* base_ = smem + (s_) * STAGE + r0 * 128 + ((c8 ^ swz) << 4);                          \
    *(uint4*)(base_) = ra0;                                                                    \
    *(uint4*)(base_ + 64 * 128) = ra1;                                                         \
    *(uint4*)(base_ + 128 * 128) = ra2;                                                        \
    *(uint4*)(base_ + 192 * 128) = ra3;                                                        \
    *(uint4*)(base_ + A_BYTES) = rb0;                                                          \
    if constexpr (NS > 1) *(uint4*)(base_ + A_BYTES + 64 * 128) = rb1;                         \
    if constexpr (NB > 1) {                                                                    \
      *(uint4*)(base_ + A_BYTES + B_BYTES) = rb2;                                              \
      if constexpr (NS > 1) *(uint4*)(base_ + A_BYTES + B_BYTES + 64 * 128) = rb3;             \
    }                                                                                          \
  }
  __syncthreads();
  GEMM_GLOAD(0)
  GEMM_SSTORE(0)
  if (nk > 1) GEMM_GLOAD(1)
  __syncthreads();
  for (int kt = 0; kt < nk; ++kt) {
    const int s = kt & 1;
    if (kt + 1 < nk) GEMM_SSTORE(s ^ 1)
    if (kt + 2 < nk) GEMM_GLOAD(kt + 2)
    __builtin_amdgcn_sched_barrier(0);
    const char* base = smem + s * STAGE;
#pragma unroll
    for (int kk = 0; kk < 4; ++kk) {
      bf16x8 af[2], bfr[NB][NS];
#pragma unroll
      for (int ms = 0; ms < 2; ++ms) {
        const int row = wm * 64 + ms * 32 + lr, ch = kk * 2 + lh;
        af[ms] = *(const bf16x8*)(base + row * 128 + ((ch ^ ((row >> 1) & 7)) << 4));
      }
#pragma unroll
      for (int b = 0; b < NB; ++b)
#pragma unroll
        for (int ns = 0; ns < NS; ++ns) {
          const int row = wn * (32 * NS) + ns * 32 + lr, ch = kk * 2 + lh;
          bfr[b][ns] = *(const bf16x8*)(base + A_BYTES + b * B_BYTES + row * 128 + ((ch ^ ((row >> 1) & 7)) << 4));
        }
#pragma unroll
      for (int b = 0; b < NB; ++b)
#pragma unroll
        for (int ms = 0; ms < 2; ++ms)
#pragma unroll
          for (int ns = 0; ns < NS; ++ns) acc[b][ms][ns] = MFMA(af[ms], bfr[b][ns], acc[b][ms][ns]);
    }
    __syncthreads();
  }
}

#define EPI_IDS                                                                       \
  const int tid = otid(), lane = tid & 63, wave = tid >> 6, wm = wave >> 1, wn = wave & 1; \
  const int lr = lane & 31, lh = lane >> 5;                                           \
  (void)tid; (void)wm; (void)wn; (void)lr; (void)lh;

struct Job { const float* src; u16* dst; int K, N, ld; const float* ks; };

DI Job get_job(const Params& p, int l, int j) {
  u16* w = WTS(p, l);
  Job o;
  o.ks = nullptr;
  const float* win = p.in[7] + (size_t)l * D * INW;
  switch (j) {
    case 0: o.src = p.in[2] + (size_t)l * D * FF; o.dst = w + W_F1W1; o.K = D; o.N = FF; o.ld = FF; break;
    case 1: o.src = p.in[3] + (size_t)l * D * FF; o.dst = w + W_F1W3; o.K = D; o.N = FF; o.ld = FF; break;
    case 2: o.src = p.in[4] + (size_t)l * D * FF; o.dst = w + W_F1W2; o.K = FF; o.N = D; o.ld = D; break;
    case 3: o.src = p.in[35] + (size_t)l * D * FF; o.dst = w + W_F2W1; o.K = D; o.N = FF; o.ld = FF; break;
    case 4: o.src = p.in[36] + (size_t)l * D * FF; o.dst = w + W_F2W3; o.K = D; o.N = FF; o.ld = FF; break;
    case 5: o.src = p.in[37] + (size_t)l * D * FF; o.dst = w + W_F2W2; o.K = FF; o.N = D; o.ld = D; break;
    case 6: o.src = win; o.dst = w + W_IN; o.K = D; o.N = 2944; o.ld = INW; break;
    case 7: o.src = win + 2976; o.dst = w + W_IN + (size_t)2944 * D; o.K = D; o.N = 1280; o.ld = INW; break;
    case 8: o.src = win + 2944; o.dst = w + W_IN + (size_t)ZC_KROPE * D; o.K = D; o.N = 32; o.ld = INW; break;
    case 9: o.src = win + 4256; o.dst = w + W_IN + (size_t)ZC_GATE * D; o.K = D; o.N = 24; o.ld = INW; break;
    case 10: o.src = win + 4280; o.dst = w + W_IN + (size_t)ZW * D; o.K = D; o.N = 4096; o.ld = INW; break;
    case 11: o.src = p.in[13] + (size_t)l * 512 * D; o.dst = w + W_OUT4; o.K = 512; o.N = D; o.ld = D; break;
    case 12: o.src = p.in[15] + (size_t)l * 512 * D; o.dst = w + W_OUT4 + (size_t)1 * 1024 * 512; o.K = 512; o.N = D; o.ld = D; break;
    case 13: o.src = p.in[20] + (size_t)l * 512 * D; o.dst = w + W_OUT4 + (size_t)2 * 1024 * 512; o.K = 512; o.N = D; o.ld = D; break;
    case 14: o.src = p.in[25] + (size_t)l * 512 * D; o.dst = w + W_OUT4 + (size_t)3 * 1024 * 512; o.K = 512; o.N = D; o.ld = D; break;
    case 15: o.src = p.in[18] + (size_t)l * 256 * 768; o.dst = w + W_UQ; o.K = 256; o.N = 768; o.ld = 768; o.ks = p.in[16] + l * 256; break;
    case 16: o.src = p.in[19] + (size_t)l * 128 * 1024; o.dst = w + W_UKV; o.K = 128; o.N = 1024; o.ld = 1024; o.ks = p.in[17] + l * 128; break;
    case 17: o.src = p.in[26] + (size_t)l * D * D; o.dst = w + W_O; o.K = D; o.N = D; o.ld = D; break;
    case 18: o.src = p.in[29] + (size_t)l * D * 512; o.dst = w + W_XQ; o.K = D; o.N = 512; o.ld = 512; break;
    case 19: o.src = p.in[30] + (size_t)l * D * 512; o.dst = w + W_XKV; o.K = D; o.N = 512; o.ld = 512; break;
    case 20: o.src = p.in[31] + (size_t)l * D * 512; o.dst = w + W_XKV + (size_t)512 * D; o.K = D; o.N = 512; o.ld = 512; break;
    case 21: o.src = p.in[32] + (size_t)l * 512 * D; o.dst = w + W_XO; o.K = 512; o.N = D; o.ld = D; break;
    case 22: o.src = p.in[23] + (size_t)l * 2048 * 64; o.dst = w + W_CK; o.K = 1024; o.N = 64; o.ld = 64; break;
    case 23: o.src = p.in[23] + (size_t)l * 2048 * 64 + 1024 * 64; o.dst = w + W_CK + (size_t)64 * 1024; o.K = 1024; o.N = 64; o.ld = 64; break;
    case 24: o.src = p.in[24] + (size_t)l * 2048 * 64; o.dst = w + W_CV; o.K = 1024; o.N = 64; o.ld = 64; break;
    default: o.src = p.in[24] + (size_t)l * 2048 * 64 + 1024 * 64; o.dst = w + W_CV + (size_t)64 * 1024; o.K = 1024; o.N = 64; o.ld = 64; break;
  }
  return o;
}
constexpr int NJOBS = 26;

DI void conv_tiles4(const Job& jb, int t0, int tstep, int ntiles, int nkt, char* smem) {
  const int tid = otid(), kk = tid >> 3, c = tid & 7;
  float v[4][8];
#pragma unroll
  for (int u = 0; u < 4; ++u) {
    const int t = t0 + u * tstep;
#pragma unroll
    for (int e = 0; e < 8; ++e) v[u][e] = 0.f;
    if (t < ntiles) {
      const int tk = t % nkt, tn = t / nkt;
      const int k = tk * 64 + kk, n0 = tn * 64 + c * 8;
      const float* s = jb.src + (size_t)k * jb.ld + n0;
      if (n0 + 8 <= jb.N) {
        float4 a, b;
        a.x = __builtin_nontemporal_load(s); a.y = __builtin_nontemporal_load(s + 1); a.z = __builtin_nontemporal_load(s + 2); a.w = __builtin_nontemporal_load(s + 3);
        b.x = __builtin_nontemporal_load(s + 4); b.y = __builtin_nontemporal_load(s + 5); b.z = __builtin_nontemporal_load(s + 6); b.w = __builtin_nontemporal_load(s + 7);
        v[u][0] = a.x; v[u][1] = a.y; v[u][2] = a.z; v[u][3] = a.w; v[u][4] = b.x; v[u][5] = b.y; v[u][6] = b.z; v[u][7] = b.w;
      } else {
#pragma unroll
        for (int e = 0; e < 8; ++e) v[u][e] = (n0 + e < jb.N) ? s[e] : 0.f;
      }
    }
  }
#pragma unroll
  for (int u = 0; u < 4; ++u) {
    const int t = t0 + u * tstep;
    if (t < ntiles) {
      u16* Ts = (u16*)smem + u * (64 * 72);
      const float sc = jb.ks ? jb.ks[(t % nkt) * 64 + kk] : 1.f;
#pragma unroll
      for (int e = 0; e < 8; ++e) Ts[(c * 8 + e) * 72 + kk] = f2bf(v[u][e] * sc);
    }
  }
  __syncthreads();
  const int n = tid >> 3, ch = tid & 7;
#pragma unroll
  for (int u = 0; u < 4; ++u) {
    const int t = t0 + u * tstep;
    if (t < ntiles) {
      const int tk = t % nkt, tn = t / nkt;
      if (tn * 64 + n < jb.N) {
        const u16* Ts = (const u16*)smem + u * (64 * 72);
        const uint4 val = *(const uint4*)(Ts + n * 72 + ch * 8);
        *(uint4*)(jb.dst + (size_t)(tn * 64 + n) * jb.K + tk * 64 + ch * 8) = val;
      }
    }
  }
  __syncthreads();
}

DI void phase0(const Params& p, char* smem) {
  const int tid = otid();
  const size_t gtid = (size_t)blockIdx.x * NTHREADS + tid, gsz = (size_t)gridDim.x * NTHREADS;
  for (int l = 0; l < DEPTH; ++l)
    for (int j = 0; j < NJOBS; ++j) {
      Job jb = get_job(p, l, j);
      const int nkt = jb.K / 64, nnt = (jb.N + 63) / 64;
      for (int t = blockIdx.x; t < nkt * nnt; t += 4 * gridDim.x) conv_tiles4(jb, t, gridDim.x, nkt * nnt, nkt, smem);
    }
  for (int l = 0; l < DEPTH; ++l) {
    u16* w = WTS(p, l);
    float* f = F32L(p, l);
    for (size_t i = gtid; i < (size_t)72 * D; i += gsz) w[W_IN + (size_t)4280 * D + i] = 0;
    const float* gws = p.in[11] + (size_t)l * 4 * 128 * 128;
    for (size_t i = gtid; i < (size_t)4 * 128 * 128; i += gsz) {
      const int s = (int)(i & 127), t = (int)((i >> 7) & 127);
      w[W_GWS + i] = (s <= t) ? f2bf(gws[i]) : (u16)0;
    }
    const float* bin = p.in[8] + (size_t)l * INW;
    for (size_t i = gtid; i < (size_t)(ZW + 4096); i += gsz) {
      const int c = (int)i;
      float v;
      if (c < 2944) v = bin[c];
      else if (c < 4224) v = bin[c - 2944 + 2976];
      else if (c < 4256) v = bin[c - 4224 + 2944];
      else if (c < 4280) v = bin[c];
      else if (c < ZW) v = 0.f;
      else v = bin[c - ZW + 4280];
      f[F_BZ + c] = v;
    }
  }
  for (int it = blockIdx.x; it < DEPTH * 2; it += gridDim.x) {
    const int l = it >> 1, kv = it & 1;
    const float* pe = p.in[kv ? 22 : 21] + (size_t)l * 2048;
    const float* wc = p.in[kv ? 24 : 23] + (size_t)l * 2048 * 64;
    float* red = (float*)smem;
    const int e = tid & 63, part = tid >> 6;
    float a = 0.f;
    for (int i = part * 256; i < part * 256 + 256; ++i) a += pe[i] * wc[(size_t)i * 64 + e];
    __syncthreads();
    red[part * 64 + e] = a;
    __syncthreads();
    if (tid < 64) {
      float s = 0.f;
      for (int q = 0; q < 8; ++q) s += red[q * 64 + tid];
      F32L(p, l)[(kv ? F_CV : F_CK) + tid] = s;
    }
    __syncthreads();
  }
  {
    float2* t64 = TAB64(p);
    float2* t32 = TAB32(p);
    for (size_t i = gtid; i < (size_t)4096 * 48; i += gsz) {
      int pos, idx;
      float inv;
      float2* dst;
      if (i < (size_t)4096 * 32) { pos = (int)(i >> 5); idx = (int)(i & 31); inv = powf(10000.f, -(float)idx / 32.f); dst = t64 + i; }
      else { size_t k = i - (size_t)4096 * 32; pos = (int)(k >> 4); idx = (int)(k & 15); inv = powf(10000.f, -(float)idx / 16.f); dst = t32 + k; }
      const float ang = (float)pos * inv;
      const float kq = rintf(ang * 0.15915494309189535f);
      float r = fmaf(-kq, 6.2831854820251465f, ang);
      r = fmaf(-kq, -1.7484555e-7f, r);
      *dst = make_float2(__cosf(r), __sinf(r));
    }
  }
  {
    const float* x = p.in[0];
    u16* xb = XB(p);
    for (size_t i = gtid; i < (size_t)T * D / 8; i += gsz) {
      const float* s8 = x + i * 8;
      float4 a, b;
      a.x = __builtin_nontemporal_load(s8); a.y = __builtin_nontemporal_load(s8 + 1); a.z = __builtin_nontemporal_load(s8 + 2); a.w = __builtin_nontemporal_load(s8 + 3);
      b.x = __builtin_nontemporal_load(s8 + 4); b.y = __builtin_nontemporal_load(s8 + 5); b.z = __builtin_nontemporal_load(s8 + 6); b.w = __builtin_nontemporal_load(s8 + 7);
      uint4 o; o.x = pack2(a.x, a.y); o.y = pack2(a.z, a.w); o.z = pack2(b.x, b.y); o.w = pack2(b.z, b.w);
      *(uint4*)(xb + i * 8) = o;
    }
    const float* mem = p.in[1];
    u16* mb = (u16*)(PWS(p) + WS_MEMB);
    for (size_t i = gtid; i < (size_t)BATCH * MEML * D / 8; i += gsz) {
      float4 a = *(const float4*)(mem + i * 8), b = *(const float4*)(mem + i * 8 + 4);
      uint4 o; o.x = pack2(a.x, a.y); o.y = pack2(a.z, a.w); o.z = pack2(b.x, b.y); o.w = pack2(b.z, b.w);
      *(uint4*)(mb + i * 8) = o;
    }
  }
}

template <class Toff, class Setup, class Epi>
DI void gemm256_stream(int tiles_per_xcd, int K, long ais, long akcs, long bis, Toff toff, Setup setup, Epi epi, char* smem) {
  constexpr int A_BYTES = 256 * 128, STAGE = 2 * A_BYTES;
  const int tid = otid(), lane = tid & 63, wave = tid >> 6, wm = wave >> 2, wn = wave & 3;
  const int lr = lane & 31, lh = lane >> 5, c8 = tid & 7, r0 = tid >> 3, swz = (r0 >> 1) & 7;
  const int xcd = blockIdx.x & 7, jb = blockIdx.x >> 3, nj = gridDim.x >> 3;
  int q = jb;
  if (q >= tiles_per_xcd) return;
  f32x16 acc[4][2];
#pragma unroll
  for (int ms = 0; ms < 4; ++ms)
#pragma unroll
    for (int ns = 0; ns < 2; ++ns)
#pragma unroll
      for (int i = 0; i < 16; ++i) acc[ms][ns][i] = 0.f;
  const u16 *Ac, *Bc, *An = nullptr, *Bn = nullptr;
  int aoff, boff;
  toff(r0, c8, aoff, boff);
  setup(xcd, q, Ac, Bc);
  uint4 ra0, ra1, ra2, ra3, rb0, rb1, rb2, rb3;
#define G256_GLOAD(Ap_, Bp_, kt_)                                 \
  {                                                               \
    const u16* ap_ = (Ap_) + aoff + (long)(kt_) * akcs;           \
    const u16* bp_ = (Bp_) + boff + (kt_) * 64;                   \
    ra0 = *(const uint4*)(ap_);                                   \
    ra1 = *(const uint4*)(ap_ + ais);                             \
    ra2 = *(const uint4*)(ap_ + 2 * ais);                         \
    ra3 = *(const uint4*)(ap_ + 3 * ais);                         \
    rb0 = *(const uint4*)(bp_);                                   \
    rb1 = *(const uint4*)(bp_ + bis);                             \
    rb2 = *(const uint4*)(bp_ + 2 * bis);                         \
    rb3 = *(const uint4*)(bp_ + 3 * bis);                         \
  }
#define G256_SSTORE(s_)                                                       \
  {                                                                           \
    char* base_ = smem + (s_) * STAGE + r0 * 128 + ((c8 ^ swz) << 4);         \
    *(uint4*)(base_) = ra0;                                                   \
    *(uint4*)(base_ + 64 * 128) = ra1;                                        \
    *(uint4*)(base_ + 2 * 64 * 128) = ra2;                                    \
    *(uint4*)(base_ + 3 * 64 * 128) = ra3;                                    \
    *(uint4*)(base_ + A_BYTES) = rb0;                                         \
    *(uint4*)(base_ + A_BYTES + 64 * 128) = rb1;                              \
    *(uint4*)(base_ + A_BYTES + 2 * 64 * 128) = rb2;                          \
    *(uint4*)(base_ + A_BYTES + 3 * 64 * 128) = rb3;                          \
  }
#define G256_ST1(s_, kk_, RA, RB)                                                                        \
  {                                                                                                        \
    char* base_ = smem + (s_) * STAGE + r0 * 128 + ((c8 ^ swz) << 4) + (kk_) * 64 * 128;                   \
    *(uint4*)(base_) = RA;                                                                                 \
    *(uint4*)(base_ + A_BYTES) = RB;                                                                       \
  }
#define G256_LD1(Ap_, Bp_, kt_, kk_, RA, RB)                                                               \
  {                                                                                                        \
    RA = *(const uint4*)((Ap_) + aoff + (long)(kt_) * akcs + (kk_) * ais);                                 \
    RB = *(const uint4*)((Bp_) + boff + (kt_) * 64 + (kk_) * bis);                                         \
  }
#define G256_KSTEP(kk, RA, RB)                                                                             \
  {                                                                                                        \
    bf16x8 af[4], bfr[2];                                                                                  \
    const int ch = kk * 2 + lh;                                                                            \
    _Pragma("unroll") for (int ms = 0; ms < 4; ++ms) {                                                     \
      const int row = wm * 128 + ms * 32 + lr;                                                             \
      af[ms] = *(const bf16x8*)(base + row * 128 + ((ch ^ ((row >> 1) & 7)) << 4));                        \
    }                                                                                                      \
    _Pragma("unroll") for (int ns = 0; ns < 2; ++ns) {                                                     \
      const int row = wn * 64 + ns * 32 + lr;                                                              \
      bfr[ns] = *(const bf16x8*)(base + A_BYTES + row * 128 + ((ch ^ ((row >> 1) & 7)) << 4));            \
    }                                                                                                      \
    if (have1) G256_ST1(s ^ 1, kk, RA, RB)                                                                 \
    if (have2) G256_LD1(Ap2, Bp2, kt2, kk, RA, RB)                                                         \
    __builtin_amdgcn_sched_barrier(0);                                                                     \
    _Pragma("unroll") for (int ms = 0; ms < 4; ++ms)                                                       \
      _Pragma("unroll") for (int ns = 0; ns < 2; ++ns) acc[ms][ns] = MFMA(af[ms], bfr[ns], acc[ms][ns]);   \
  }
  const int nk = K >> 6;
  __syncthreads();
  G256_GLOAD(Ac, Bc, 0)
  G256_SSTORE(0)
  G256_GLOAD(Ac, Bc, 1)
  __syncthreads();
  while (true) {
    const int qn = q + nj;
    const bool has_next = qn < tiles_per_xcd;
    if (has_next) setup(xcd, qn, An, Bn);
    for (int kt = 0; kt < nk; ++kt) {
      const int s = kt & 1;
      const bool have1 = (kt + 1 < nk) || has_next;
      const bool in_cur = (kt + 2 < nk);
      const bool have2 = in_cur || (has_next && kt + 2 == nk);
      const u16* Ap2 = in_cur ? Ac : An;
      const u16* Bp2 = in_cur ? Bc : Bn;
      const int kt2 = in_cur ? kt + 2 : kt + 2 - nk;
      const char* base = smem + s * STAGE;
      G256_KSTEP(0, ra0, rb0)
      G256_KSTEP(1, ra1, rb1)
      G256_KSTEP(2, ra2, rb2)
      G256_KSTEP(3, ra3, rb3)
      __syncthreads();
    }
    epi(xcd, q, acc);
#pragma unroll
    for (int ms = 0; ms < 4; ++ms)
#pragma unroll
      for (int ns = 0; ns < 2; ++ns)
#pragma unroll
        for (int i = 0; i < 16; ++i) acc[ms][ns][i] = 0.f;
    if (!has_next) break;
    q = qn;
    Ac = An;
    Bc = Bn;
    G256_GLOAD(Ac, Bc, 1)
  }
}
#define G256_IDS
#define G256_SETUP_IDS
#define G256_EPI_IDS                                                                          \
  const int tid = otid(), lane = tid & 63, wave = tid >> 6, wm = wave >> 2, wn = wave & 3;    \
  const int lr = lane & 31, lh = lane >> 5;                                                   \
  (void)wm; (void)wn; (void)lr; (void)lh;

DI void phase_ffn_up(const Params& p, const u16* w1t, const u16* w3t, char* smem) {
  G256_IDS
  const u16* xb = XB(p);
  u16* hb = BUF(p, B_H);
  constexpr int MPX = (T / 256) / 8;
  auto setup = [&](int xcd, int q, const u16*& Ap, const u16*& Bp) __attribute__((always_inline)) {
    G256_SETUP_IDS
    const int mt = xcd * MPX + (q / (4 * (FF / 128))) * 4 + (q & 3), nt = (q >> 2) % (FF / 128);
    Ap = xb + (size_t)mt * 256 * D;
    Bp = w1t + (size_t)nt * 128 * D;
  };
  const int w3off = (int)(w3t - w1t);
  auto toff = [&](int r0, int c8, int& aoff, int& boff) __attribute__((always_inline)) {
    aoff = r0 * D + c8 * 8;
    boff = ((r0 < 32) ? 0 : w3off) + (r0 & 31) * D + c8 * 8;
  };
  auto epi = [&](int xcd, int q, f32x16 (&acc)[4][2]) __attribute__((always_inline)) {
    G256_EPI_IDS
    const int mt = xcd * MPX + (q / (4 * (FF / 128))) * 4 + (q & 3), nt = (q >> 2) % (FF / 128);
#pragma unroll
    for (int ms = 0; ms < 4; ++ms)
#pragma unroll
      for (int i = 0; i < 16; ++i) {
        const size_t row = (size_t)mt * 256 + wm * 128 + ms * 32 + crow(i, lh);
        const int col = nt * 128 + wn * 32 + lr;
        const float a = acc[ms][0][i], b = acc[ms][1][i];
        __builtin_nontemporal_store(f2bf(a * sigmoidf(a) * b), &hb[row * FF + col]);
      }
  };
  gemm256_stream(MPX * (FF / 128), D, (long)64 * D, 64, (long)32 * D, toff, setup, epi, smem);
}

DI void phase_gemm_resid(const Params& p, const u16* A, int lda, int K, const u16* Bt, bool last_sub, float scl,
                         int row0, int nrows, char* smem) {
  G256_IDS
  u16* r16 = R16(p, last_sub);
  const u16* xres = XB(p);
  const int mpx = (nrows / 256) / 8;
  auto setup = [&](int xcd, int q, const u16*& Ap, const u16*& Bp) __attribute__((always_inline)) {
    G256_SETUP_IDS
    const int mt = xcd * mpx + (q >> 5) * 8 + (q & 7), nt = (q >> 3) & 3;
    Ap = A + (size_t)mt * 256 * lda;
    Bp = Bt + (size_t)nt * 256 * K;
  };
  auto toff = [&](int r0, int c8, int& aoff, int& boff) __attribute__((always_inline)) {
    aoff = r0 * lda + c8 * 8;
    boff = r0 * K + c8 * 8;
  };
  auto epi = [&](int xcd, int q, f32x16 (&acc)[4][2]) __attribute__((always_inline)) {
    G256_EPI_IDS
    const int mt = xcd * mpx + (q >> 5) * 8 + (q & 7), nt = (q >> 3) & 3;
#pragma unroll
    for (int ms = 0; ms < 4; ++ms)
#pragma unroll
      for (int ns = 0; ns < 2; ++ns)
#pragma unroll
        for (int i = 0; i < 16; ++i) {
          const size_t row = (size_t)row0 + mt * 256 + wm * 128 + ms * 32 + crow(i, lh);
          const int col = nt * 256 + wn * 64 + ns * 32 + lr;
          __builtin_nontemporal_store(__builtin_bit_cast(u16, (_Float16)(ALPHA * bf2f(xres[row * D + col]) + scl * acc[ms][ns][i])), &r16[row * D + col]);
        }
  };
  gemm256_stream(mpx * 4, K, (long)64 * lda, 64, (long)64 * K, toff, setup, epi, smem);
}

DI void phase_ln(const Params& p, const float* g, const float* b, bool final_ln) {
  const int tid_ = otid(); const int lane = tid_ & 63, wave = tid_ >> 6;
  float* X = (float*)launder((char*)p.out);
  const u16* r16 = R16(p, final_ln);
  u16* xb = XB(p);
  float4 gg[4], bb[4];
#pragma unroll
  for (int i = 0; i < 4; ++i) { gg[i] = *(const float4*)(g + i * 256 + lane * 4); bb[i] = *(const float4*)(b + i * 256 + lane * 4); }
  for (int row = blockIdx.x * 8 + wave; row < T; row += gridDim.x * 8) {
    float* xr = X + (size_t)row * D;
    float4 v[4];
    float s = 0.f;
#pragma unroll
    for (int i = 0; i < 4; ++i) {
      const unsigned long long raw = __builtin_nontemporal_load((const unsigned long long*)(r16 + (size_t)row * D + i * 256 + lane * 4));
      v[i].x = (float)__builtin_bit_cast(_Float16, (u16)(raw & 0xffffu));
      v[i].y = (float)__builtin_bit_cast(_Float16, (u16)((raw >> 16) & 0xffffu));
      v[i].z = (float)__builtin_bit_cast(_Float16, (u16)((raw >> 32) & 0xffffu));
      v[i].w = (float)__builtin_bit_cast(_Float16, (u16)(raw >> 48));
      s += v[i].x + v[i].y + v[i].z + v[i].w;
    }
    const float mean = wave_sum(s) * (1.f / D);
    float q = 0.f;
#pragma unroll
    for (int i = 0; i < 4; ++i) {
      v[i].x -= mean; v[i].y -= mean; v[i].z -= mean; v[i].w -= mean;
      q += v[i].x * v[i].x + v[i].y * v[i].y + v[i].z * v[i].z + v[i].w * v[i].w;
    }
    const float rstd = rsqrtf(wave_sum(q) * (1.f / D) + 1e-5f);
#pragma unroll
    for (int i = 0; i < 4; ++i) {
      float4 o;
      o.x = v[i].x * rstd * gg[i].x + bb[i].x; o.y = v[i].y * rstd * gg[i].y + bb[i].y;
      o.z = v[i].z * rstd * gg[i].z + bb[i].z; o.w = v[i].w * rstd * gg[i].w + bb[i].w;
      if (final_ln) *(float4*)(xr + i * 256 + lane * 4) = o;
      uint2 pk; pk.x = pack2(o.x, o.y); pk.y = pack2(o.z, o.w);
      *(uint2*)(xb + (size_t)row * D + i * 256 + lane * 4) = pk;
    }
  }
}

DI void phase_m1(const Params& p, int l, int grp, char* smem) {
  G256_IDS
  const u16* xb = XB(p) + (size_t)grp * TG * D;
  const u16* wt = WTS(p, l) + W_IN;
  const float* bz = F32L(p, l) + F_BZ;
  u16* z = BUF(p, B_Z);
  u16* vst = BUF(p, B_VST);
  u16* vwt = BUF(p, B_VWT);
  const float2* t64 = TAB64(p);
  const float2* t32 = TAB32(p);
  constexpr int MPX = (TG / 256) / 8, NT = ZW / 256;
  auto setup = [&](int xcd, int q, const u16*& Ap, const u16*& Bp) __attribute__((always_inline)) {
    G256_SETUP_IDS
    const int mt = xcd * MPX + q % MPX, nt = q / MPX;
    Ap = xb + (size_t)mt * 256 * D;
    Bp = wt + (size_t)nt * 256 * D;
  };
  auto toff = [&](int r0, int c8, int& aoff, int& boff) __attribute__((always_inline)) {
    aoff = r0 * D + c8 * 8;
    boff = r0 * D + c8 * 8;
  };
  auto epi = [&](int xcd, int q, f32x16 (&acc)[4][2]) __attribute__((always_inline)) {
    G256_EPI_IDS
    const int mt = xcd * MPX + q % MPX, nt = q / MPX;
    const int cb0 = nt * 256 + wn * 64;
    const int sec = cb0 >> 7, kvg = (cb0 >> 6) & 1;
    const float bias0 = bz[cb0 + lr], bias1 = bz[cb0 + 32 + lr];
    const bool rope64 = (sec >= 23 && sec < 27) || sec == 29 || sec == 31;
    const bool vtr = (sec == 30) || (sec == 32);
    if (vtr) {
      u16* vt = (sec == 30) ? vst : vwt;
#pragma unroll
      for (int ms = 0; ms < 4; ++ms)
#pragma unroll
        for (int ns = 0; ns < 2; ++ns)
#pragma unroll
          for (int gq = 0; gq < 4; ++gq) {
            const int row = mt * 256 + wm * 128 + ms * 32 + 8 * gq + 4 * lh;
            const int bl = row >> 12, s = row & 4095;
            const int dv = ns * 32 + lr;
            const float bs = ns ? bias1 : bias0;
            uint2 pk;
            pk.x = pack2(acc[ms][ns][4 * gq] + bs, acc[ms][ns][4 * gq + 1] + bs);
            pk.y = pack2(acc[ms][ns][4 * gq + 2] + bs, acc[ms][ns][4 * gq + 3] + bs);
            *(uint2*)(vt + ((size_t)(bl * 2 + kvg) * 64 + dv) * SEQ + s) = pk;
          }
    } else if (rope64) {
#pragma unroll
      for (int ms = 0; ms < 4; ++ms)
#pragma unroll
        for (int i = 0; i < 16; ++i) {
          const int row = mt * 256 + wm * 128 + ms * 32 + crow(i, lh);
          const int pos = row & 4095;
          const float2 cs = t64[pos * 32 + lr];
          const float x1 = acc[ms][0][i] + bias0, x2 = acc[ms][1][i] + bias1;
          z[(size_t)row * ZW + cb0 + lr] = f2bf(x1 * cs.x - x2 * cs.y);
          z[(size_t)row * ZW + cb0 + 32 + lr] = f2bf(x1 * cs.y + x2 * cs.x);
        }
    } else {
      const bool rope32 = (cb0 == ZC_KROPE);
#pragma unroll
      for (int ms = 0; ms < 4; ++ms)
#pragma unroll
        for (int ns = 0; ns < 2; ++ns)
#pragma unroll
          for (int i = 0; i < 16; ++i) {
            const int row = mt * 256 + wm * 128 + ms * 32 + crow(i, lh);
            float v = acc[ms][ns][i] + (ns ? bias1 : bias0);
            if (rope32 && ns == 0) {
              const float pr = __shfl_xor(v, 16);
              const float2 cs = t32[(row & 4095) * 16 + (lr & 15)];
              v = (lr < 16) ? (v * cs.x - pr * cs.y) : (pr * cs.y + v * cs.x);
            }
            z[(size_t)row * ZW + cb0 + ns * 32 + lr] = f2bf(v);
          }
    }
  };
  gemm256_stream(MPX * NT, D, (long)64 * D, 64, (long)64 * D, toff, setup, epi, smem);
}

DI void m2_gmlp_ln(const Params& p, int l, int chunk, char* smem) {
  const int tid = otid(), s = tid & 127, cgi = tid >> 7;
  const u16* z = BUF(p, B_Z);
  u16* vl = BUF(p, B_VLNT);
  const float* lg = p.in[9] + (size_t)l * 512 + cgi * 128;
  const float* lb = p.in[10] + (size_t)l * 512 + cgi * 128;
  float* red = (float*)smem;
  const u16* src = z + (size_t)(chunk * 128 + s) * ZW + ZC_V + cgi * 128;
  uint4 v[16];
  float sm = 0.f, sq = 0.f;
#pragma unroll
  for (int i = 0; i < 16; ++i) {
    v[i] = *(const uint4*)(src + i * 8);
    const unsigned w[4] = {v[i].x, v[i].y, v[i].z, v[i].w};
#pragma unroll
    for (int e = 0; e < 4; ++e) {
      const float a = __uint_as_float(w[e] << 16), b = __uint_as_float(w[e] & 0xffff0000u);
      sm += a + b; sq += a * a + b * b;
    }
  }
  __syncthreads();
  red[cgi * 128 + s] = sm;
  red[512 + cgi * 128 + s] = sq;
  __syncthreads();
  const float ts = red[s] + red[128 + s] + red[256 + s] + red[384 + s];
  const float tq = red[512 + s] + red[640 + s] + red[768 + s] + red[896 + s];
  const float mean = ts * (1.f / 512.f);
  const float var = fmaxf(tq * (1.f / 512.f) - mean * mean, 0.f);
  const float rstd = rsqrtf(var + 1e-5f);
  u16* dst = vl + ((size_t)cgi * TG + (size_t)chunk * 128) * 128 + s;
#pragma unroll
  for (int i = 0; i < 16; ++i) {
    const unsigned w[4] = {v[i].x, v[i].y, v[i].z, v[i].w};
#pragma unroll
    for (int e = 0; e < 4; ++e) {
      const float a = __uint_as_float(w[e] << 16), b = __uint_as_float(w[e] & 0xffff0000u);
      const int d0 = i * 8 + e * 2;
      dst[(size_t)d0 * 128] = f2bf((a - mean) * rstd * lg[d0] + lb[d0]);
      dst[(size_t)(d0 + 1) * 128] = f2bf((b - mean) * rstd * lg[d0 + 1] + lb[d0 + 1]);
    }
  }
  __syncthreads();
}

DI void m2_conv(const Params& p, int l, int item) {
  const int tid = otid();
  const u16* z = BUF(p, B_Z);
  u16* P = BUF(p, B_P);
  const float* cw = p.in[14] + (size_t)l * 3 * 512;
#pragma unroll 1
  for (int i = 0; i < 8; ++i) {
    const int vi = tid + 512 * i, tok = item * 64 + (vi >> 6), c0 = (vi & 63) * 8;
    const int s = tok & 4095;
    float y[8];
#pragma unroll
    for (int e = 0; e < 8; ++e) y[e] = 0.f;
#pragma unroll
    for (int k = 0; k < 3; ++k) {
      if (s - 2 + k >= 0) {
        const u16* zr = z + (size_t)(tok - 2 + k) * ZW;
        const uint4 c = *(const uint4*)(zr + ZC_CC + c0), h = *(const uint4*)(zr + ZC_CH + c0);
        const unsigned cwd[4] = {c.x, c.y, c.z, c.w}, hwd[4] = {h.x, h.y, h.z, h.w};
#pragma unroll
        for (int e = 0; e < 4; ++e) {
          const float c_lo = __uint_as_float(cwd[e] << 16), c_hi = __uint_as_float(cwd[e] & 0xffff0000u);
          const float h_lo = __uint_as_float(hwd[e] << 16), h_hi = __uint_as_float(hwd[e] & 0xffff0000u);
          y[2 * e] += c_lo * h_lo * cw[k * 512 + c0 + 2 * e];
          y[2 * e + 1] += c_hi * h_hi * cw[k * 512 + c0 + 2 * e + 1];
        }
      }
    }
    const uint4 b = *(const uint4*)(z + (size_t)tok * ZW + ZC_CB + c0);
    const unsigned bwd[4] = {b.x, b.y, b.z, b.w};
    uint4 o;
    unsigned ow[4];
#pragma unroll
    for (int e = 0; e < 4; ++e)
      ow[e] = pack2(__uint_as_float(bwd[e] << 16) * y[2 * e], __uint_as_float(bwd[e] & 0xffff0000u) * y[2 * e + 1]);
    o.x = ow[0]; o.y = ow[1]; o.z = ow[2]; o.w = ow[3];
    *(uint4*)(P + (size_t)tok * 2048 + 512 + c0) = o;
  }
}

constexpr int RS_OFF = 132 * 1024;
template <int W>
DI void row_rstd(const u16* z, int m0, int c0, char* smem) {
  const int tid = otid(), r = tid >> 1, hf = tid & 1;
  const u16* src = z + (size_t)(m0 + r) * ZW + c0 + hf * (W / 2);
  float sq = 0.f;
#pragma unroll
  for (int i = 0; i < W / 16; ++i) {
    const uint4 v = *(const uint4*)(src + i * 8);
    const unsigned w[4] = {v.x, v.y, v.z, v.w};
#pragma unroll
    for (int e = 0; e < 4; ++e) {
      const float a = __uint_as_float(w[e] << 16), b = __uint_as_float(w[e] & 0xffff0000u);
      sq += a * a + b * b;
    }
  }
  sq += __shfl_xor(sq, 1);
  __syncthreads();
  if (hf == 0) ((float*)(smem + RS_OFF))[r] = rsqrtf(sq * (1.f / W) + 1e-6f);
  __syncthreads();
}

DI void m2_mla_q(const Params& p, int l, int mt, int nt, char* smem) {
  EPI_IDS
  const u16* z = BUF(p, B_Z);
  u16* qb = BUF(p, B_QB);
  const float2* t32 = TAB32(p);
  row_rstd<256>(z, mt * 256, ZC_QLAT, smem);
  f32x16 acc[1][2][2];
  gemm_core<1, 2>(acc, z + (size_t)mt * 256 * ZW + ZC_QLAT, ZW, 64, WTS(p, l) + W_UQ + (size_t)nt * 128 * 256, nullptr, 256, 256, smem);
  const float* rs = (const float*)(smem + RS_OFF);
#pragma unroll
  for (int ms = 0; ms < 2; ++ms)
#pragma unroll
    for (int ns = 0; ns < 2; ++ns) {
      const int cbase = nt * 128 + wn * 64 + ns * 32;
      const bool rope = ((cbase >> 5) % 3) == 2;
#pragma unroll
      for (int i = 0; i < 16; ++i) {
        const int rl = wm * 64 + ms * 32 + crow(i, lh), row = mt * 256 + rl;
        float v = acc[0][ms][ns][i] * rs[rl];
        if (rope) {
          const float pr = __shfl_xor(v, 16);
          const float2 cs = t32[(row & 4095) * 16 + (lr & 15)];
          v = (lr < 16) ? (v * cs.x - pr * cs.y) : (pr * cs.y + v * cs.x);
        }
        qb[(size_t)row * 768 + cbase + lr] = f2bf(v);
      }
    }
}

DI void m2_mla_kv(const Params& p, int l, int mt, int nt, char* smem) {
  EPI_IDS
  const u16* z = BUF(p, B_Z);
  u16* kb = BUF(p, B_KB);
  u16* vt = BUF(p, B_VT);
  row_rstd<128>(z, mt * 256, ZC_KVLAT, smem);
  f32x16 acc[1][2][2];
  gemm_core<1, 2>(acc, z + (size_t)mt * 256 * ZW + ZC_KVLAT, ZW, 64, WTS(p, l) + W_UKV + (size_t)nt * 128 * 128, nullptr, 128, 128, smem);
  const float* rs = (const float*)(smem + RS_OFF);
  if (wn == 0) {
#pragma unroll
    for (int ms = 0; ms < 2; ++ms)
#pragma unroll
      for (int ns = 0; ns < 2; ++ns)
#pragma unroll
        for (int i = 0; i < 16; ++i) {
          const int rl = wm * 64 + ms * 32 + crow(i, lh), row = mt * 256 + rl;
          kb[(size_t)row * 768 + nt * 96 + ns * 32 + lr] = f2bf(acc[0][ms][ns][i] * rs[rl]);
        }
  } else {
#pragma unroll
    for (int ms = 0; ms < 2; ++ms)
#pragma unroll
      for (int ns = 0; ns < 2; ++ns)
#pragma unroll
        for (int gq = 0; gq < 4; ++gq) {
          const int rl = wm * 64 + ms * 32 + 8 * gq + 4 * lh, row = mt * 256 + rl;
          const int bl = row >> 12, s = row & 4095, dv = ns * 32 + lr;
          uint2 pk;
          pk.x = pack2(acc[0][ms][ns][4 * gq] * rs[rl], acc[0][ms][ns][4 * gq + 1] * rs[rl + 1]);
          pk.y = pack2(acc[0][ms][ns][4 * gq + 2] * rs[rl + 2], acc[0][ms][ns][4 * gq + 3] * rs[rl + 3]);
          *(uint2*)(vt + ((size_t)(bl * 8 + nt) * 64 + dv) * SEQ + s) = pk;
        }
  }
#pragma unroll
  for (int i = 0; i < 2; ++i) {
    const int ci = tid + 512 * i, r = ci >> 2, c = ci & 3;
    const size_t row = (size_t)mt * 256 + r;
    *(uint4*)(kb + row * 768 + nt * 96 + 64 + c * 8) = *(const uint4*)(z + row * ZW + ZC_KROPE + c * 8);
  }
}

DI void m2_uv(const Params& p, int l, int it, char* smem) {
  EPI_IDS
  const int kv = it >> 3, g = (it >> 2) & 1, mt = it & 3;
  const u16* z = BUF(p, B_Z);
  float* uv = (float*)(PWS(p) + WS_BIG + B_UV) + ((size_t)(kv * 2 + g) * (TG / 16)) * 128;
  f32x16 acc[1][2][2];
  gemm_core<1, 2>(acc, z + (size_t)mt * 256 * 16 * ZW + (kv ? ZC_NVC : ZC_NKC) + g * 64, (long)16 * ZW, ZW,
                  WTS(p, l) + (kv ? W_CV : W_CK), nullptr, 1024, 1024, smem);
#pragma unroll
  for (int ms = 0; ms < 2; ++ms)
#pragma unroll
    for (int ns = 0; ns < 2; ++ns)
#pragma unroll
      for (int i = 0; i < 16; ++i) {
        const int seg = mt * 256 + wm * 64 + ms * 32 + crow(i, lh), col = wn * 64 + ns * 32 + lr;
        uv[(size_t)seg * 128 + col] = acc[0][ms][ns][i];
      }
}

DI void m2_xkv(const Params& p, int l, int it, char* smem) {
  EPI_IDS
  const int mt = it >> 3, nt = it & 7;
  const u16* mb = (const u16*)(PWS(p) + WS_MEMB);
  u16* kx = (u16*)(PWS(p) + WS_KX);
  u16* vxt = (u16*)(PWS(p) + WS_VXT);
  f32x16 acc[1][2][2];
  gemm_core<1, 2>(acc, mb + (size_t)mt * 256 * D, D, 64, WTS(p, l) + W_XKV + (size_t)nt * 128 * D, nullptr, D, D, smem);
  if (nt < 4) {
#pragma unroll
    for (int ms = 0; ms < 2; ++ms)
#pragma unroll
      for (int ns = 0; ns < 2; ++ns)
#pragma unroll
        for (int i = 0; i < 16; ++i) {
          const size_t row = (size_t)mt * 256 + wm * 64 + ms * 32 + crow(i, lh);
          kx[row * 512 + nt * 128 + wn * 64 + ns * 32 + lr] = f2bf(acc[0][ms][ns][i]);
        }
  } else {
    const int hx = nt - 4;
#pragma unroll
    for (int ms = 0; ms < 2; ++ms)
#pragma unroll
      for (int ns = 0; ns < 2; ++ns)
#pragma unroll
        for (int gq = 0; gq < 4; ++gq) {
          const int mrow = wm * 64 + ms * 32 + 8 * gq + 4 * lh;
          const int dv = wn * 64 + ns * 32 + lr;
          uint2 pk;
          pk.x = pack2(acc[0][ms][ns][4 * gq], acc[0][ms][ns][4 * gq + 1]);
          pk.y = pack2(acc[0][ms][ns][4 * gq + 2], acc[0][ms][ns][4 * gq + 3]);
          *(uint2*)(vxt + ((size_t)(mt * 4 + hx) * 128 + dv) * MEML + mrow) = pk;
        }
  }
}

constexpr int M2_NQ = (TG / 256) * 6, M2_NKV = (TG / 256) * 8, M2_NUV = 16, M2_NLN = TG / 128, M2_NCONV = TG / 64;
DI void phase_m2(const Params& p, int l, int grp, char* smem) {
  constexpr int TOT = M2_NKV + M2_NQ + M2_NUV + M2_NLN + M2_NCONV;
  const int nx = (grp == 0) ? 64 : 0;
  for (int t = blockIdx.x; t < TOT + nx; t += gridDim.x) {
    int it = t;
    if (it >= TOT) { m2_xkv(p, l, it - TOT, smem); continue; }
    if (it < M2_NUV) { m2_uv(p, l, it, smem); continue; }
    it -= M2_NUV;
    if (it < M2_NQ) { m2_mla_q(p, l, it / 6, it % 6, smem); continue; }
    it -= M2_NQ;
    if (it < M2_NKV) { m2_mla_kv(p, l, it >> 3, it & 7, smem); continue; }
    it -= M2_NKV;
    if (it < M2_NLN) { m2_gmlp_ln(p, l, it, smem); continue; }
    it -= M2_NLN;
    m2_conv(p, l, it);
  }
}

template <int DK, int DV>
struct FA {
  static constexpr int KSTR = DK * 2 + 16, VSTR = 144, KBYTES = 64 * KSTR, VBYTES = DV * VSTR, STAGE = KBYTES + VBYTES;
  static constexpr int KCH = 64 * DK / 8, VCH = DV * 8, KN = (KCH + 511) / 512, VN = (VCH + 511) / 512;
};
template <int DK, int DV, int MODE>
DI bool fa_active(int kb, int wave_qmax, unsigned long long sel) {
  bool active = true;
  if (MODE != 0) active = (kb * 64 <= wave_qmax);
  if (MODE == 2) {
    const bool selbit = (sel >> kb) & 1ull;
    if (__ballot(selbit) == 0ull) active = false;
  }
  return active;
}
template <int DK, int DV, int MODE>
DI void fa_qk(f32x16 (&S)[2], const bf16x8 (&q)[DK / 16], const char* base, int lr, int lh) {
  using C = FA<DK, DV>;
  __builtin_amdgcn_s_setprio(1);
#pragma unroll
  for (int ks = 0; ks < 2; ++ks) {
#pragma unroll
    for (int kk = 0; kk < DK / 16; ++kk) {
      const bf16x8 kf = *(const bf16x8*)(base + (ks * 32 + lr) * C::KSTR + (kk * 2 + lh) * 16);
      if (kk == 0) {
#pragma unroll
        for (int i = 0; i < 16; ++i) S[ks][i] = 0.f;
      }
      S[ks] = MFMA(kf, q[kk], S[ks]);
    }
  }
  __builtin_amdgcn_s_setprio(0);
}
template <int DK, int DV, int MODE>
DI void fa_softmax_pv(f32x16 (&S)[2], float& m, float& l, f32x16 (&O)[DV / 32], float scale, const char* base, int kb,
                      int qpos, int wave_qmax, unsigned long long sel, int lr, int lh, int variant = 0) {
  using C = FA<DK, DV>;
  bool selbit = true;
  bool need_mask = false;
  if (MODE != 0) need_mask = (kb * 64 + 63 > wave_qmax - 31);
  if (MODE == 2) selbit = (sel >> kb) & 1ull;
  if (MODE == 3) need_mask = need_mask || (kb * 64 <= wave_qmax - 512);
  const float c2 = scale * 1.4426950408889634f;
  if (need_mask) {
#pragma unroll
    for (int ks = 0; ks < 2; ++ks)
#pragma unroll
      for (int i = 0; i < 16; ++i) {
        const int key = kb * 64 + ks * 32 + crow(i, lh);
        bool valid = key <= qpos;
        if (MODE == 2) valid = valid && selbit;
        if (MODE == 3) valid = valid && (qpos - key < 512);
        S[ks][i] = valid ? S[ks][i] : -1e30f;
      }
  }
  float mx = fmaxf(S[0][0], S[0][1]);
#pragma unroll
  for (int ks = 0; ks < 2; ++ks)
#pragma unroll
    for (int i = (ks ? 0 : 2); i < 16; i += 2) mx = fmaxf(fmaxf(mx, S[ks][i]), S[ks][i + 1]);
  mx = fmaxf(mx, __shfl_xor(mx, 32));
  if (MODE == 2) mx = selbit ? mx : -1e30f;
  const float mn = fmaxf(m, mx);
  if (__any((mn - m) * c2 > 8.f)) {
    const float alpha = __builtin_amdgcn_exp2f((m - mn) * c2);
    m = mn;
    l *= alpha;
#pragma unroll
    for (int d = 0; d < DV / 32; ++d) O[d] = O[d] * alpha;
  }
  float mc = m * c2;
  if (MODE == 2) mc = selbit ? mc : 1e30f;
  const f32x2v c2v = {c2, c2}, mcv = {-mc, -mc};
  f32x2v rs2 = {0.f, 0.f};
#pragma unroll
  for (int ks = 0; ks < 2; ++ks)
#pragma unroll
    for (int st = 0; st < 2; ++st) {
      union { unsigned u[4]; bf16x8 v; } pf;
#pragma unroll
      for (int j = 0; j < 4; ++j) {
        const int i0 = 8 * st + 2 * j;
        f32x2v t = {S[ks][i0], S[ks][i0 + 1]};
        t = __builtin_elementwise_fma(t, c2v, mcv);
        f32x2v pv;
        if (variant == 1) { pv = t; } else {
        pv.x = __builtin_amdgcn_exp2f(t.x);
        pv.y = __builtin_amdgcn_exp2f(t.y);
        }
        if (MODE != 0) {
          if (need_mask) {
            pv.x = (S[ks][i0] > -1e29f) ? pv.x : 0.f;
            pv.y = (S[ks][i0 + 1] > -1e29f) ? pv.y : 0.f;
          }
        }
        rs2 += pv;
        pf.u[j] = __builtin_bit_cast(unsigned, __builtin_convertvector(pv, hwbf16x2));
      }
#pragma unroll
      for (int d = 0; d < DV / 32; ++d) {
        const char* vp = base + C::KBYTES + (d * 32 + lr) * C::VSTR + (ks * 32 + 16 * st + 4 * lh) * 2;
        const s16x4 lo = *(const s16x4*)vp, hi = *(const s16x4*)(vp + 16);
        const bf16x8 vf = __builtin_shufflevector(lo, hi, 0, 1, 2, 3, 4, 5, 6, 7);
        O[d] = MFMA(vf, pf.v, O[d]);
      }
    }
  float rs = rs2.x + rs2.y;
  rs += __shfl_xor(rs, 32);
  l += rs;
}

template <int N> DI void wait_vmcnt() { asm volatile("s_waitcnt vmcnt(%0)" ::"n"(N) : "memory"); }
DI void raw_barrier() {
  asm volatile("s_waitcnt lgkmcnt(0)" ::: "memory");
  __builtin_amdgcn_s_barrier();
  asm volatile("" ::: "memory");
}
template <int DK, int DV, int MODE>
DI void flash_loop(float& m, float& l, f32x16 (&O)[DV / 32], const bf16x8 (&q)[DK / 16], float scale,
                   const u16* __restrict__ Kp, long ldk, const u16* __restrict__ VTp, long ldvt, int kb0, int kb1,
                   int qpos, int wave_qmax, unsigned long long sel, char* smem, int variant = 0) {
  using C = FA<DK, DV>;
  constexpr int KC = C::KSTR / 16, NCH = C::STAGE / 16, NW = NCH / 64, NI = (NW + 7) / 8;
  constexpr int NST = (C::STAGE * 4 <= 100 * 1024) ? 4 : 3;
  static_assert(NCH % 64 == 0 && (64 * KC) % 64 == 0 && NI <= 5, "piece layout");
  const int tid = otid(), lane = tid & 63, wave = tid >> 6, lr = lane & 31, lh = lane >> 5;
  const int ntile = kb1 - kb0;
  __syncthreads();
  if (ntile <= 0) return;
  const u16* src[5];
  long stp[5];
  int ldo[5];
#pragma unroll
  for (int i = 0; i < 5; ++i) {
    src[i] = Kp; stp[i] = 0; ldo[i] = 0;
    if (i < NI) {
      int w_ = i * 8 + wave;
      if (w_ > NW - 1) w_ = NW - 1;
      const int L = w_ * 64 + lane;
      if (w_ < KC) {
        const int row = L / KC;
        int c = L % KC;
        if (c > DK / 8 - 1) c = DK / 8 - 1;
        src[i] = Kp + (long)(kb0 * 64 + row) * ldk + c * 8;
        stp[i] = 64 * ldk;
      } else {
        const int L2 = L - 64 * KC, row = L2 / 9;
        int c = L2 % 9;
        if (c > 7) c = 7;
        src[i] = VTp + (long)row * ldvt + kb0 * 64 + c * 8;
        stp[i] = 64;
      }
      ldo[i] = w_ * 1024;
    }
  }
#define FA_ISSUE(t_, stage_)                                                                              \
  {                                                                                                       \
    _Pragma("unroll") for (int i = 0; i < NI; ++i)                                                        \
        __builtin_amdgcn_global_load_lds((const unsigned*)(src[i] + (long)(t_) * stp[i]),                 \
                                         (unsigned*)(smem + (stage_) * C::STAGE + ldo[i]), 16, 0, 0);      \
  }
  asm volatile("s_waitcnt vmcnt(0)" ::: "memory");
#pragma unroll
  for (int t = 0; t < NST - 1; ++t)
    if (t < ntile) FA_ISSUE(t, t)
  int stage = 0;
  for (int t = 0; t < ntile; ++t) {
    int ahead = ((ntile < t + NST - 1) ? ntile : t + NST - 1) - (t + 1);
    if (NST == 4 && ahead >= 2) wait_vmcnt<2 * NI>();
    else if (ahead >= 1) wait_vmcnt<NI>();
    else wait_vmcnt<0>();
    raw_barrier();
    if (t + NST - 1 < ntile) {
      const int sn = (stage == 0) ? NST - 1 : stage - 1;
      FA_ISSUE(t + NST - 1, sn)
    }
    const int kb = kb0 + t;
    if (fa_active<DK, DV, MODE>(kb, wave_qmax, sel)) {
      f32x16 S[2];
      const char* base = smem + stage * C::STAGE;
      fa_qk<DK, DV, MODE>(S, q, base, lr, lh);
      fa_softmax_pv<DK, DV, MODE>(S, m, l, O, scale, base, kb, qpos, wave_qmax, sel, lr, lh, variant);
    }
    stage = (stage == NST - 1) ? 0 : stage + 1;
  }
  raw_barrier();
}

DI void mla_item(const Params& p, int bl, int h, int qt, char* smem, int variant = 0) {
  const int tid = otid(), lane = tid & 63, wave = tid >> 6, lr = lane & 31, lh = lane >> 5;
  const u16* qb = BUF(p, B_QB);
  const u16* kb = BUF(p, B_KB);
  const u16* vt = BUF(p, B_VT);
  u16* P = BUF(p, B_P);
  const int wq0 = qt * 256 + wave * 32, qpos = wq0 + lr;
  const size_t tok = (size_t)bl * SEQ + qpos;
  bf16x8 q[6];
#pragma unroll
  for (int kk = 0; kk < 6; ++kk) q[kk] = *(const bf16x8*)(qb + tok * 768 + h * 96 + kk * 16 + lh * 8);
  float m = -1e30f, l = 0.f;
  f32x16 O[2];
#pragma unroll
  for (int d = 0; d < 2; ++d)
#pragma unroll
    for (int i = 0; i < 16; ++i) O[d][i] = 0.f;
  flash_loop<96, 64, 1>(m, l, O, q, 0.10206207261596577f, kb + (size_t)bl * SEQ * 768 + h * 96, 768,
                        vt + ((size_t)(bl * 8 + h) * 64) * SEQ, SEQ, 0, 4 * (qt + 1), qpos, wq0 + 31, 0ull, smem, variant);
  if (variant != 0 && l > -1e38f) return;
  const float inv = 1.f / l;
#pragma unroll
  for (int d = 0; d < 2; ++d)
#pragma unroll
    for (int gq = 0; gq < 4; ++gq) {
      uint2 pk;
      pk.x = pack2(O[d][4 * gq] * inv, O[d][4 * gq + 1] * inv);
      pk.y = pack2(O[d][4 * gq + 2] * inv, O[d][4 * gq + 3] * inv);
      *(uint2*)(P + tok * 2048 + 1024 + h * 64 + d * 32 + 8 * gq + 4 * lh) = pk;
    }
}

constexpr int NSA_KC_OFF = 0, NSA_VC_OFF = 36864, NSA_IMP_OFF = 36864 + 33792, NSA_SEL_OFF = 137216;
constexpr int VCSTR = 528;
DI void nsa_item(const Params& p, int l, int bl, int g, int jq, char* smem) {
  const int tid = otid(), lane = tid & 63, wave = tid >> 6, lr = lane & 31, lh = lane >> 5;
  const int hh = wave & 3, qs = wave >> 2;
  const int q0 = jq * 64, qloc = qs * 32 + lr, qpos = q0 + qloc;
  const int head = g * 4 + hh;
  const size_t tokbase = (size_t)bl * SEQ;
  const u16* z = BUF(p, B_Z);
  u16* P = BUF(p, B_P);
  const float scale = 0.125f;
  char* sKc = smem + NSA_KC_OFF;
  char* sVc = smem + NSA_VC_OFF;
  float* sImp = (float*)(smem + NSA_IMP_OFF);
  unsigned char* sSel = (unsigned char*)(smem + NSA_SEL_OFF);

  bf16x8 q[4];
#pragma unroll
  for (int kk = 0; kk < 4; ++kk) q[kk] = *(const bf16x8*)(z + (tokbase + qpos) * ZW + ZC_NQ + head * 64 + kk * 16 + lh * 8);

  const int ncnt = min(255, (q0 + 32) / 16 + 1);
  const int ntile = (ncnt + 63) >> 6;
  __syncthreads();
  {
    const float* uvb = (const float*)(PWS(p) + WS_BIG + B_UV);
    const float* UVk = uvb + ((size_t)(0 * 2 + g) * (TG / 16) + (size_t)bl * 256) * 128;
    const float* UVv = uvb + ((size_t)(1 * 2 + g) * (TG / 16) + (size_t)bl * 256) * 128;
    const float* ck = F32L(p, l) + F_CK;
    const float* cv = F32L(p, l) + F_CV;
    const float2* t64 = TAB64(p);
    for (int idx = tid; idx < ntile * 64 * 32; idx += NTHREADS) {
      const int n = idx >> 5, e = idx & 31;
      float r1 = 0.f, r2 = 0.f, v1 = 0.f, v2 = 0.f;
      if (n < 255) {
        const float k1 = UVk[n * 128 + e] + UVk[(n + 1) * 128 + 64 + e] + ck[e];
        const float k2 = UVk[n * 128 + e + 32] + UVk[(n + 1) * 128 + 96 + e] + ck[e + 32];
        v1 = UVv[n * 128 + e] + UVv[(n + 1) * 128 + 64 + e] + cv[e];
        v2 = UVv[n * 128 + e + 32] + UVv[(n + 1) * 128 + 96 + e] + cv[e + 32];
        const float2 cs = t64[(16 * n + 31) * 32 + e];
        r1 = k1 * cs.x - k2 * cs.y;
        r2 = k1 * cs.y + k2 * cs.x;
      }
      *(u16*)(sKc + n * 144 + e * 2) = f2bf(r1);
      *(u16*)(sKc + n * 144 + (e + 32) * 2) = f2bf(r2);
      *(u16*)(sVc + e * VCSTR + n * 2) = f2bf(v1);
      *(u16*)(sVc + (e + 32) * VCSTR + n * 2) = f2bf(v2);
    }
    for (int idx = tid; idx < 4 * 64 * 65; idx += NTHREADS) sImp[idx] = 0.f;
  }
  __syncthreads();

  float mc = -1e30f, lc = 0.f;
#pragma unroll 1
  for (int t = 0; t < ntile; ++t) {
    f32x16 S[2];
    float mx = -1e30f;
#pragma unroll
    for (int ks = 0; ks < 2; ++ks) {
#pragma unroll
      for (int i = 0; i < 16; ++i) S[ks][i] = 0.f;
#pragma unroll
      for (int kk = 0; kk < 4; ++kk) {
        const bf16x8 kf = *(const bf16x8*)(sKc + (t * 64 + ks * 32 + lr) * 144 + (kk * 2 + lh) * 16);
        S[ks] = MFMA(kf, q[kk], S[ks]);
      }
#pragma unroll
      for (int i = 0; i < 16; ++i) {
        const int n = t * 64 + ks * 32 + crow(i, lh);
        const float tv = (16 * n + 31 <= qpos) ? S[ks][i] * scale : -1e30f;
        S[ks][i] = tv;
        mx = fmaxf(mx, tv);
      }
    }
    mx = fmaxf(mx, __shfl_xor(mx, 32));
    const float mn = fmaxf(mc, mx);
    float rs = 0.f;
#pragma unroll
    for (int ks = 0; ks < 2; ++ks)
#pragma unroll
      for (int i = 0; i < 16; ++i) rs += (S[ks][i] > -1e29f) ? __expf(S[ks][i] - mn) : 0.f;
    rs += __shfl_xor(rs, 32);
    lc = lc * __expf(mc - mn) + rs;
    mc = mn;
  }
  const float invl = (lc > 0.f) ? 1.f / lc : 0.f;

  f32x16 Oo[2];
#pragma unroll
  for (int d = 0; d < 2; ++d)
#pragma unroll
    for (int i = 0; i < 16; ++i) Oo[d][i] = 0.f;
#pragma unroll
  for (int t = 0; t < 4; ++t) {
    if (t < ntile) {
#pragma unroll
      for (int ks = 0; ks < 2; ++ks) {
        f32x16 S;
#pragma unroll
        for (int i = 0; i < 16; ++i) S[i] = 0.f;
#pragma unroll
        for (int kk = 0; kk < 4; ++kk) {
          const bf16x8 kf = *(const bf16x8*)(sKc + (t * 64 + ks * 32 + lr) * 144 + (kk * 2 + lh) * 16);
          S = MFMA(kf, q[kk], S);
        }
#pragma unroll
        for (int i = 0; i < 16; ++i) {
          const int n = t * 64 + ks * 32 + crow(i, lh);
          S[i] = (16 * n + 31 <= qpos) ? __expf(S[i] * scale - mc) * invl : 0.f;
        }
#pragma unroll
        for (int gq = 0; gq < 4; ++gq) {
          const int j = t * 16 + ks * 8 + 2 * gq + lh;
          atomicAdd(&sImp[(hh * 64 + qloc) * 65 + j], S[4 * gq] + S[4 * gq + 1] + S[4 * gq + 2] + 0.5f * S[4 * gq + 3]);
          if (j + 1 < 64) atomicAdd(&sImp[(hh * 64 + qloc) * 65 + j + 1], 0.5f * S[4 * gq + 3]);
        }
#pragma unroll
        for (int st = 0; st < 2; ++st) {
          union { unsigned u[4]; bf16x8 v; } pf;
#pragma unroll
          for (int j = 0; j < 4; ++j) pf.u[j] = pack2(S[8 * st + 2 * j], S[8 * st + 2 * j + 1]);
#pragma unroll
          for (int d = 0; d < 2; ++d) {
            const char* vp = sVc + (d * 32 + lr) * VCSTR + (t * 64 + ks * 32 + 16 * st + 4 * lh) * 2;
            const s16x4 lo = *(const s16x4*)vp, hi = *(const s16x4*)(vp + 16);
            const bf16x8 vf = __builtin_shufflevector(lo, hi, 0, 1, 2, 3, 4, 5, 6, 7);
            Oo[d] = MFMA(vf, pf.v, Oo[d]);
          }
        }
      }
    }
  }
  __syncthreads();

  {
    const int qq = tid >> 3, part = tid & 7;
    float v[8];
#pragma unroll
    for (int k = 0; k < 8; ++k) {
      const int j = part * 8 + k;
      float val = sImp[(0 * 64 + qq) * 65 + j] + sImp[(1 * 64 + qq) * 65 + j] + sImp[(2 * 64 + qq) * 65 + j] + sImp[(3 * 64 + qq) * 65 + j];
      const bool forced = (j == 0) || (j == jq) || (j == jq - 1);
      val = forced ? 1e9f : val;
      val = (j <= jq) ? val : -1.f;
      v[k] = val;
    }
    unsigned taken = 0, selb = 0;
#pragma unroll 1
    for (int r = 0; r < 8; ++r) {
      float best = -2.f;
      int bidx = 1000;
#pragma unroll
      for (int k = 0; k < 8; ++k)
        if (!((taken >> k) & 1u) && v[k] > best) { best = v[k]; bidx = part * 8 + k; }
#pragma unroll
      for (int off = 1; off < 8; off <<= 1) {
        const float ob = __shfl_xor(best, off);
        const int oi = __shfl_xor(bidx, off);
        if (ob > best || (ob == best && oi < bidx)) { best = ob; bidx = oi; }
      }
      if ((bidx >> 3) == part) {
        taken |= 1u << (bidx & 7);
        if (best >= 0.f) selb |= 1u << (bidx & 7);
      }
    }
    sSel[qq * 8 + part] = (unsigned char)selb;
  }
  __syncthreads();
  const unsigned long long sel = *(const unsigned long long*)(sSel + qloc * 8);

  const u16* gz = z + (tokbase + qpos) * ZW + ZC_GATE + head * 3;
  const float g0 = sigmoidf(bf2f(gz[0])), g1 = sigmoidf(bf2f(gz[1])), g2 = sigmoidf(bf2f(gz[2]));
#pragma unroll
  for (int d = 0; d < 2; ++d)
#pragma unroll
    for (int i = 0; i < 16; ++i) Oo[d][i] *= g0;

  {
    float m = -1e30f, ls = 0.f;
    f32x16 O[2];
#pragma unroll
    for (int d = 0; d < 2; ++d)
#pragma unroll
      for (int i = 0; i < 16; ++i) O[d][i] = 0.f;
    flash_loop<64, 64, 2>(m, ls, O, q, scale, z + tokbase * ZW + ZC_NKS + g * 64, ZW,
                          BUF(p, B_VST) + ((size_t)(bl * 2 + g) * 64) * SEQ, SEQ, 0, jq + 1, qpos, q0 + 63, sel, smem);
    const float f = (ls > 0.f) ? g1 / ls : 0.f;
#pragma unroll
    for (int d = 0; d < 2; ++d)
#pragma unroll
      for (int i = 0; i < 16; ++i) Oo[d][i] += f * O[d][i];
  }
  {
    float m = -1e30f, lw = 0.f;
    f32x16 O[2];
#pragma unroll
    for (int d = 0; d < 2; ++d)
#pragma unroll
      for (int i = 0; i < 16; ++i) O[d][i] = 0.f;
    flash_loop<64, 64, 3>(m, lw, O, q, scale, z + tokbase * ZW + ZC_NKW + g * 64, ZW,
                          BUF(p, B_VWT) + ((size_t)(bl * 2 + g) * 64) * SEQ, SEQ, max(0, jq - 8), jq + 1, qpos, q0 + 63, 0ull, smem);
    const float f = (lw > 0.f) ? g2 / lw : 0.f;
#pragma unroll
    for (int d = 0; d < 2; ++d)
#pragma unroll
      for (int i = 0; i < 16; ++i) Oo[d][i] += f * O[d][i];
  }
#pragma unroll
  for (int d = 0; d < 2; ++d)
#pragma unroll
    for (int gq = 0; gq < 4; ++gq) {
      uint2 pk;
      pk.x = pack2(Oo[d][4 * gq], Oo[d][4 * gq + 1]);
      pk.y = pack2(Oo[d][4 * gq + 2], Oo[d][4 * gq + 3]);
      *(uint2*)(P + (tokbase + qpos) * 2048 + 1536 + head * 64 + d * 32 + 8 * gq + 4 * lh) = pk;
    }
  __syncthreads();
}

DI void gmlp_tile(const Params& p, int l, int mt, int g, char* smem) {
  EPI_IDS
  const u16* vl = BUF(p, B_VLNT) + (size_t)g * TG * 128;
  const u16* z = BUF(p, B_Z);
  u16* P = BUF(p, B_P);
  const float* bs = p.in[12] + (size_t)l * 512 + g * 128;
  f32x16 acc[1][2][2];
  gemm_core<1, 2>(acc, vl + (size_t)mt * 256 * 128, 128, 64, WTS(p, l) + W_GWS + (size_t)g * 128 * 128, nullptr, 128, 128, smem);
#pragma unroll
  for (int ms = 0; ms < 2; ++ms)
#pragma unroll
    for (int ns = 0; ns < 2; ++ns) {
      const int t = wn * 64 + ns * 32 + lr;
      const float bias = bs[t];
#pragma unroll
      for (int gq = 0; gq < 4; ++gq) {
        const int R = mt * 256 + wm * 64 + ms * 32 + 8 * gq + 4 * lh;
        const int chunk = R >> 7, d = R & 127;
        const size_t tok = (size_t)chunk * 128 + t;
        const uint2 u = *(const uint2*)(z + tok * ZW + ZC_U + g * 128 + d);
        uint2 pk;
        pk.x = pack2(__uint_as_float(u.x << 16) * (acc[0][ms][ns][4 * gq] + bias),
                     __uint_as_float(u.x & 0xffff0000u) * (acc[0][ms][ns][4 * gq + 1] + bias));
        pk.y = pack2(__uint_as_float(u.y << 16) * (acc[0][ms][ns][4 * gq + 2] + bias),
                     __uint_as_float(u.y & 0xffff0000u) * (acc[0][ms][ns][4 * gq + 3] + bias));
        *(uint2*)(P + tok * 2048 + g * 128 + d) = pk;
      }
    }
}

DI void phase_m3(const Params& p, int l, char* smem, int only = 0) {
  const int xcd = blockIdx.x & 7, nj = gridDim.x >> 3;
  for (int vj = blockIdx.x >> 3; vj < 32; vj += nj) {
    const int hsel = vj >> 4, f = vj & 15;
    const int hd0 = 4 * xcd + hsel, hd1 = 4 * xcd + 2 + hsel;
    if (only == 0 || only == 1 || only >= 10) mla_item(p, hd0 >> 3, hd0 & 7, f, smem, only >= 10 ? only - 10 : 0);
    if (only == 0 || only == 2) nsa_item(p, l, xcd >> 1, xcd & 1, 63 - vj, smem);
    if (only == 0 || only == 1 || only >= 10) mla_item(p, hd1 >> 3, hd1 & 7, 15 - f, smem, only >= 10 ? only - 10 : 0);
    if (only == 0 || only == 2) nsa_item(p, l, xcd >> 1, xcd & 1, vj, smem);
  }
  if (only == 0 || only == 3)
    for (int it = blockIdx.x; it < (TG / 256) * 4; it += gridDim.x) gmlp_tile(p, l, it >> 2, it & 3, smem);
}

DI size_t gate_off(size_t row4, int col) { return (((row4 >> 2) * 128 + (size_t)(col >> 5)) * 32 + (size_t)(col & 31)) * 4; }
DI void phase_m4a(const Params& p, int l, int grp, char* smem) {
  G256_IDS
  const u16* xb = XB(p) + (size_t)grp * TG * D;
  const u16* wt = WTS(p, l) + W_IN + (size_t)ZW * D;
  const float* bgate = F32L(p, l) + F_BGATE;
  u16* gt = BUF(p, B_Z);
  constexpr int MPX = (TG / 256) / 8;
  auto setup = [&](int xcd, int q, const u16*& Ap, const u16*& Bp) __attribute__((always_inline)) {
    G256_SETUP_IDS
    const int mt = xcd * MPX + q % MPX, nt = q / MPX;
    Ap = xb + (size_t)mt * 256 * D;
    Bp = wt + (size_t)nt * 256 * D;
  };
  auto toff = [&](int r0, int c8, int& aoff, int& boff) __attribute__((always_inline)) {
    aoff = r0 * D + c8 * 8;
    boff = r0 * D + c8 * 8;
  };
  auto epi = [&](int xcd, int q, f32x16 (&acc)[4][2]) __attribute__((always_inline)) {
    G256_EPI_IDS
    const int mt = xcd * MPX + q % MPX, nt = q / MPX;
    const int col0 = nt * 256 + wn * 64 + lr;
    const float bias0 = bgate[col0], bias1 = bgate[col0 + 32];
#pragma unroll
    for (int ms = 0; ms < 4; ++ms)
#pragma unroll
      for (int gq = 0; gq < 4; ++gq) {
        const size_t row = (size_t)mt * 256 + wm * 128 + ms * 32 + 8 * gq + 4 * lh;
        uint2 pk0, pk1;
        pk0.x = pack2(sigmoidf(acc[ms][0][4 * gq] + bias0), sigmoidf(acc[ms][0][4 * gq + 1] + bias0));
        pk0.y = pack2(sigmoidf(acc[ms][0][4 * gq + 2] + bias0), sigmoidf(acc[ms][0][4 * gq + 3] + bias0));
        pk1.x = pack2(sigmoidf(acc[ms][1][4 * gq] + bias1), sigmoidf(acc[ms][1][4 * gq + 1] + bias1));
        pk1.y = pack2(sigmoidf(acc[ms][1][4 * gq + 2] + bias1), sigmoidf(acc[ms][1][4 * gq + 3] + bias1));
        *(uint2*)(gt + gate_off(row, col0)) = pk0;
        *(uint2*)(gt + gate_off(row, col0 + 32)) = pk1;
      }
  };
  gemm256_stream(MPX * 16, D, (long)64 * D, 64, (long)64 * D, toff, setup, epi, smem);
}

DI void phase_m4b(const Params& p, int l, char* smem) {
  const u16* P = BUF(p, B_P);
  const u16* gt = BUF(p, B_Z);
  u16* mg = BUF(p, B_MG);
  const u16* w = WTS(p, l);
  for (int qq = blockIdx.x >> 3; qq < 64; qq += (gridDim.x >> 3)) {
    const int mt = (blockIdx.x & 7) * ((TG / 256) / 8) + (qq & 7), nt = qq >> 3;
    f32x16 accm[2][2];
#pragma unroll
    for (int ms = 0; ms < 2; ++ms)
#pragma unroll
      for (int ns = 0; ns < 2; ++ns)
#pragma unroll
        for (int i = 0; i < 16; ++i) accm[ms][ns][i] = 0.f;
#pragma unroll 1
    for (int br = 0; br < 4; ++br) {
      f32x16 ay[1][2][2];
      gemm_core<1, 2>(ay, P + (size_t)mt * 256 * 2048 + br * 512, 2048, 64, w + W_OUT4 + (size_t)br * 1024 * 512 + (size_t)nt * 128 * 512, nullptr, 512, 512, smem);
      EPI_IDS
#pragma unroll
      for (int ms = 0; ms < 2; ++ms)
#pragma unroll
        for (int ns = 0; ns < 2; ++ns)
#pragma unroll
          for (int gq = 0; gq < 4; ++gq) {
            const size_t row = (size_t)mt * 256 + wm * 64 + ms * 32 + 8 * gq + 4 * lh;
            const int col = nt * 128 + wn * 64 + ns * 32 + lr;
            const unsigned long long gq64 = __builtin_nontemporal_load((const unsigned long long*)(gt + gate_off(row, br * 1024 + col)));
            uint2 gv; gv.x = (unsigned)gq64; gv.y = (unsigned)(gq64 >> 32);
            accm[ms][ns][4 * gq] += __uint_as_float(gv.x << 16) * ay[0][ms][ns][4 * gq];
            accm[ms][ns][4 * gq + 1] += __uint_as_float(gv.x & 0xffff0000u) * ay[0][ms][ns][4 * gq + 1];
            accm[ms][ns][4 * gq + 2] += __uint_as_float(gv.y << 16) * ay[0][ms][ns][4 * gq + 2];
            accm[ms][ns][4 * gq + 3] += __uint_as_float(gv.y & 0xffff0000u) * ay[0][ms][ns][4 * gq + 3];
          }
    }
    EPI_IDS
#pragma unroll
    for (int ms = 0; ms < 2; ++ms)
#pragma unroll
      for (int ns = 0; ns < 2; ++ns)
#pragma unroll
        for (int i = 0; i < 16; ++i) {
          const size_t row = (size_t)mt * 256 + wm * 64 + ms * 32 + crow(i, lh);
          mg[row * D + nt * 128 + wn * 64 + ns * 32 + lr] = f2bf(accm[ms][ns][i]);
        }
  }
}

DI void phase_x1(const Params& p, int l, char* smem) {
  G256_IDS
  const u16* xb = XB(p);
  const u16* w = WTS(p, l);
  u16* xq = BUF(p, B_XQ);
  constexpr int MPX = (T / 256) / 8;
  {
    auto setup = [&](int xcd, int q, const u16*& Ap, const u16*& Bp) __attribute__((always_inline)) {
    G256_SETUP_IDS
      const int mt = xcd * MPX + q % MPX, nt = q / MPX;
      Ap = xb + (size_t)mt * 256 * D;
      Bp = w + W_XQ + (size_t)nt * 256 * D;
    };
    auto toff = [&](int r0, int c8, int& aoff, int& boff) __attribute__((always_inline)) {
      aoff = r0 * D + c8 * 8;
      boff = r0 * D + c8 * 8;
    };
    auto epi = [&](int xcd, int q, f32x16 (&acc)[4][2]) __attribute__((always_inline)) {
    G256_EPI_IDS
      const int mt = xcd * MPX + q % MPX, nt = q / MPX;
#pragma unroll
      for (int ms = 0; ms < 4; ++ms)
#pragma unroll
        for (int ns = 0; ns < 2; ++ns)
#pragma unroll
          for (int i = 0; i < 16; ++i) {
            const size_t row = (size_t)mt * 256 + wm * 128 + ms * 32 + crow(i, lh);
            xq[row * 512 + nt * 256 + wn * 64 + ns * 32 + lr] = f2bf(acc[ms][ns][i]);
          }
    };
    gemm256_stream(2 * MPX, D, (long)64 * D, 64, (long)64 * D, toff, setup, epi, smem);
  }
}

DI void phase_x2(const Params& p, char* smem) {
  const int tid = otid(), lane = tid & 63, wave = tid >> 6, lr = lane & 31, lh = lane >> 5;
  const u16* xq = BUF(p, B_XQ);
  u16* xo = BUF(p, B_XO);
  const u16* kx = (const u16*)(PWS(p) + WS_KX);
  const u16* vxt = (const u16*)(PWS(p) + WS_VXT);
  for (int t = blockIdx.x; t < BATCH * 4 * 16; t += gridDim.x) {
    const int b = t >> 6, h = (t >> 4) & 3, qt = t & 15;
    const size_t tok = (size_t)b * SEQ + qt * 256 + wave * 32 + lr;
    bf16x8 q[8];
#pragma unroll
    for (int kk = 0; kk < 8; ++kk) q[kk] = *(const bf16x8*)(xq + tok * 512 + h * 128 + kk * 16 + lh * 8);
    float m = -1e30f, l = 0.f;
    f32x16 O[4];
#pragma unroll
    for (int d = 0; d < 4; ++d)
#pragma unroll
      for (int i = 0; i < 16; ++i) O[d][i] = 0.f;
    flash_loop<128, 128, 0>(m, l, O, q, 0.08838834764831845f, kx + (size_t)b * MEML * 512 + h * 128, 512,
                            vxt + ((size_t)(b * 4 + h) * 128) * MEML, MEML, 0, 4, 0, 0, 0ull, smem);
    const float inv = 1.f / l;
#pragma unroll
    for (int d = 0; d < 4; ++d)
#pragma unroll
      for (int gq = 0; gq < 4; ++gq) {
        uint2 pk;
        pk.x = pack2(O[d][4 * gq] * inv, O[d][4 * gq + 1] * inv);
        pk.y = pack2(O[d][4 * gq + 2] * inv, O[d][4 * gq + 3] * inv);
        *(uint2*)(xo + tok * 512 + h * 128 + d * 32 + 8 * gq + 4 * lh) = pk;
      }
  }
}

#define XB_TMO      128
#define XB_XCNT(j)  (256  + 64 * (j))
#define XB_XSUB(j)  (1280 + 64 * (j))
#define XB_XGEN(j)  (2304 + 64 * (j))
#define XB_TOP      3328
#define XB_TOPGEN   3392
#define XCD_BAR_WORDS 3456
#define XB_SPIN_CAP (1u << 22)
#define LAS __attribute__((address_space(3)))
DI unsigned xb_ld(unsigned* p) { return __hip_atomic_load(p, __ATOMIC_RELAXED, __HIP_MEMORY_SCOPE_AGENT); }
DI unsigned xb_add(unsigned* p, unsigned v) { return __hip_atomic_fetch_add(p, v, __ATOMIC_RELAXED, __HIP_MEMORY_SCOPE_AGENT); }
DI unsigned xb_xcc_id() { return (unsigned)__builtin_amdgcn_s_getreg((3 << 11) | 20) & 0xFu; }
#define XB_SPIN(cond, bar) do { unsigned _sp = 0; while (cond) { __builtin_amdgcn_s_sleep(1); \
    if ((++_sp & 255u) == 0u) { if (xb_ld(&(bar)[XB_TMO])) break; if (_sp > XB_SPIN_CAP) { atomicAdd(&(bar)[XB_TMO], 1u); break; } } } } while (0)
struct XcdBarrier { unsigned* bar; unsigned x; volatile LAS unsigned* st; };
DI XcdBarrier xcd_barrier_post(unsigned* bar, volatile LAS unsigned* st) {
  XcdBarrier b; b.bar = bar; b.x = xb_xcc_id(); b.st = st;
  if (threadIdx.x == 0) (void)xb_add(&bar[XB_XCNT(b.x)], 1u);
  return b;
}
DI void xcd_barrier_complete(unsigned* bar, unsigned x, unsigned& nloc, unsigned& nx) {
  const unsigned G = gridDim.x * gridDim.y * gridDim.z;
  unsigned sum, cnt, mine, sp = 0u;
  for (;;) {
    sum = 0u; cnt = 0u; mine = 0u;
#pragma unroll
    for (unsigned j = 0; j < 16; ++j) { const unsigned c = xb_ld(&bar[XB_XCNT(j)]); sum += c; cnt += (c > 0u) ? 1u : 0u; mine = (j == x) ? c : mine; }
    if (sum == G) break;
    __builtin_amdgcn_s_sleep(1);
    if ((++sp & 255u) == 0u) { if (xb_ld(&bar[XB_TMO])) break; if (sp > XB_SPIN_CAP) { atomicAdd(&bar[XB_TMO], 1u); break; } }
  }
  nloc = mine > 0u ? mine : 1u; nx = cnt > 0u ? cnt : 1u;
}
DI void xcd_barrier(const XcdBarrier& b) {
  asm volatile("s_waitcnt vmcnt(0)" ::: "memory");
  __syncthreads();
  if (threadIdx.x == 0) {
    unsigned* bar = b.bar;
    __builtin_amdgcn_s_waitcnt(0);
    unsigned nloc = b.st[0], nx = b.st[1];
    if (nloc == 0u) { xcd_barrier_complete(bar, b.x, nloc, nx); b.st[0] = nloc; b.st[1] = nx; }
    const unsigned old = xb_add(&bar[XB_XSUB(b.x)], 1u);
    const unsigned gen = old / nloc;
    if (old + 1u == (gen + 1u) * nloc) {
      __builtin_amdgcn_fence(__ATOMIC_RELEASE, "agent");
      asm volatile("s_waitcnt vmcnt(0)" ::: "memory");
      const unsigned og = xb_add(&bar[XB_TOP], 1u);
      const unsigned tg = og / nx;
      if (og + 1u == (tg + 1u) * nx) xb_add(&bar[XB_TOPGEN], 1u);
      else XB_SPIN(xb_ld(&bar[XB_TOPGEN]) == tg, bar);
      __builtin_amdgcn_fence(__ATOMIC_ACQUIRE, "agent");
      xb_add(&bar[XB_XGEN(b.x)], 1u);
      asm volatile("s_waitcnt vmcnt(0)" ::: "memory");
    } else {
      XB_SPIN(xb_ld(&bar[XB_XGEN(b.x)]) == gen, bar);
      __builtin_amdgcn_fence(__ATOMIC_ACQUIRE, "agent");
      asm volatile("s_waitcnt vmcnt(0)" ::: "memory");
    }
  }
  __syncthreads();
}
DI XcdBarrier mk_bar(const Params& p, char* smem) {
  XcdBarrier b;
  b.bar = (unsigned*)(PWS(p) + WS_BAR);
  b.x = xb_xcc_id();
  b.st = (volatile LAS unsigned*)(smem + XB_LDS_OFF);
  return b;
}

enum { PH_INIT, PH_FFN_UP, PH_RESID, PH_LN, PH_M1, PH_M2, PH_M3, PH_M4A, PH_M4B, PH_X1, PH_X2 };
constexpr int STEPS_PER_LAYER = 3 + NGRP * 6 + 8;
constexpr int NSTEPS = 1 + DEPTH * STEPS_PER_LAYER;
#define PROBE_PH (-1)
#define PROBE_SUB 0
__global__ void __launch_bounds__(NTHREADS) k_mega(Params p) {
  extern __shared__ __attribute__((aligned(16))) char smem[];
  cg::grid_group grid = cg::this_grid();
  {
    volatile LAS unsigned* st = (volatile LAS unsigned*)(smem + XB_LDS_OFF);
    if (threadIdx.x == 0) { st[0] = 0u; st[1] = 0u; }
    __syncthreads();
    (void)xcd_barrier_post((unsigned*)(PWS(p) + WS_BAR), st);
  }
#pragma unroll 1
  for (int step = 0; step < NSTEPS; ++step) {
    int ph = PH_INIT, l = 0, grp = 0, var = 0;
    if (step > 0) {
      const int s1 = step - 1;
      l = s1 / STEPS_PER_LAYER;
      const int r = s1 % STEPS_PER_LAYER;
      constexpr int MIXEND = 3 + NGRP * 6;
      if (r == 0) { ph = PH_FFN_UP; var = 0; }
      else if (r == 1) { ph = PH_RESID; var = 0; }
      else if (r == 2) { ph = PH_LN; var = 0; }
      else if (r < MIXEND) {
        const int m = r - 3, k = m % 6;
        grp = m / 6;
        ph = (k == 0) ? PH_M1 : (k == 1) ? PH_M2 : (k == 2) ? PH_M3 : (k == 3) ? PH_M4A : (k == 4) ? PH_M4B : PH_RESID;
        var = 1;
      }
      else if (r == MIXEND) { ph = PH_LN; var = 1; }
      else if (r == MIXEND + 1) { ph = PH_X1; }
      else if (r == MIXEND + 2) { ph = PH_X2; }
      else if (r == MIXEND + 3) { ph = PH_RESID; var = 2; }
      else if (r == MIXEND + 4) { ph = PH_LN; var = 2; }
      else if (r == MIXEND + 5) { ph = PH_FFN_UP; var = 1; }
      else if (r == MIXEND + 6) { ph = PH_RESID; var = 3; }
      else { ph = PH_LN; var = 3; }
    }
    const u16* w = WTS(p, l);
#pragma unroll 1
    for (int rep = 0; rep < ((ph == PROBE_PH) ? 2 : 1); ++rep) {
    switch (ph) {
      case PH_INIT: phase0(p, smem); break;
      case PH_FFN_UP: phase_ffn_up(p, w + (var ? W_F2W1 : W_F1W1), w + (var ? W_F2W3 : W_F1W3), smem); break;
      case PH_RESID: {
        const u16* A; const u16* Bt; const float* res = p.out; int lda, K, row0 = 0, nrows = T; float scl = 1.f;
        if (var == 0) { A = BUF(p, B_H); lda = FF; K = FF; Bt = w + W_F1W2; scl = 0.5f; if (l == 0) res = p.in[0]; }
        else if (var == 1) { A = BUF(p, B_MG); lda = D; K = D; Bt = w + W_O; row0 = grp * TG; nrows = TG; }
        else if (var == 2) { A = BUF(p, B_XO); lda = 512; K = 512; Bt = w + W_XO; }
        else { A = BUF(p, B_H); lda = FF; K = FF; Bt = w + W_F2W2; scl = 0.5f; }
        (void)res;
        phase_gemm_resid(p, A, lda, K, Bt, (l == DEPTH - 1) && (var == 3), scl, row0, nrows, smem);
      } break;
      case PH_LN: {
        const int gi = (var == 0) ? 5 : (var == 1) ? 27 : (var == 2) ? 33 : 38;
        phase_ln(p, p.in[gi] + l * D, p.in[gi + 1] + l * D, (l == DEPTH - 1) && (var == 3));
      } break;
      case PH_M1: phase_m1(p, l, grp, smem); break;
      case PH_M2: phase_m2(p, l, grp, smem); break;
      case PH_M3: phase_m3(p, l, smem, rep ? PROBE_SUB : 0); break;
      case PH_M4A: phase_m4a(p, l, grp, smem); break;
      case PH_M4B: phase_m4b(p, l, smem); break;
      case PH_X1: phase_x1(p, l, smem); break;
      default: phase_x2(p, smem); break;
    }
    if (step == 0) grid.sync();
    else xcd_barrier(mk_bar(p, smem));
    }
  }
}

extern "C" void kernel_launch(void* const* d_in, const int* in_sizes, int n_in, void* d_out, int out_size, void* d_ws,
                              size_t ws_size, hipStream_t stream) {
  (void)in_sizes; (void)out_size;
  if (n_in < 40 || ws_size < WS_TOTAL) {
    fprintf(stderr, "kernel_launch: unexpected inputs (n_in %d, ws %zu < %zu)\n", n_in, ws_size, (size_t)WS_TOTAL);
    return;
  }
  static int grid_blocks = 0;
  if (!grid_blocks) {
    hipFuncSetAttribute((const void*)k_mega, hipFuncAttributeMaxDynamicSharedMemorySize, SMEM_BYTES);
    int dev = 0, cus = 0, per_cu = 0;
    hipGetDevice(&dev);
    hipDeviceGetAttribute(&cus, hipDeviceAttributeMultiprocessorCount, dev);
    hipOccupancyMaxActiveBlocksPerMultiprocessor(&per_cu, k_mega, NTHREADS, SMEM_BYTES);
    if (per_cu < 1) per_cu = 1;
    grid_blocks = cus * per_cu;
  }
  Params p{};
  for (int i = 0; i < 40; ++i) p.in[i] = (const float*)d_in[i];
  p.out = (float*)d_out;
  p.ws = (char*)d_ws;
  hipMemsetAsync((char*)d_ws + WS_BAR, 0, (size_t)XCD_BAR_WORDS * 4, stream);
  void* args[] = {&p};
  hipError_t e = hipLaunchCooperativeKernel((const void*)k_mega, dim3(grid_blocks), dim3(NTHREADS), args, SMEM_BYTES, stream);
  if (e != hipSuccess) fprintf(stderr, "cooperative launch failed: %s (grid %d)\n", hipGetErrorString(e), grid_blocks);
}
```

```cpp
#include <hip/hip_runtime.h>
#include <hip/hip_cooperative_groups.h>
#include <cstdio>
#include <cstdint>
namespace cg = cooperative_groups;

typedef unsigned short u16;
using bf16x8 = __attribute__((ext_vector_type(8))) short;
using s16x4 = __attribute__((ext_vector_type(4))) short;
using f32x16 = __attribute__((ext_vector_type(16))) float;
#define DI __device__ __forceinline__
#define MFMA(a, b, c) __builtin_amdgcn_mfma_f32_32x32x16_bf16((a), (b), (c), 0, 0, 0)

constexpr int D = 1024, BATCH = 8, SEQ = 4096, T = BATCH * SEQ, DEPTH = 2, MEML = 256, FF = 2816;
constexpr int BG = 4;
constexpr int TG = BG * SEQ;
constexpr int NGRP = BATCH / BG;
constexpr int ZW = 4352;
constexpr int INW = 8376;
constexpr int ZC_U = 0, ZC_V = 512, ZC_CB = 1024, ZC_CC = 1536, ZC_CH = 2048, ZC_QLAT = 2560, ZC_KVLAT = 2816,
              ZC_NQ = 2944, ZC_NKC = 3456, ZC_NVC = 3584, ZC_NKS = 3712, ZC_NVS = 3840, ZC_NKW = 3968,
              ZC_NVW = 4096, ZC_KROPE = 4224, ZC_GATE = 4256;
constexpr float ALPHA = 1.4142135623730951f;
constexpr int NTHREADS = 512;
constexpr int SMEM_BYTES = 140 * 1024;
constexpr int XB_LDS_OFF = 138 * 1024;

constexpr size_t W_F1W1 = 0;
constexpr size_t W_F1W3 = W_F1W1 + (size_t)FF * D;
constexpr size_t W_F1W2 = W_F1W3 + (size_t)FF * D;
constexpr size_t W_F2W1 = W_F1W2 + (size_t)FF * D;
constexpr size_t W_F2W3 = W_F2W1 + (size_t)FF * D;
constexpr size_t W_F2W2 = W_F2W3 + (size_t)FF * D;
constexpr size_t W_IN = W_F2W2 + (size_t)FF * D;
constexpr size_t W_OUT4 = W_IN + (size_t)(ZW + 4096) * D;
constexpr size_t W_UQ = W_OUT4 + (size_t)4 * 1024 * 512;
constexpr size_t W_UKV = W_UQ + (size_t)768 * 256;
constexpr size_t W_O = W_UKV + (size_t)1024 * 128;
constexpr size_t W_XQ = W_O + (size_t)1024 * 1024;
constexpr size_t W_XKV = W_XQ + (size_t)512 * 1024;
constexpr size_t W_XO = W_XKV + (size_t)1024 * 1024;
constexpr size_t W_CK = W_XO + (size_t)1024 * 512;
constexpr size_t W_CV = W_CK + (size_t)128 * 1024;
constexpr size_t W_GWS = W_CV + (size_t)128 * 1024;
constexpr size_t LAYER_W = W_GWS + (size_t)4 * 128 * 128;

constexpr int F_BZ = 0, F_BGATE = ZW, F_CK = ZW + 4096, F_CV = F_CK + 64, F32_PER_LAYER = F_CV + 64;

constexpr size_t al256(size_t x) { return (x + 255) & ~(size_t)255; }
constexpr size_t cmax(size_t a, size_t b) { return a > b ? a : b; }
constexpr size_t WS_WTS = 0;
constexpr size_t WS_F32 = al256(WS_WTS + 2 * LAYER_W * 2);
constexpr size_t WS_BAR = al256(WS_F32 + (size_t)2 * F32_PER_LAYER * 4);
constexpr size_t WS_TAB64 = al256(WS_BAR + (size_t)4096 * 4);
constexpr size_t WS_TAB32 = al256(WS_TAB64 + (size_t)4096 * 32 * 8);
constexpr size_t WS_XB = al256(WS_TAB32 + (size_t)4096 * 16 * 8);
constexpr size_t WS_MEMB = al256(WS_XB + (size_t)T * D * 2);
constexpr size_t WS_KX = al256(WS_MEMB + (size_t)BATCH * MEML * D * 2);
constexpr size_t WS_VXT = al256(WS_KX + (size_t)BATCH * MEML * 512 * 2);
constexpr size_t WS_BIG = al256(WS_VXT + (size_t)BATCH * MEML * 512 * 2);
constexpr size_t B_H = 0;
constexpr size_t B_Z = 0;
constexpr size_t B_P = al256(B_Z + (size_t)TG * ZW * 2);
constexpr size_t B_QB = al256(B_P + (size_t)TG * 2048 * 2);
constexpr size_t B_KB = al256(B_QB + (size_t)TG * 768 * 2);
constexpr size_t B_MG = B_QB;
constexpr size_t B_VT = al256(B_KB + (size_t)TG * 768 * 2);
constexpr size_t B_VST = al256(B_VT + (size_t)TG * 512 * 2);
constexpr size_t B_VWT = al256(B_VST + (size_t)TG * 128 * 2);
constexpr size_t B_VLNT = al256(B_VWT + (size_t)TG * 128 * 2);
constexpr size_t B_UV = al256(B_VLNT + (size_t)TG * 512 * 2);
constexpr size_t B_END = al256(B_UV + (size_t)4 * (TG / 16) * 128 * 4);
constexpr size_t B_XQ = 0;
constexpr size_t B_XO = al256((size_t)T * 512 * 2);
constexpr size_t WS_TOTAL = WS_BIG + cmax(B_END, (size_t)T * FF * 2);
static_assert(WS_TOTAL <= (size_t)512 * 1024 * 1024, "workspace too large");

struct Params {
  const float* in[40];
  float* out;
  char* ws;
};

DI char* launder(char* x) {
  unsigned lo = (unsigned)(uintptr_t)x, hi = (unsigned)((uintptr_t)x >> 32);
  unsigned vlo, vhi;
  asm volatile("v_mov_b32 %0, %2\n\tv_mov_b32 %1, %3" : "=v"(vlo), "=v"(vhi) : "s"(lo), "s"(hi));
  lo = __builtin_amdgcn_readfirstlane(vlo);
  hi = __builtin_amdgcn_readfirstlane(vhi);
  return (char*)(__attribute__((address_space(1))) char*)(((uintptr_t)hi << 32) | (uintptr_t)lo);
}
#define PWS(p) launder((p).ws)
DI u16* WTS(const Params& p, int l) { return (u16*)(PWS(p) + WS_WTS) + (size_t)l * LAYER_W; }
DI float* F32L(const Params& p, int l) { return (float*)(PWS(p) + WS_F32) + (size_t)l * F32_PER_LAYER; }
DI float2* TAB64(const Params& p) { return (float2*)(PWS(p) + WS_TAB64); }
DI float2* TAB32(const Params& p) { return (float2*)(PWS(p) + WS_TAB32); }
DI u16* XB(const Params& p) { return (u16*)(PWS(p) + WS_XB); }
constexpr size_t B_R16_LAST = (size_t)192 * 1024 * 1024;
static_assert(B_R16_LAST >= (size_t)T * FF * 2 && B_R16_LAST + (size_t)T * D * 2 <= cmax(B_END, (size_t)T * FF * 2), "r16 placement");
DI u16* R16(const Params& p, bool last) { return last ? (u16*)(PWS(p) + WS_BIG + B_R16_LAST) : (u16*)launder((char*)p.out); }
DI u16* BUF(const Params& p, size_t off) { return (u16*)(PWS(p) + WS_BIG + off); }

typedef __bf16 hwbf16x2 __attribute__((ext_vector_type(2)));
typedef float f32x2v __attribute__((ext_vector_type(2)));
DI unsigned pack2(float a, float b) { f32x2v v = {a, b}; hwbf16x2 r = __builtin_convertvector(v, hwbf16x2); return __builtin_bit_cast(unsigned, r); }
DI u16 f2bf(float x) { return (u16)(pack2(x, 0.f) & 0xffffu); }
DI float bf2f(u16 v) { return __uint_as_float(((unsigned)v) << 16); }
DI int otid() { int t = threadIdx.x; asm volatile("" : "+v"(t)); return t; }
DI int crow(int i, int h) { return (i & 3) + 8 * (i >> 2) + 4 * h; }
DI float sigmoidf(float x) { return __builtin_amdgcn_rcpf(1.f + __expf(-x)); }
DI float wave_sum(float v) {
#pragma unroll
  for (int o = 32; o >= 1; o >>= 1) v += __shfl_xor(v, o);
  return v;
}

template <int NB, int NS>
DI void gemm_core(f32x16 (&acc)[NB][2][NS], const u16* __restrict__ A, long lda, long akcs,
                  const u16* __restrict__ B0, const u16* __restrict__ B1, long ldb, int K, char* smem) {
  constexpr int A_BYTES = 256 * 128, B_BYTES = 64 * NS * 128, STAGE = A_BYTES + NB * B_BYTES;
  const int tid = otid(), lane = tid & 63, wave = tid >> 6, wm = wave >> 1, wn = wave & 1;
  const int lr = lane & 31, lh = lane >> 5, c8 = tid & 7, r0 = tid >> 3;
  const int swz = (r0 >> 1) & 7;
  const int nk = K >> 6;
#pragma unroll
  for (int b = 0; b < NB; ++b)
#pragma unroll
    for (int ms = 0; ms < 2; ++ms)
#pragma unroll
      for (int ns = 0; ns < NS; ++ns)
#pragma unroll
        for (int i = 0; i < 16; ++i) acc[b][ms][ns][i] = 0.f;

  uint4 ra0, ra1, ra2, ra3, rb0, rb1, rb2, rb3;
  ra0 = ra1 = ra2 = ra3 = rb0 = rb1 = rb2 = rb3 = make_uint4(0, 0, 0, 0);
#define GEMM_GLOAD(kt_)                                                                        \
  {                                                                                            \
    const u16* ap_ = A + (long)r0 * lda + (long)(kt_) * akcs + c8 * 8;                         \
    ra0 = *(const uint4*)(ap_);                                                                \
    ra1 = *(const uint4*)(ap_ + 64 * lda);                                                     \
    ra2 = *(const uint4*)(ap_ + 128 * lda);                                                    \
    ra3 = *(const uint4*)(ap_ + 192 * lda);                                                    \
    const u16* bp_ = B0 + (long)r0 * ldb + (kt_) * 64 + c8 * 8;                                \
    rb0 = *(const uint4*)(bp_);                                                                \
    if constexpr (NS > 1) rb1 = *(const uint4*)(bp_ + 64 * ldb);                               \
    if constexpr (NB > 1) {                                                                    \
      const u16* bq_ = B1 + (long)r0 * ldb + (kt_) * 64 + c8 * 8;                              \
      rb2 = *(const uint4*)(bq_);                                                              \
      if constexpr (NS > 1) rb3 = *(const uint4*)(bq_ + 64 * ldb);                             \
    }                                                                                          \
  }
#define GEMM_SSTORE(s_)                                                                        \
  {                                                                                            \
    char* base_ = smem + (s_) * STAGE + r0 * 128 + ((c8 ^ swz) << 4);                          \
    *(uint4*)(base_) = ra0;                                                                    \
    *(uint4*)(base_ + 64 * 128) = ra1;                                                         \
    *(uint4*)(base_ + 128 * 128) = ra2;                                                        \
    *(uint4*)(base_ + 192 * 128) = ra3;                                                        \
    *(uint4*)(base_ + A_BYTES) = rb0;                                                          \
    if constexpr (NS > 1) *(uint4*)(base_ + A_BYTES + 64 * 128) = rb1;                         \
    if constexpr (NB > 1) {                                                                    \
      *(uint4*)(base_ + A_BYTES + B_BYTES) = rb2;                                              \
      if constexpr (NS > 1) *(uint4*)(base_ + A_BYTES + B_BYTES + 64 * 128) = rb3;             \
    }                                                                                          \
  }
  __syncthreads();
  GEMM_GLOAD(0)
  GEMM_SSTORE(0)
  if (nk > 1) GEMM_GLOAD(1)
  __syncthreads();
  for (int kt = 0; kt < nk; ++kt) {
    const int s = kt & 1;
    if (kt + 1 < nk) GEMM_SSTORE(s ^ 1)
    if (kt + 2 < nk) GEMM_GLOAD(kt + 2)
    __builtin_amdgcn_sched_barrier(0);
    const char* base = smem + s * STAGE;
#pragma unroll
    for (int kk = 0; kk < 4; ++kk) {
      bf16x8 af[2], bfr[NB][NS];
#pragma unroll
      for (int ms = 0; ms < 2; ++ms) {
        const int row = wm * 64 + ms * 32 + lr, ch = kk * 2 + lh;
        af[ms] = *(const bf16x8*)(base + row * 128 + ((ch ^ ((row >> 1) & 7)) << 4));
      }
#pragma unroll
      for (int b = 0; b < NB; ++b)
#pragma unroll
        for (int ns = 0; ns < NS; ++ns) {
          const int row = wn * (32 * NS) + ns * 32 + lr, ch = kk * 2 + lh;
          bfr[b][ns] = *(const bf16x8*)(base + A_BYTES + b * B_BYTES + row * 128 + ((ch ^ ((row >> 1) & 7)) << 4));
        }
#pragma unroll
      for (int b = 0; b < NB; ++b)
#pragma unroll
        for (int ms = 0; ms < 2; ++ms)
#pragma unroll
          for (int ns = 0; ns < NS; ++ns) acc[b][ms][ns] = MFMA(af[ms], bfr[b][ns], acc[b][ms][ns]);
    }
    __syncthreads();
  }
}

#define EPI_IDS                                                                       \
  const int tid = otid(), lane = tid & 63, wave = tid >> 6, wm = wave >> 1, wn = wave & 1; \
  const int lr = lane & 31, lh = lane >> 5;                                           \
  (void)tid; (void)wm; (void)wn; (void)lr; (void)lh;

struct Job { const float* src; u16* dst; int K, N, ld; const float* ks; };

DI Job get_job(const Params& p, int l, int j) {
  u16* w = WTS(p, l);
  Job o;
  o.ks = nullptr;
  const float* win = p.in[7] + (size_t)l * D * INW;
  switch (j) {
    case 0: o.src = p.in[2] + (size_t)l * D * FF; o.dst = w + W_F1W1; o.K = D; o.N = FF; o.ld = FF; break;
    case 1: o.src = p.in[3] + (size_t)l * D * FF; o.dst = w + W_F1W3; o.K = D; o.N = FF; o.ld = FF; break;
    case 2: o.src = p.in[4] + (size_t)l * D * FF; o.dst = w + W_F1W2; o.K = FF; o.N = D; o.ld = D; break;
    case 3: o.src = p.in[35] + (size_t)l * D * FF; o.dst = w + W_F2W1; o.K = D; o.N = FF; o.ld = FF; break;
    case 4: o.src = p.in[36] + (size_t)l * D * FF; o.dst = w + W_F2W3; o.K = D; o.N = FF; o.ld = FF; break;
    case 5: o.src = p.in[37] + (size_t)l * D * FF; o.dst = w + W_F2W2; o.K = FF; o.N = D; o.ld = D; break;
    case 6: o.src = win; o.dst = w + W_IN; o.K = D; o.N = 2944; o.ld = INW; break;
    case 7: o.src = win + 2976; o.dst = w + W_IN + (size_t)2944 * D; o.K = D; o.N = 1280; o.ld = INW; break;
    case 8: o.src = win + 2944; o.dst = w + W_IN + (size_t)ZC_KROPE * D; o.K = D; o.N = 32; o.ld = INW; break;
    case 9: o.src = win + 4256; o.dst = w + W_IN + (size_t)ZC_GATE * D; o.K = D; o.N = 24; o.ld = INW; break;
    case 10: o.src = win + 4280; o.dst = w + W_IN + (size_t)ZW * D; o.K = D; o.N = 4096; o.ld = INW; break;
    case 11: o.src = p.in[13] + (size_t)l * 512 * D; o.dst = w + W_OUT4; o.K = 512; o.N = D; o.ld = D; break;
    case 12: o.src = p.in[15] + (size_t)l * 512 * D; o.dst = w + W_OUT4 + (size_t)1 * 1024 * 512; o.K = 512; o.N = D; o.ld = D; break;
    case 13: o.src = p.in[20] + (size_t)l * 512 * D; o.dst = w + W_OUT4 + (size_t)2 * 1024 * 512; o.K = 512; o.N = D; o.ld = D; break;
    case 14: o.src = p.in[25] + (size_t)l * 512 * D; o.dst = w + W_OUT4 + (size_t)3 * 1024 * 512; o.K = 512; o.N = D; o.ld = D; break;
    case 15: o.src = p.in[18] + (size_t)l * 256 * 768; o.dst = w + W_UQ; o.K = 256; o.N = 768; o.ld = 768; o.ks = p.in[16] + l * 256; break;
    case 16: o.src = p.in[19] + (size_t)l * 128 * 1024; o.dst = w + W_UKV; o.K = 128; o.N = 1024; o.ld = 1024; o.ks = p.in[17] + l * 128; break;
    case 17: o.src = p.in[26] + (size_t)l * D * D; o.dst = w + W_O; o.K = D; o.N = D; o.ld = D; break;
    case 18: o.src = p.in[29] + (size_t)l * D * 512; o.dst = w + W_XQ; o.K = D; o.N = 512; o.ld = 512; break;
    case 19: o.src = p.in[30] + (size_t)l * D * 512; o.dst = w + W_XKV; o.K = D; o.N = 512; o.ld = 512; break;
    case 20: o.src = p.in[31] + (size_t)l * D * 512; o.dst = w + W_XKV + (size_t)512 * D; o.K = D; o.N = 512; o.ld = 512; break;
    case 21: o.src = p.in[32] + (size_t)l * 512 * D; o.dst = w + W_XO; o.K = 512; o.N = D; o.ld = D; break;
    case 22: o.src = p.in[23] + (size_t)l * 2048 * 64; o.dst = w + W_CK; o.K = 1024; o.N = 64; o.ld = 64; break;
    case 23: o.src = p.in[23] + (size_t)l * 2048 * 64 + 1024 * 64; o.dst = w + W_CK + (size_t)64 * 1024; o.K = 1024; o.N = 64; o.ld = 64; break;
    case 24: o.src = p.in[24] + (size_t)l * 2048 * 64; o.dst = w + W_CV; o.K = 1024; o.N = 64; o.ld = 64; break;
    default: o.src = p.in[24] + (size_t)l * 2048 * 64 + 1024 * 64; o.dst = w + W_CV + (size_t)64 * 1024; o.K = 1024; o.N = 64; o.ld = 64; break;
  }
  return o;
}
constexpr int NJOBS = 26;

DI void conv_tiles4(const Job& jb, int t0, int tstep, int ntiles, int nkt, char* smem) {
  const int tid = otid(), kk = tid >> 3, c = tid & 7;
  float v[4][8];
#pragma unroll
  for (int u = 0; u < 4; ++u) {
    const int t = t0 + u * tstep;
#pragma unroll
    for (int e = 0; e < 8; ++e) v[u][e] = 0.f;
    if (t < ntiles) {
      const int tk = t % nkt, tn = t / nkt;
      const int k = tk * 64 + kk, n0 = tn * 64 + c * 8;
      const float* s = jb.src + (size_t)k * jb.ld + n0;
      if (n0 + 8 <= jb.N) {
        float4 a, b;
        a.x = __builtin_nontemporal_load(s); a.y = __builtin_nontemporal_load(s + 1); a.z = __builtin_nontemporal_load(s + 2); a.w = __builtin_nontemporal_load(s + 3);
        b.x = __builtin_nontemporal_load(s + 4); b.y = __builtin_nontemporal_load(s + 5); b.z = __builtin_nontemporal_load(s + 6); b.w = __builtin_nontemporal_load(s + 7);
        v[u][0] = a.x; v[u][1] = a.y; v[u][2] = a.z; v[u][3] = a.w; v[u][4] = b.x; v[u][5] = b.y; v[u][6] = b.z; v[u][7] = b.w;
      } else {
#pragma unroll
        for (int e = 0; e < 8; ++e) v[u][e] = (n0 + e < jb.N) ? s[e] : 0.f;
      }
    }
  }
#pragma unroll
  for (int u = 0; u < 4; ++u) {
    const int t = t0 + u * tstep;
    if (t < ntiles) {
      u16* Ts = (u16*)smem + u * (64 * 72);
      const float sc = jb.ks ? jb.ks[(t % nkt) * 64 + kk] : 1.f;
#pragma unroll
      for (int e = 0; e < 8; ++e) Ts[(c * 8 + e) * 72 + kk] = f2bf(v[u][e] * sc);
    }
  }
  __syncthreads();
  const int n = tid >> 3, ch = tid & 7;
#pragma unroll
  for (int u = 0; u < 4; ++u) {
    const int t = t0 + u * tstep;
    if (t < ntiles) {
      const int tk = t % nkt, tn = t / nkt;
      if (tn * 64 + n < jb.N) {
        const u16* Ts = (const u16*)smem + u * (64 * 72);
        const uint4 val = *(const uint4*)(Ts + n * 72 + ch * 8);
        *(uint4*)(jb.dst + (size_t)(tn * 64 + n) * jb.K + tk * 64 + ch * 8) = val;
      }
    }
  }
  __syncthreads();
}

DI void phase0(const Params& p, char* smem) {
  const int tid = otid();
  const size_t gtid = (size_t)blockIdx.x * NTHREADS + tid, gsz = (size_t)gridDim.x * NTHREADS;
  for (int l = 0; l < DEPTH; ++l)
    for (int j = 0; j < NJOBS; ++j) {
      Job jb = get_job(p, l, j);
      const int nkt = jb.K / 64, nnt = (jb.N + 63) / 64;
      for (int t = blockIdx.x; t < nkt * nnt; t += 4 * gridDim.x) conv_tiles4(jb, t, gridDim.x, nkt * nnt, nkt, smem);
    }
  for (int l = 0; l < DEPTH; ++l) {
    u16* w = WTS(p, l);
    float* f = F32L(p, l);
    for (size_t i = gtid; i < (size_t)72 * D; i += gsz) w[W_IN + (size_t)4280 * D + i] = 0;
    const float* gws = p.in[11] + (size_t)l * 4 * 128 * 128;
    for (size_t i = gtid; i < (size_t)4 * 128 * 128; i += gsz) {
      const int s = (int)(i & 127), t = (int)((i >> 7) & 127);
      w[W_GWS + i] = (s <= t) ? f2bf(gws[i]) : (u16)0;
    }
    const float* bin = p.in[8] + (size_t)l * INW;
    for (size_t i = gtid; i < (size_t)(ZW + 4096); i += gsz) {
      const int c = (int)i;
      float v;
      if (c < 2944) v = bin[c];
      else if (c < 4224) v = bin[c - 2944 + 2976];
      else if (c < 4256) v = bin[c - 4224 + 2944];
      else if (c < 4280) v = bin[c];
      else if (c < ZW) v = 0.f;
      else v = bin[c - ZW + 4280];
      f[F_BZ + c] = v;
    }
  }
  for (int it = blockIdx.x; it < DEPTH * 2; it += gridDim.x) {
    const int l = it >> 1, kv = it & 1;
    const float* pe = p.in[kv ? 22 : 21] + (size_t)l * 2048;
    const float* wc = p.in[kv ? 24 : 23] + (size_t)l * 2048 * 64;
    float* red = (float*)smem;
    const int e = tid & 63, part = tid >> 6;
    float a = 0.f;
    for (int i = part * 256; i < part * 256 + 256; ++i) a += pe[i] * wc[(size_t)i * 64 + e];
    __syncthreads();
    red[part * 64 + e] = a;
    __syncthreads();
    if (tid < 64) {
      float s = 0.f;
      for (int q = 0; q < 8; ++q) s += red[q * 64 + tid];
      F32L(p, l)[(kv ? F_CV : F_CK) + tid] = s;
    }
    __syncthreads();
  }
  {
    float2* t64 = TAB64(p);
    float2* t32 = TAB32(p);
    for (size_t i = gtid; i < (size_t)4096 * 48; i += gsz) {
      int pos, idx;
      float inv;
      float2* dst;
      if (i < (size_t)4096 * 32) { pos = (int)(i >> 5); idx = (int)(i & 31); inv = powf(10000.f, -(float)idx / 32.f); dst = t64 + i; }
      else { size_t k = i - (size_t)4096 * 32; pos = (int)(k >> 4); idx = (int)(k & 15); inv = powf(10000.f, -(float)idx / 16.f); dst = t32 + k; }
      const float ang = (float)pos * inv;
      const float kq = rintf(ang * 0.15915494309189535f);
      float r = fmaf(-kq, 6.2831854820251465f, ang);
      r = fmaf(-kq, -1.7484555e-7f, r);
      *dst = make_float2(__cosf(r), __sinf(r));
    }
  }
  {
    const float* x = p.in[0];
    u16* xb = XB(p);
    for (size_t i = gtid; i < (size_t)T * D / 8; i += gsz) {
      const float* s8 = x + i * 8;
      float4 a, b;
      a.x = __builtin_nontemporal_load(s8); a.y = __builtin_nontemporal_load(s8 + 1); a.z = __builtin_nontemporal_load(s8 + 2); a.w = __builtin_nontemporal_load(s8 + 3);
      b.x = __builtin_nontemporal_load(s8 + 4); b.y = __builtin_nontemporal_load(s8 + 5); b.z = __builtin_nontemporal_load(s8 + 6); b.w = __builtin_nontemporal_load(s8 + 7);
      uint4 o; o.x = pack2(a.x, a.y); o.y = pack2(a.z, a.w); o.z = pack2(b.x, b.y); o.w = pack2(b.z, b.w);
      *(uint4*)(xb + i * 8) = o;
    }
    const float* mem = p.in[1];
    u16* mb = (u16*)(PWS(p) + WS_MEMB);
    for (size_t i = gtid; i < (size_t)BATCH * MEML * D / 8; i += gsz) {
      float4 a = *(const float4*)(mem + i * 8), b = *(const float4*)(mem + i * 8 + 4);
      uint4 o; o.x = pack2(a.x, a.y); o.y = pack2(a.z, a.w); o.z = pack2(b.x, b.y); o.w = pack2(b.z, b.w);
      *(uint4*)(mb + i * 8) = o;
    }
  }
}

template <class Toff, class Setup, class Epi>
DI void gemm256_stream(int tiles_per_xcd, int K, long ais, long akcs, long bis, Toff toff, Setup setup, Epi epi, char* smem) {
  constexpr int A_BYTES = 256 * 128, STAGE = 2 * A_BYTES;
  const int tid = otid(), lane = tid & 63, wave = tid >> 6, wm = wave >> 2, wn = wave & 3;
  const int lr = lane & 31, lh = lane >> 5, c8 = tid & 7, r0 = tid >> 3, swz = (r0 >> 1) & 7;
  const int xcd = blockIdx.x & 7, jb = blockIdx.x >> 3, nj = gridDim.x >> 3;
  int q = jb;
  if (q >= tiles_per_xcd) return;
  f32x16 acc[4][2];
#pragma unroll
  for (int ms = 0; ms < 4; ++ms)
#pragma unroll
    for (int ns = 0; ns < 2; ++ns)
#pragma unroll
      for (int i = 0; i < 16; ++i) acc[ms][ns][i] = 0.f;
  const u16 *Ac, *Bc, *An = nullptr, *Bn = nullptr;
  int aoff, boff;
  toff(r0, c8, aoff, boff);
  setup(xcd, q, Ac, Bc);
  uint4 ra0, ra1, ra2, ra3, rb0, rb1, rb2, rb3;
#define G256_GLOAD(Ap_, Bp_, kt_)                                 \
  {                                                               \
    const u16* ap_ = (Ap_) + aoff + (long)(kt_) * akcs;           \
    const u16* bp_ = (Bp_) + boff + (kt_) * 64;                   \
    ra0 = *(const uint4*)(ap_);                                   \
    ra1 = *(const uint4*)(ap_ + ais);                             \
    ra2 = *(const uint4*)(ap_ + 2 * ais);                         \
    ra3 = *(const uint4*)(ap_ + 3 * ais);                         \
    rb0 = *(const uint4*)(bp_);                                   \
    rb1 = *(const uint4*)(bp_ + bis);                             \
    rb2 = *(const uint4*)(bp_ + 2 * bis);                         \
    rb3 = *(const uint4*)(bp_ + 3 * bis);                         \
  }
#define G256_SSTORE(s_)                                                       \
  {                                                                           \
    char* base_ = smem + (s_) * STAGE + r0 * 128 + ((c8 ^ swz) << 4);         \
    *(uint4*)(base_) = ra0;                                                   \
    *(uint4*)(base_ + 64 * 128) = ra1;                                        \
    *(uint4*)(base_ + 2 * 64 * 128) = ra2;                                    \
    *(uint4*)(base_ + 3 * 64 * 128) = ra3;                                    \
    *(uint4*)(base_ + A_BYTES) = rb0;                                         \
    *(uint4*)(base_ + A_BYTES + 64 * 128) = rb1;                              \
    *(uint4*)(base_ + A_BYTES + 2 * 64 * 128) = rb2;                          \
    *(uint4*)(base_ + A_BYTES + 3 * 64 * 128) = rb3;                          \
  }
#define G256_ST1(s_, kk_, RA, RB)                                                                        \
  {                                                                                                        \
    char* base_ = smem + (s_) * STAGE + r0 * 128 + ((c8 ^ swz) << 4) + (kk_) * 64 * 128;                   \
    *(uint4*)(base_) = RA;                                                                                 \
    *(uint4*)(base_ + A_BYTES) = RB;                                                                       \
  }
#define G256_LD1(Ap_, Bp_, kt_, kk_, RA, RB)                                                               \
  {                                                                                                        \
    RA = *(const uint4*)((Ap_) + aoff + (long)(kt_) * akcs + (kk_) * ais);                                 \
    RB = *(const uint4*)((Bp_) + boff + (kt_) * 64 + (kk_) * bis);                                         \
  }
#define G256_KSTEP(kk, RA, RB)                                                                             \
  {                                                                                                        \
    bf16x8 af[4], bfr[2];                                                                                  \
    const int ch = kk * 2 + lh;                                                                            \
    _Pragma("unroll") for (int ms = 0; ms < 4; ++ms) {                                                     \
      const int row = wm * 128 + ms * 32 + lr;                                                             \
      af[ms] = *(const bf16x8*)(base + row * 128 + ((ch ^ ((row >> 1) & 7)) << 4));                        \
    }                                                                                                      \
    _Pragma("unroll") for (int ns = 0; ns < 2; ++ns) {                                                     \
      const int row = wn * 64 + ns * 32 + lr;                                                              \
      bfr[ns] = *(const bf16x8*)(base + A_BYTES + row * 128 + ((ch ^ ((row >> 1) & 7)) << 4));            \
    }                                                                                                      \
    if (have1) G256_ST1(s ^ 1, kk, RA, RB)                                                                 \
    if (have2) G256_LD1(Ap2, Bp2, kt2, kk, RA, RB)                                                         \
    __builtin_amdgcn_sched_barrier(0);                                                                     \
    _Pragma("unroll") for (int ms = 0; ms < 4; ++ms)                                                       \
      _Pragma("unroll") for (int ns = 0; ns < 2; ++ns) acc[ms][ns] = MFMA(af[ms], bfr[ns], acc[ms][ns]);   \
  }
  const int nk = K >> 6;
  __syncthreads();
  G256_GLOAD(Ac, Bc, 0)
  G256_SSTORE(0)
  G256_GLOAD(Ac, Bc, 1)
  __syncthreads();
  while (true) {
    const int qn = q + nj;
    const bool has_next = qn < tiles_per_xcd;
    if (has_next) setup(xcd, qn, An, Bn);
    for (int kt = 0; kt < nk; ++kt) {
      const int s = kt & 1;
      const bool have1 = (kt + 1 < nk) || has_next;
      const bool in_cur = (kt + 2 < nk);
      const bool have2 = in_cur || (has_next && kt + 2 == nk);
      const u16* Ap2 = in_cur ? Ac : An;
      const u16* Bp2 = in_cur ? Bc : Bn;
      const int kt2 = in_cur ? kt + 2 : kt + 2 - nk;
      const char* base = smem + s * STAGE;
      G256_KSTEP(0, ra0, rb0)
      G256_KSTEP(1, ra1, rb1)
      G256_KSTEP(2, ra2, rb2)
      G256_KSTEP(3, ra3, rb3)
      __syncthreads();
    }
    epi(xcd, q, acc);
#pragma unroll
    for (int ms = 0; ms < 4; ++ms)
#pragma unroll
      for (int ns = 0; ns < 2; ++ns)
#pragma unroll
        for (int i = 0; i < 16; ++i) acc[ms][ns][i] = 0.f;
    if (!has_next) break;
    q = qn;
    Ac = An;
    Bc = Bn;
    G256_GLOAD(Ac, Bc, 1)
  }
}
#define G256_IDS
#define G256_SETUP_IDS
#define G256_EPI_IDS                                                                          \
  const int tid = otid(), lane = tid & 63, wave = tid >> 6, wm = wave >> 2, wn = wave & 3;    \
  const int lr = lane & 31, lh = lane >> 5;                                                   \
  (void)wm; (void)wn; (void)lr; (void)lh;

DI void phase_ffn_up(const Params& p, const u16* w1t, const u16* w3t, char* smem) {
  G256_IDS
  const u16* xb = XB(p);
  u16* hb = BUF(p, B_H);
  constexpr int MPX = (T / 256) / 8;
  auto setup = [&](int xcd, int q, const u16*& Ap, const u16*& Bp) __attribute__((always_inline)) {
    G256_SETUP_IDS
    const int mt = xcd * MPX + (q / (4 * (FF / 128))) * 4 + (q & 3), nt = (q >> 2) % (FF / 128);
    Ap = xb + (size_t)mt * 256 * D;
    Bp = w1t + (size_t)nt * 128 * D;
  };
  const int w3off = (int)(w3t - w1t);
  auto toff = [&](int r0, int c8, int& aoff, int& boff) __attribute__((always_inline)) {
    aoff = r0 * D + c8 * 8;
    boff = ((r0 < 32) ? 0 : w3off) + (r0 & 31) * D + c8 * 8;
  };
  auto epi = [&](int xcd, int q, f32x16 (&acc)[4][2]) __attribute__((always_inline)) {
    G256_EPI_IDS
    const int mt = xcd * MPX + (q / (4 * (FF / 128))) * 4 + (q & 3), nt = (q >> 2) % (FF / 128);
#pragma unroll
    for (int ms = 0; ms < 4; ++ms)
#pragma unroll
      for (int i = 0; i < 16; ++i) {
        const size_t row = (size_t)mt * 256 + wm * 128 + ms * 32 + crow(i, lh);
        const int col = nt * 128 + wn * 32 + lr;
        const float a = acc[ms][0][i], b = acc[ms][1][i];
        __builtin_nontemporal_store(f2bf(a * sigmoidf(a) * b), &hb[row * FF + col]);
      }
  };
  gemm256_stream(MPX * (FF / 128), D, (long)64 * D, 64, (long)32 * D, toff, setup, epi, smem);
}

DI void phase_gemm_resid(const Params& p, const u16* A, int lda, int K, const u16* Bt, bool last_sub, float scl,
                         int row0, int nrows, char* smem) {
  G256_IDS
  u16* r16 = R16(p, last_sub);
  const u16* xres = XB(p);
  const int mpx = (nrows / 256) / 8;
  auto setup = [&](int xcd, int q, const u16*& Ap, const u16*& Bp) __attribute__((always_inline)) {
    G256_SETUP_IDS
    const int mt = xcd * mpx + (q >> 5) * 8 + (q & 7), nt = (q >> 3) & 3;
    Ap = A + (size_t)mt * 256 * lda;
    Bp = Bt + (size_t)nt * 256 * K;
  };
  auto toff = [&](int r0, int c8, int& aoff, int& boff) __attribute__((always_inline)) {
    aoff = r0 * lda + c8 * 8;
    boff = r0 * K + c8 * 8;
  };
  auto epi = [&](int xcd, int q, f32x16 (&acc)[4][2]) __attribute__((always_inline)) {
    G256_EPI_IDS
    const int mt = xcd * mpx + (q >> 5) * 8 + (q & 7), nt = (q >> 3) & 3;
#pragma unroll
    for (int ms = 0; ms < 4; ++ms)
#pragma unroll
      for (int ns = 0; ns < 2; ++ns)
#pragma unroll
        for (int i = 0; i < 16; ++i) {
          const size_t row = (size_t)row0 + mt * 256 + wm * 128 + ms * 32 + crow(i, lh);
          const int col = nt * 256 + wn * 64 + ns * 32 + lr;
          __builtin_nontemporal_store(__builtin_bit_cast(u16, (_Float16)(ALPHA * bf2f(xres[row * D + col]) + scl * acc[ms][ns][i])), &r16[row * D + col]);
        }
  };
  gemm256_stream(mpx * 4, K, (long)64 * lda, 64, (long)64 * K, toff, setup, epi, smem);
}

DI void phase_ln(const Params& p, const float* g, const float* b, bool final_ln) {
  const int tid_ = otid(); const int lane = tid_ & 63, wave = tid_ >> 6;
  float* X = (float*)launder((char*)p.out);
  const u16* r16 = R16(p, final_ln);
  u16* xb = XB(p);
  float4 gg[4], bb[4];
#pragma unroll
  for (int i = 0; i < 4; ++i) { gg[i] = *(const float4*)(g + i * 256 + lane * 4); bb[i] = *(const float4*)(b + i * 256 + lane * 4); }
  for (int row = blockIdx.x * 8 + wave; row < T; row += gridDim.x * 8) {
    float* xr = X + (size_t)row * D;
    float4 v[4];
    float s = 0.f;
#pragma unroll
    for (int i = 0; i < 4; ++i) {
      const unsigned long long raw = __builtin_nontemporal_load((const unsigned long long*)(r16 + (size_t)row * D + i * 256 + lane * 4));
      v[i].x = (float)__builtin_bit_cast(_Float16, (u16)(raw & 0xffffu));
      v[i].y = (float)__builtin_bit_cast(_Float16, (u16)((raw >> 16) & 0xffffu));
      v[i].z = (float)__builtin_bit_cast(_Float16, (u16)((raw >> 32) & 0xffffu));
      v[i].w = (float)__builtin_bit_cast(_Float16, (u16)(raw >> 48));
      s += v[i].x + v[i].y + v[i].z + v[i].w;
    }
    const float mean = wave_sum(s) * (1.f / D);
    float q = 0.f;
#pragma unroll
    for (int i = 0; i < 4; ++i) {
      v[i].x -= mean; v[i].y -= mean; v[i].z -= mean; v[i].w -= mean;
      q += v[i].x * v[i].x + v[i].y * v[i].y + v[i].z * v[i].z + v[i].w * v[i].w;
    }
    const float rstd = rsqrtf(wave_sum(q) * (1.f / D) + 1e-5f);
#pragma unroll
    for (int i = 0; i < 4; ++i) {
      float4 o;
      o.x = v[i].x * rstd * gg[i].x + bb[i].x; o.y = v[i].y * rstd * gg[i].y + bb[i].y;
      o.z = v[i].z * rstd * gg[i].z + bb[i].z; o.w = v[i].w * rstd * gg[i].w + bb[i].w;
      if (final_ln) *(float4*)(xr + i * 256 + lane * 4) = o;
      uint2 pk; pk.x = pack2(o.x, o.y); pk.y = pack2(o.z, o.w);
      *(uint2*)(xb + (size_t)row * D + i * 256 + lane * 4) = pk;
    }
  }
}

DI void phase_m1(const Params& p, int l, int grp, char* smem) {
  G256_IDS
  const u16* xb = XB(p) + (size_t)grp * TG * D;
  const u16* wt = WTS(p, l) + W_IN;
  const float* bz = F32L(p, l) + F_BZ;
  u16* z = BUF(p, B_Z);
  u16* vst = BUF(p, B_VST);
  u16* vwt = BUF(p, B_VWT);
  const float2* t64 = TAB64(p);
  const float2* t32 = TAB32(p);
  constexpr int MPX = (TG / 256) / 8, NT = ZW / 256;
  auto setup = [&](int xcd, int q, const u16*& Ap, const u16*& Bp) __attribute__((always_inline)) {
    G256_SETUP_IDS
    const int mt = xcd * MPX + q % MPX, nt = q / MPX;
    Ap = xb + (size_t)mt * 256 * D;
    Bp = wt + (size_t)nt * 256 * D;
  };
  auto toff = [&](int r0, int c8, int& aoff, int& boff) __attribute__((always_inline)) {
    aoff = r0 * D + c8 * 8;
    boff = r0 * D + c8 * 8;
  };
  auto epi = [&](int xcd, int q, f32x16 (&acc)[4][2]) __attribute__((always_inline)) {
    G256_EPI_IDS
    const int mt = xcd * MPX + q % MPX, nt = q / MPX;
    const int cb0 = nt * 256 + wn * 64;
    const int sec = cb0 >> 7, kvg = (cb0 >> 6) & 1;
    const float bias0 = bz[cb0 + lr], bias1 = bz[cb0 + 32 + lr];
    const bool rope64 = (sec >= 23 && sec < 27) || sec == 29 || sec == 31;
    const bool vtr = (sec == 30) || (sec == 32);
    if (vtr) {
      u16* vt = (sec == 30) ? vst : vwt;
#pragma unroll
      for (int ms = 0; ms < 4; ++ms)
#pragma unroll
        for (int ns = 0; ns < 2; ++ns)
#pragma unroll
          for (int gq = 0; gq < 4; ++gq) {
            const int row = mt * 256 + wm * 128 + ms * 32 + 8 * gq + 4 * lh;
            const int bl = row >> 12, s = row & 4095;
            const int dv = ns * 32 + lr;
            const float bs = ns ? bias1 : bias0;
            uint2 pk;
            pk.x = pack2(acc[ms][ns][4 * gq] + bs, acc[ms][ns][4 * gq + 1] + bs);
            pk.y = pack2(acc[ms][ns][4 * gq + 2] + bs, acc[ms][ns][4 * gq + 3] + bs);
            *(uint2*)(vt + ((size_t)(bl * 2 + kvg) * 64 + dv) * SEQ + s) = pk;
          }
    } else if (rope64) {
#pragma unroll
      for (int ms = 0; ms < 4; ++ms)
#pragma unroll
        for (int i = 0; i < 16; ++i) {
          const int row = mt * 256 + wm * 128 + ms * 32 + crow(i, lh);
          const int pos = row & 4095;
          const float2 cs = t64[pos * 32 + lr];
          const float x1 = acc[ms][0][i] + bias0, x2 = acc[ms][1][i] + bias1;
          z[(size_t)row * ZW + cb0 + lr] = f2bf(x1 * cs.x - x2 * cs.y);
          z[(size_t)row * ZW + cb0 + 32 + lr] = f2bf(x1 * cs.y + x2 * cs.x);
        }
    } else {
      const bool rope32 = (cb0 == ZC_KROPE);
#pragma unroll
      for (int ms = 0; ms < 4; ++ms)
#pragma unroll
        for (int ns = 0; ns < 2; ++ns)
#pragma unroll
          for (int i = 0; i < 16; ++i) {
            const int row = mt * 256 + wm * 128 + ms * 32 + crow(i, lh);
            float v = acc[ms][ns][i] + (ns ? bias1 : bias0);
            if (rope32 && ns == 0) {
              const float pr = __shfl_xor(v, 16);
              const float2 cs = t32[(row & 4095) * 16 + (lr & 15)];
              v = (lr < 16) ? (v * cs.x - pr * cs.y) : (pr * cs.y + v * cs.x);
            }
            z[(size_t)row * ZW + cb0 + ns * 32 + lr] = f2bf(v);
          }
    }
  };
  gemm256_stream(MPX * NT, D, (long)64 * D, 64, (long)64 * D, toff, setup, epi, smem);
}

DI void m2_gmlp_ln(const Params& p, int l, int chunk, char* smem) {
  const int tid = otid(), s = tid & 127, cgi = tid >> 7;
  const u16* z = BUF(p, B_Z);
  u16* vl = BUF(p, B_VLNT);
  const float* lg = p.in[9] + (size_t)l * 512 + cgi * 128;
  const float* lb = p.in[10] + (size_t)l * 512 + cgi * 128;
  float* red = (float*)smem;
  const u16* src = z + (size_t)(chunk * 128 + s) * ZW + ZC_V + cgi * 128;
  uint4 v[16];
  float sm = 0.f, sq = 0.f;
#pragma unroll
  for (int i = 0; i < 16; ++i) {
    v[i] = *(const uint4*)(src + i * 8);
    const unsigned w[4] = {v[i].x, v[i].y, v[i].z, v[i].w};
#pragma unroll
    for (int e = 0; e < 4; ++e) {
      const float a = __uint_as_float(w[e] << 16), b = __uint_as_float(w[e] & 0xffff0000u);
      sm += a + b; sq += a * a + b * b;
    }
  }
  __syncthreads();
  red[cgi * 128 + s] = sm;
  red[512 + cgi * 128 + s] = sq;
  __syncthreads();
  const float ts = red[s] + red[128 + s] + red[256 + s] + red[384 + s];
  const float tq = red[512 + s] + red[640 + s] + red[768 + s] + red[896 + s];
  const float mean = ts * (1.f / 512.f);
  const float var = fmaxf(tq * (1.f / 512.f) - mean * mean, 0.f);
  const float rstd = rsqrtf(var + 1e-5f);
  u16* dst = vl + ((size_t)cgi * TG + (size_t)chunk * 128) * 128 + s;
#pragma unroll
  for (int i = 0; i < 16; ++i) {
    const unsigned w[4] = {v[i].x, v[i].y, v[i].z, v[i].w};
#pragma unroll
    for (int e = 0; e < 4; ++e) {
      const float a = __uint_as_float(w[e] << 16), b = __uint_as_float(w[e] & 0xffff0000u);
      const int d0 = i * 8 + e * 2;
      dst[(size_t)d0 * 128] = f2bf((a - mean) * rstd * lg[d0] + lb[d0]);
      dst[(size_t)(d0 + 1) * 128] = f2bf((b - mean) * rstd * lg[d0 + 1] + lb[d0 + 1]);
    }
  }
  __syncthreads();
}

DI void m2_conv(const Params& p, int l, int item) {
  const int tid = otid();
  const u16* z = BUF(p, B_Z);
  u16* P = BUF(p, B_P);
  const float* cw = p.in[14] + (size_t)l * 3 * 512;
#pragma unroll 1
  for (int i = 0; i < 8; ++i) {
    const int vi = tid + 512 * i, tok = item * 64 + (vi >> 6), c0 = (vi & 63) * 8;
    const int s = tok & 4095;
    float y[8];
#pragma unroll
    for (int e = 0; e < 8; ++e) y[e] = 0.f;
#pragma unroll
    for (int k = 0; k < 3; ++k) {
      if (s - 2 + k >= 0) {
        const u16* zr = z + (size_t)(tok - 2 + k) * ZW;
        const uint4 c = *(const uint4*)(zr + ZC_CC + c0), h = *(const uint4*)(zr + ZC_CH + c0);
        const unsigned cwd[4] = {c.x, c.y, c.z, c.w}, hwd[4] = {h.x, h.y, h.z, h.w};
#pragma unroll
        for (int e = 0; e < 4; ++e) {
          const float c_lo = __uint_as_float(cwd[e] << 16), c_hi = __uint_as_float(cwd[e] & 0xffff0000u);
          const float h_lo = __uint_as_float(hwd[e] << 16), h_hi = __uint_as_float(hwd[e] & 0xffff0000u);
          y[2 * e] += c_lo * h_lo * cw[k * 512 + c0 + 2 * e];
          y[2 * e + 1] += c_hi * h_hi * cw[k * 512 + c0 + 2 * e + 1];
        }
      }
    }
    const uint4 b = *(const uint4*)(z + (size_t)tok * ZW + ZC_CB + c0);
    const unsigned bwd[4] = {b.x, b.y, b.z, b.w};
    uint4 o;
    unsigned ow[4];
#pragma unroll
    for (int e = 0; e < 4; ++e)
      ow[e] = pack2(__uint_as_float(bwd[e] << 16) * y[2 * e], __uint_as_float(bwd[e] & 0xffff0000u) * y[2 * e + 1]);
    o.x = ow[0]; o.y = ow[1]; o.z = ow[2]; o.w = ow[3];
    *(uint4*)(P + (size_t)tok * 2048 + 512 + c0) = o;
  }
}

constexpr int RS_OFF = 132 * 1024;
template <int W>
DI void row_rstd(const u16* z, int m0, int c0, char* smem) {
  const int tid = otid(), r = tid >> 1, hf = tid & 1;
  const u16* src = z + (size_t)(m0 + r) * ZW + c0 + hf * (W / 2);
  float sq = 0.f;
#pragma unroll
  for (int i = 0; i < W / 16; ++i) {
    const uint4 v = *(const uint4*)(src + i * 8);
    const unsigned w[4] = {v.x, v.y, v.z, v.w};
#pragma unroll
    for (int e = 0; e < 4; ++e) {
      const float a = __uint_as_float(w[e] << 16), b = __uint_as_float(w[e] & 0xffff0000u);
      sq += a * a + b * b;
    }
  }
  sq += __shfl_xor(sq, 1);
  __syncthreads();
  if (hf == 0) ((float*)(smem + RS_OFF))[r] = rsqrtf(sq * (1.f / W) + 1e-6f);
  __syncthreads();
}

DI void m2_mla_q(const Params& p, int l, int mt, int nt, char* smem) {
  EPI_IDS
  const u16* z = BUF(p, B_Z);
  u16* qb = BUF(p, B_QB);
  const float2* t32 = TAB32(p);
  row_rstd<256>(z, mt * 256, ZC_QLAT, smem);
  f32x16 acc[1][2][2];
  gemm_core<1, 2>(acc, z + (size_t)mt * 256 * ZW + ZC_QLAT, ZW, 64, WTS(p, l) + W_UQ + (size_t)nt * 128 * 256, nullptr, 256, 256, smem);
  const float* rs = (const float*)(smem + RS_OFF);
#pragma unroll
  for (int ms = 0; ms < 2; ++ms)
#pragma unroll
    for (int ns = 0; ns < 2; ++ns) {
      const int cbase = nt * 128 + wn * 64 + ns * 32;
      const bool rope = ((cbase >> 5) % 3) == 2;
#pragma unroll
      for (int i = 0; i < 16; ++i) {
        const int rl = wm * 64 + ms * 32 + crow(i, lh), row = mt * 256 + rl;
        float v = acc[0][ms][ns][i] * rs[rl];
        if (rope) {
          const float pr = __shfl_xor(v, 16);
          const float2 cs = t32[(row & 4095) * 16 + (lr & 15)];
          v = (lr < 16) ? (v * cs.x - pr * cs.y) : (pr * cs.y + v * cs.x);
        }
        qb[(size_t)row * 768 + cbase + lr] = f2bf(v);
      }
    }
}

DI void m2_mla_kv(const Params& p, int l, int mt, int nt, char* smem) {
  EPI_IDS
  const u16* z = BUF(p, B_Z);
  u16* kb = BUF(p, B_KB);
  u16* vt = BUF(p, B_VT);
  row_rstd<128>(z, mt * 256, ZC_KVLAT, smem);
  f32x16 acc[1][2][2];
  gemm_core<1, 2>(acc, z + (size_t)mt * 256 * ZW + ZC_KVLAT, ZW, 64, WTS(p, l) + W_UKV + (size_t)nt * 128 * 128, nullptr, 128, 128, smem);
  const float* rs = (const float*)(smem + RS_OFF);
  if (wn == 0) {
#pragma unroll
    for (int ms = 0; ms < 2; ++ms)
#pragma unroll
      for (int ns = 0; ns < 2; ++ns)
#pragma unroll
        for (int i = 0; i < 16; ++i) {
          const int rl = wm * 64 + ms * 32 + crow(i, lh), row = mt * 256 + rl;
          kb[(size_t)row * 768 + nt * 96 + ns * 32 + lr] = f2bf(acc[0][ms][ns][i] * rs[rl]);
        }
  } else {
#pragma unroll
    for (int ms = 0; ms < 2; ++ms)
#pragma unroll
      for (int ns = 0; ns < 2; ++ns)
#pragma unroll
        for (int gq = 0; gq < 4; ++gq) {
          const int rl = wm * 64 + ms * 32 + 8 * gq + 4 * lh, row = mt * 256 + rl;
          const int bl = row >> 12, s = row & 4095, dv = ns * 32 + lr;
          uint2 pk;
          pk.x = pack2(acc[0][ms][ns][4 * gq] * rs[rl], acc[0][ms][ns][4 * gq + 1] * rs[rl + 1]);
          pk.y = pack2(acc[0][ms][ns][4 * gq + 2] * rs[rl + 2], acc[0][ms][ns][4 * gq + 3] * rs[rl + 3]);
          *(uint2*)(vt + ((size_t)(bl * 8 + nt) * 64 + dv) * SEQ + s) = pk;
        }
  }
#pragma unroll
  for (int i = 0; i < 2; ++i) {
    const int ci = tid + 512 * i, r = ci >> 2, c = ci & 3;
    const size_t row = (size_t)mt * 256 + r;
    *(uint4*)(kb + row * 768 + nt * 96 + 64 + c * 8) = *(const uint4*)(z + row * ZW + ZC_KROPE + c * 8);
  }
}

DI void m2_uv(const Params& p, int l, int it, char* smem) {
  EPI_IDS
  const int kv = it >> 3, g = (it >> 2) & 1, mt = it & 3;
  const u16* z = BUF(p, B_Z);
  float* uv = (float*)(PWS(p) + WS_BIG + B_UV) + ((size_t)(kv * 2 + g) * (TG / 16)) * 128;
  f32x16 acc[1][2][2];
  gemm_core<1, 2>(acc, z + (size_t)mt * 256 * 16 * ZW + (kv ? ZC_NVC : ZC_NKC) + g * 64, (long)16 * ZW, ZW,
                  WTS(p, l) + (kv ? W_CV : W_CK), nullptr, 1024, 1024, smem);
#pragma unroll
  for (int ms = 0; ms < 2; ++ms)
#pragma unroll
    for (int ns = 0; ns < 2; ++ns)
#pragma unroll
      for (int i = 0; i < 16; ++i) {
        const int seg = mt * 256 + wm * 64 + ms * 32 + crow(i, lh), col = wn * 64 + ns * 32 + lr;
        uv[(size_t)seg * 128 + col] = acc[0][ms][ns][i];
      }
}

DI void m2_xkv(const Params& p, int l, int it, char* smem) {
  EPI_IDS
  const int mt = it >> 3, nt = it & 7;
  const u16* mb = (const u16*)(PWS(p) + WS_MEMB);
  u16* kx = (u16*)(PWS(p) + WS_KX);
  u16* vxt = (u16*)(PWS(p) + WS_VXT);
  f32x16 acc[1][2][2];
  gemm_core<1, 2>(acc, mb + (size_t)mt * 256 * D, D, 64, WTS(p, l) + W_XKV + (size_t)nt * 128 * D, nullptr, D, D, smem);
  if (nt < 4) {
#pragma unroll
    for (int ms = 0; ms < 2; ++ms)
#pragma unroll
      for (int ns = 0; ns < 2; ++ns)
#pragma unroll
        for (int i = 0; i < 16; ++i) {
          const size_t row = (size_t)mt * 256 + wm * 64 + ms * 32 + crow(i, lh);
          kx[row * 512 + nt * 128 + wn * 64 + ns * 32 + lr] = f2bf(acc[0][ms][ns][i]);
        }
  } else {
    const int hx = nt - 4;
#pragma unroll
    for (int ms = 0; ms < 2; ++ms)
#pragma unroll
      for (int ns = 0; ns < 2; ++ns)
#pragma unroll
        for (int gq = 0; gq < 4; ++gq) {
          const int mrow = wm * 64 + ms * 32 + 8 * gq + 4 * lh;
          const int dv = wn * 64 + ns * 32 + lr;
          uint2 pk;
          pk.x = pack2(acc[0][ms][ns][4 * gq], acc[0][ms][ns][4 * gq + 1]);
          pk.y = pack2(acc[0][ms][ns][4 * gq + 2], acc[0][ms][ns][4 * gq + 3]);
          *(uint2*)(vxt + ((size_t)(mt * 4 + hx) * 128 + dv) * MEML + mrow) = pk;
        }
  }
}

constexpr int M2_NQ = (TG / 256) * 6, M2_NKV = (TG / 256) * 8, M2_NUV = 16, M2_NLN = TG / 128, M2_NCONV = TG / 64;
DI void phase_m2(const Params& p, int l, int grp, char* smem) {
  constexpr int TOT = M2_NKV + M2_NQ + M2_NUV + M2_NLN + M2_NCONV;
  const int nx = (grp == 0) ? 64 : 0;
  for (int t = blockIdx.x; t < TOT + nx; t += gridDim.x) {
    int it = t;
    if (it >= TOT) { m2_xkv(p, l, it - TOT, smem); continue; }
    if (it < M2_NUV) { m2_uv(p, l, it, smem); continue; }
    it -= M2_NUV;
    if (it < M2_NQ) { m2_mla_q(p, l, it / 6, it % 6, smem); continue; }
    it -= M2_NQ;
    if (it < M2_NKV) { m2_mla_kv(p, l, it >> 3, it & 7, smem); continue; }
    it -= M2_NKV;
    if (it < M2_NLN) { m2_gmlp_ln(p, l, it, smem); continue; }
    it -= M2_NLN;
    m2_conv(p, l, it);
  }
}

template <int DK, int DV>
struct FA {
  static constexpr int KSTR = DK * 2 + 16, VSTR = 144, KBYTES = 64 * KSTR, VBYTES = DV * VSTR, STAGE = KBYTES + VBYTES;
  static constexpr int KCH = 64 * DK / 8, VCH = DV * 8, KN = (KCH + 511) / 512, VN = (VCH + 511) / 512;
};
template <int DK, int DV, int MODE>
DI bool fa_active(int kb, int wave_qmax, unsigned long long sel) {
  bool active = true;
  if (MODE != 0) active = (kb * 64 <= wave_qmax);
  if (MODE == 2) {
    const bool selbit = (sel >> kb) & 1ull;
    if (__ballot(selbit) == 0ull) active = false;
  }
  return active;
}
template <int DK, int DV, int MODE>
DI void fa_qk(f32x16 (&S)[2], const bf16x8 (&q)[DK / 16], const char* base, int lr, int lh) {
  using C = FA<DK, DV>;
#pragma unroll
  for (int ks = 0; ks < 2; ++ks) {
#pragma unroll
    for (int kk = 0; kk < DK / 16; ++kk) {
      const bf16x8 kf = *(const bf16x8*)(base + (ks * 32 + lr) * C::KSTR + (kk * 2 + lh) * 16);
      if (kk == 0) {
#pragma unroll
        for (int i = 0; i < 16; ++i) S[ks][i] = 0.f;
      }
      S[ks] = MFMA(kf, q[kk], S[ks]);
    }
  }
}
template <int DK, int DV, int MODE>
DI void fa_softmax_pv(f32x16 (&S)[2], float& m, float& l, f32x16 (&O)[DV / 32], float scale, const char* base, int kb,
                      int qpos, int wave_qmax, unsigned long long sel, int lr, int lh, int variant = 0) {
  using C = FA<DK, DV>;
  bool selbit = true;
  bool need_mask = false;
  if (MODE != 0) need_mask = (kb * 64 + 63 > wave_qmax - 31);
  if (MODE == 2) selbit = (sel >> kb) & 1ull;
  if (MODE == 3) need_mask = need_mask || (kb * 64 <= wave_qmax - 512);
  const float c2 = scale * 1.4426950408889634f;
  if (need_mask) {
#pragma unroll
    for (int ks = 0; ks < 2; ++ks)
#pragma unroll
      for (int i = 0; i < 16; ++i) {
        const int key = kb * 64 + ks * 32 + crow(i, lh);
        bool valid = key <= qpos;
        if (MODE == 2) valid = valid && selbit;
        if (MODE == 3) valid = valid && (qpos - key < 512);
        S[ks][i] = valid ? S[ks][i] : -1e30f;
      }
  }
  float mx = fmaxf(S[0][0], S[0][1]);
#pragma unroll
  for (int ks = 0; ks < 2; ++ks)
#pragma unroll
    for (int i = (ks ? 0 : 2); i < 16; i += 2) mx = fmaxf(fmaxf(mx, S[ks][i]), S[ks][i + 1]);
  mx = fmaxf(mx, __shfl_xor(mx, 32));
  if (MODE == 2) mx = selbit ? mx : -1e30f;
  const float mn = fmaxf(m, mx);
  if (__any((mn - m) * c2 > 8.f)) {
    const float alpha = __builtin_amdgcn_exp2f((m - mn) * c2);
    m = mn;
    l *= alpha;
#pragma unroll
    for (int d = 0; d < DV / 32; ++d) O[d] = O[d] * alpha;
  }
  float mc = m * c2;
  if (MODE == 2) mc = selbit ? mc : 1e30f;
  const f32x2v c2v = {c2, c2}, mcv = {-mc, -mc};
  f32x2v rs2 = {0.f, 0.f};
#pragma unroll
  for (int ks = 0; ks < 2; ++ks)
#pragma unroll
    for (int st = 0; st < 2; ++st) {
      union { unsigned u[4]; bf16x8 v; } pf;
#pragma unroll
      for (int j = 0; j < 4; ++j) {
        const int i0 = 8 * st + 2 * j;
        f32x2v t = {S[ks][i0], S[ks][i0 + 1]};
        t = __builtin_elementwise_fma(t, c2v, mcv);
        f32x2v pv;
        if (variant == 1) { pv = t; } else {
        pv.x = __builtin_amdgcn_exp2f(t.x);
        pv.y = __builtin_amdgcn_exp2f(t.y);
        }
        if (MODE != 0) {
          if (need_mask) {
            pv.x = (S[ks][i0] > -1e29f) ? pv.x : 0.f;
            pv.y = (S[ks][i0 + 1] > -1e29f) ? pv.y : 0.f;
          }
        }
        rs2 += pv;
        pf.u[j] = __builtin_bit_cast(unsigned, __builtin_convertvector(pv, hwbf16x2));
      }
#pragma unroll
      for (int d = 0; d < DV / 32; ++d) {
        const char* vp = base + C::KBYTES + (d * 32 + lr) * C::VSTR + (ks * 32 + 16 * st + 4 * lh) * 2;
        const s16x4 lo = *(const s16x4*)vp, hi = *(const s16x4*)(vp + 16);
        const bf16x8 vf = __builtin_shufflevector(lo, hi, 0, 1, 2, 3, 4, 5, 6, 7);
        O[d] = MFMA(vf, pf.v, O[d]);
      }
    }
  float rs = rs2.x + rs2.y;
  rs += __shfl_xor(rs, 32);
  l += rs;
}

template <int N> DI void wait_vmcnt() { asm volatile("s_waitcnt vmcnt(%0)" ::"n"(N) : "memory"); }
DI void raw_barrier() {
  asm volatile("s_waitcnt lgkmcnt(0)" ::: "memory");
  __builtin_amdgcn_s_barrier();
  asm volatile("" ::: "memory");
}
template <int DK, int DV, int MODE>
DI void flash_loop(float& m, float& l, f32x16 (&O)[DV / 32], const bf16x8 (&q)[DK / 16], float scale,
                   const u16* __restrict__ Kp, long ldk, const u16* __restrict__ VTp, long ldvt, int kb0, int kb1,
                   int qpos, int wave_qmax, unsigned long long sel, char* smem, int variant = 0) {
  using C = FA<DK, DV>;
  constexpr int KC = C::KSTR / 16, NCH = C::STAGE / 16, NW = NCH / 64, NI = (NW + 7) / 8;
  constexpr int NST = (C::STAGE * 4 <= 100 * 1024) ? 4 : 3;
  static_assert(NCH % 64 == 0 && (64 * KC) % 64 == 0 && NI <= 5, "piece layout");
  const int tid = otid(), lane = tid & 63, wave = tid >> 6, lr = lane & 31, lh = lane >> 5;
  const int ntile = kb1 - kb0;
  __syncthreads();
  if (ntile <= 0) return;
  const u16* src[5];
  long stp[5];
  int ldo[5];
#pragma unroll
  for (int i = 0; i < 5; ++i) {
    src[i] = Kp; stp[i] = 0; ldo[i] = 0;
    if (i < NI) {
      int w_ = i * 8 + wave;
      if (w_ > NW - 1) w_ = NW - 1;
      const int L = w_ * 64 + lane;
      if (w_ < KC) {
        const int row = L / KC;
        int c = L % KC;
        if (c > DK / 8 - 1) c = DK / 8 - 1;
        src[i] = Kp + (long)(kb0 * 64 + row) * ldk + c * 8;
        stp[i] = 64 * ldk;
      } else {
        const int L2 = L - 64 * KC, row = L2 / 9;
        int c = L2 % 9;
        if (c > 7) c = 7;
        src[i] = VTp + (long)row * ldvt + kb0 * 64 + c * 8;
        stp[i] = 64;
      }
      ldo[i] = w_ * 1024;
    }
  }
#define FA_ISSUE(t_, stage_)                                                                              \
  {                                                                                                       \
    _Pragma("unroll") for (int i = 0; i < NI; ++i)                                                        \
        __builtin_amdgcn_global_load_lds((const unsigned*)(src[i] + (long)(t_) * stp[i]),                 \
                                         (unsigned*)(smem + (stage_) * C::STAGE + ldo[i]), 16, 0, 0);      \
  }
  asm volatile("s_waitcnt vmcnt(0)" ::: "memory");
#pragma unroll
  for (int t = 0; t < NST - 1; ++t)
    if (t < ntile) FA_ISSUE(t, t)
  int stage = 0;
  for (int t = 0; t < ntile; ++t) {
    int ahead = ((ntile < t + NST - 1) ? ntile : t + NST - 1) - (t + 1);
    if (NST == 4 && ahead >= 2) wait_vmcnt<2 * NI>();
    else if (ahead >= 1) wait_vmcnt<NI>();
    else wait_vmcnt<0>();
    raw_barrier();
    if (t + NST - 1 < ntile) {
      const int sn = (stage == 0) ? NST - 1 : stage - 1;
      FA_ISSUE(t + NST - 1, sn)
    }
    const int kb = kb0 + t;
    if (fa_active<DK, DV, MODE>(kb, wave_qmax, sel)) {
      f32x16 S[2];
      const char* base = smem + stage * C::STAGE;
      fa_qk<DK, DV, MODE>(S, q, base, lr, lh);
      fa_softmax_pv<DK, DV, MODE>(S, m, l, O, scale, base, kb, qpos, wave_qmax, sel, lr, lh, variant);
    }
    stage = (stage == NST - 1) ? 0 : stage + 1;
  }
  raw_barrier();
}

DI void mla_item(const Params& p, int bl, int h, int qt, char* smem, int variant = 0) {
  const int tid = otid(), lane = tid & 63, wave = tid >> 6, lr = lane & 31, lh = lane >> 5;
  const u16* qb = BUF(p, B_QB);
  const u16* kb = BUF(p, B_KB);
  const u16* vt = BUF(p, B_VT);
  u16* P = BUF(p, B_P);
  const int wq0 = qt * 256 + wave * 32, qpos = wq0 + lr;
  const size_t tok = (size_t)bl * SEQ + qpos;
  bf16x8 q[6];
#pragma unroll
  for (int kk = 0; kk < 6; ++kk) q[kk] = *(const bf16x8*)(qb + tok * 768 + h * 96 + kk * 16 + lh * 8);
  float m = -1e30f, l = 0.f;
  f32x16 O[2];
#pragma unroll
  for (int d = 0; d < 2; ++d)
#pragma unroll
    for (int i = 0; i < 16; ++i) O[d][i] = 0.f;
  flash_loop<96, 64, 1>(m, l, O, q, 0.10206207261596577f, kb + (size_t)bl * SEQ * 768 + h * 96, 768,
                        vt + ((size_t)(bl * 8 + h) * 64) * SEQ, SEQ, 0, 4 * (qt + 1), qpos, wq0 + 31, 0ull, smem, variant);
  if (variant != 0 && l > -1e38f) return;
  const float inv = 1.f / l;
#pragma unroll
  for (int d = 0; d < 2; ++d)
#pragma unroll
    for (int gq = 0; gq < 4; ++gq) {
      uint2 pk;
      pk.x = pack2(O[d][4 * gq] * inv, O[d][4 * gq + 1] * inv);
      pk.y = pack2(O[d][4 * gq + 2] * inv, O[d][4 * gq + 3] * inv);
      *(uint2*)(P + tok * 2048 + 1024 + h * 64 + d * 32 + 8 * gq + 4 * lh) = pk;
    }
}

constexpr int NSA_KC_OFF = 0, NSA_VC_OFF = 36864, NSA_IMP_OFF = 36864 + 33792, NSA_SEL_OFF = 137216;
constexpr int VCSTR = 528;
DI void nsa_item(const Params& p, int l, int bl, int g, int jq, char* smem) {
  const int tid = otid(), lane = tid & 63, wave = tid >> 6, lr = lane & 31, lh = lane >> 5;
  const int hh = wave & 3, qs = wave >> 2;
  const int q0 = jq * 64, qloc = qs * 32 + lr, qpos = q0 + qloc;
  const int head = g * 4 + hh;
  const size_t tokbase = (size_t)bl * SEQ;
  const u16* z = BUF(p, B_Z);
  u16* P = BUF(p, B_P);
  const float scale = 0.125f;
  char* sKc = smem + NSA_KC_OFF;
  char* sVc = smem + NSA_VC_OFF;
  float* sImp = (float*)(smem + NSA_IMP_OFF);
  unsigned char* sSel = (unsigned char*)(smem + NSA_SEL_OFF);

  bf16x8 q[4];
#pragma unroll
  for (int kk = 0; kk < 4; ++kk) q[kk] = *(const bf16x8*)(z + (tokbase + qpos) * ZW + ZC_NQ + head * 64 + kk * 16 + lh * 8);

  const int ncnt = min(255, (q0 + 32) / 16 + 1);
  const int ntile = (ncnt + 63) >> 6;
  __syncthreads();
  {
    const float* uvb = (const float*)(PWS(p) + WS_BIG + B_UV);
    const float* UVk = uvb + ((size_t)(0 * 2 + g) * (TG / 16) + (size_t)bl * 256) * 128;
    const float* UVv = uvb + ((size_t)(1 * 2 + g) * (TG / 16) + (size_t)bl * 256) * 128;
    const float* ck = F32L(p, l) + F_CK;
    const float* cv = F32L(p, l) + F_CV;
    const float2* t64 = TAB64(p);
    for (int idx = tid; idx < ntile * 64 * 32; idx += NTHREADS) {
      const int n = idx >> 5, e = idx & 31;
      float r1 = 0.f, r2 = 0.f, v1 = 0.f, v2 = 0.f;
      if (n < 255) {
        const float k1 = UVk[n * 128 + e] + UVk[(n + 1) * 128 + 64 + e] + ck[e];
        const float k2 = UVk[n * 128 + e + 32] + UVk[(n + 1) * 128 + 96 + e] + ck[e + 32];
        v1 = UVv[n * 128 + e] + UVv[(n + 1) * 128 + 64 + e] + cv[e];
        v2 = UVv[n * 128 + e + 32] + UVv[(n + 1) * 128 + 96 + e] + cv[e + 32];
        const float2 cs = t64[(16 * n + 31) * 32 + e];
        r1 = k1 * cs.x - k2 * cs.y;
        r2 = k1 * cs.y + k2 * cs.x;
      }
      *(u16*)(sKc + n * 144 + e * 2) = f2bf(r1);
      *(u16*)(sKc + n * 144 + (e + 32) * 2) = f2bf(r2);
      *(u16*)(sVc + e * VCSTR + n * 2) = f2bf(v1);
      *(u16*)(sVc + (e + 32) * VCSTR + n * 2) = f2bf(v2);
    }
    for (int idx = tid; idx < 4 * 64 * 65; idx += NTHREADS) sImp[idx] = 0.f;
  }
  __syncthreads();

  float mc = -1e30f, lc = 0.f;
#pragma unroll 1
  for (int t = 0; t < ntile; ++t) {
    f32x16 S[2];
    float mx = -1e30f;
#pragma unroll
    for (int ks = 0; ks < 2; ++ks) {
#pragma unroll
      for (int i = 0; i < 16; ++i) S[ks][i] = 0.f;
#pragma unroll
      for (int kk = 0; kk < 4; ++kk) {
        const bf16x8 kf = *(const bf16x8*)(sKc + (t * 64 + ks * 32 + lr) * 144 + (kk * 2 + lh) * 16);
        S[ks] = MFMA(kf, q[kk], S[ks]);
      }
#pragma unroll
      for (int i = 0; i < 16; ++i) {
        const int n = t * 64 + ks * 32 + crow(i, lh);
        const float tv = (16 * n + 31 <= qpos) ? S[ks][i] * scale : -1e30f;
        S[ks][i] = tv;
        mx = fmaxf(mx, tv);
      }
    }
    mx = fmaxf(mx, __shfl_xor(mx, 32));
    const float mn = fmaxf(mc, mx);
    float rs = 0.f;
#pragma unroll
    for (int ks = 0; ks < 2; ++ks)
#pragma unroll
      for (int i = 0; i < 16; ++i) rs += (S[ks][i] > -1e29f) ? __expf(S[ks][i] - mn) : 0.f;
    rs += __shfl_xor(rs, 32);
    lc = lc * __expf(mc - mn) + rs;
    mc = mn;
  }
  const float invl = (lc > 0.f) ? 1.f / lc : 0.f;

  f32x16 Oo[2];
#pragma unroll
  for (int d = 0; d < 2; ++d)
#pragma unroll
    for (int i = 0; i < 16; ++i) Oo[d][i] = 0.f;
#pragma unroll
  for (int t = 0; t < 4; ++t) {
    if (t < ntile) {
#pragma unroll
      for (int ks = 0; ks < 2; ++ks) {
        f32x16 S;
#pragma unroll
        for (int i = 0; i < 16; ++i) S[i] = 0.f;
#pragma unroll
        for (int kk = 0; kk < 4; ++kk) {
          const bf16x8 kf = *(const bf16x8*)(sKc + (t * 64 + ks * 32 + lr) * 144 + (kk * 2 + lh) * 16);
          S = MFMA(kf, q[kk], S);
        }
#pragma unroll
        for (int i = 0; i < 16; ++i) {
          const int n = t * 64 + ks * 32 + crow(i, lh);
          S[i] = (16 * n + 31 <= qpos) ? __expf(S[i] * scale - mc) * invl : 0.f;
        }
#pragma unroll
        for (int gq = 0; gq < 4; ++gq) {
          const int j = t * 16 + ks * 8 + 2 * gq + lh;
          atomicAdd(&sImp[(hh * 64 + qloc) * 65 + j], S[4 * gq] + S[4 * gq + 1] + S[4 * gq + 2] + 0.5f * S[4 * gq + 3]);
          if (j + 1 < 64) atomicAdd(&sImp[(hh * 64 + qloc) * 65 + j + 1], 0.5f * S[4 * gq + 3]);
        }
#pragma unroll
        for (int st = 0; st < 2; ++st) {
          union { unsigned u[4]; bf16x8 v; } pf;
#pragma unroll
          for (int j = 0; j < 4; ++j) pf.u[j] = pack2(S[8 * st + 2 * j], S[8 * st + 2 * j + 1]);
#pragma unroll
          for (int d = 0; d < 2; ++d) {
            const char* vp = sVc + (d * 32 + lr) * VCSTR + (t * 64 + ks * 32 + 16 * st + 4 * lh) * 2;
            const s16x4 lo = *(const s16x4*)vp, hi = *(const s16x4*)(vp + 16);
            const bf16x8 vf = __builtin_shufflevector(lo, hi, 0, 1, 2, 3, 4, 5, 6, 7);
            Oo[d] = MFMA(vf, pf.v, Oo[d]);
          }
        }
      }
    }
  }
  __syncthreads();

  {
    const int qq = tid >> 3, part = tid & 7;
    float v[8];
#pragma unroll
    for (int k = 0; k < 8; ++k) {
      const int j = part * 8 + k;
      float val = sImp[(0 * 64 + qq) * 65 + j] + sImp[(1 * 64 + qq) * 65 + j] + sImp[(2 * 64 + qq) * 65 + j] + sImp[(3 * 64 + qq) * 65 + j];
      const bool forced = (j == 0) || (j == jq) || (j == jq - 1);
      val = forced ? 1e9f : val;
      val = (j <= jq) ? val : -1.f;
      v[k] = val;
    }
    unsigned taken = 0, selb = 0;
#pragma unroll 1
    for (int r = 0; r < 8; ++r) {
      float best = -2.f;
      int bidx = 1000;
#pragma unroll
      for (int k = 0; k < 8; ++k)
        if (!((taken >> k) & 1u) && v[k] > best) { best = v[k]; bidx = part * 8 + k; }
#pragma unroll
      for (int off = 1; off < 8; off <<= 1) {
        const float ob = __shfl_xor(best, off);
        const int oi = __shfl_xor(bidx, off);
        if (ob > best || (ob == best && oi < bidx)) { best = ob; bidx = oi; }
      }
      if ((bidx >> 3) == part) {
        taken |= 1u << (bidx & 7);
        if (best >= 0.f) selb |= 1u << (bidx & 7);
      }
    }
    sSel[qq * 8 + part] = (unsigned char)selb;
  }
  __syncthreads();
  const unsigned long long sel = *(const unsigned long long*)(sSel + qloc * 8);

  const u16* gz = z + (tokbase + qpos) * ZW + ZC_GATE + head * 3;
  const float g0 = sigmoidf(bf2f(gz[0])), g1 = sigmoidf(bf2f(gz[1])), g2 = sigmoidf(bf2f(gz[2]));
#pragma unroll
  for (int d = 0; d < 2; ++d)
#pragma unroll
    for (int i = 0; i < 16; ++i) Oo[d][i] *= g0;

  {
    float m = -1e30f, ls = 0.f;
    f32x16 O[2];
#pragma unroll
    for (int d = 0; d < 2; ++d)
#pragma unroll
      for (int i = 0; i < 16; ++i) O[d][i] = 0.f;
    flash_loop<64, 64, 2>(m, ls, O, q, scale, z + tokbase * ZW + ZC_NKS + g * 64, ZW,
                          BUF(p, B_VST) + ((size_t)(bl * 2 + g) * 64) * SEQ, SEQ, 0, jq + 1, qpos, q0 + 63, sel, smem);
    const float f = (ls > 0.f) ? g1 / ls : 0.f;
#pragma unroll
    for (int d = 0; d < 2; ++d)
#pragma unroll
      for (int i = 0; i < 16; ++i) Oo[d][i] += f * O[d][i];
  }
  {
    float m = -1e30f, lw = 0.f;
    f32x16 O[2];
#pragma unroll
    for (int d = 0; d < 2; ++d)
#pragma unroll
      for (int i = 0; i < 16; ++i) O[d][i] = 0.f;
    flash_loop<64, 64, 3>(m, lw, O, q, scale, z + tokbase * ZW + ZC_NKW + g * 64, ZW,
                          BUF(p, B_VWT) + ((size_t)(bl * 2 + g) * 64) * SEQ, SEQ, max(0, jq - 8), jq + 1, qpos, q0 + 63, 0ull, smem);
    const float f = (lw > 0.f) ? g2 / lw : 0.f;
#pragma unroll
    for (int d = 0; d < 2; ++d)
#pragma unroll
      for (int i = 0; i < 16; ++i) Oo[d][i] += f * O[d][i];
  }
#pragma unroll
  for (int d = 0; d < 2; ++d)
#pragma unroll
    for (int gq = 0; gq < 4; ++gq) {
      uint2 pk;
      pk.x = pack2(Oo[d][4 * gq], Oo[d][4 * gq + 1]);
      pk.y = pack2(Oo[d][4 * gq + 2], Oo[d][4 * gq + 3]);
      *(uint2*)(P + (tokbase + qpos) * 2048 + 1536 + head * 64 + d * 32 + 8 * gq + 4 * lh) = pk;
    }
  __syncthreads();
}

DI void gmlp_tile(const Params& p, int l, int mt, int g, char* smem) {
  EPI_IDS
  const u16* vl = BUF(p, B_VLNT) + (size_t)g * TG * 128;
  const u16* z = BUF(p, B_Z);
  u16* P = BUF(p, B_P);
  const float* bs = p.in[12] + (size_t)l * 512 + g * 128;
  f32x16 acc[1][2][2];
  gemm_core<1, 2>(acc, vl + (size_t)mt * 256 * 128, 128, 64, WTS(p, l) + W_GWS + (size_t)g * 128 * 128, nullptr, 128, 128, smem);
#pragma unroll
  for (int ms = 0; ms < 2; ++ms)
#pragma unroll
    for (int ns = 0; ns < 2; ++ns) {
      const int t = wn * 64 + ns * 32 + lr;
      const float bias = bs[t];
#pragma unroll
      for (int gq = 0; gq < 4; ++gq) {
        const int R = mt * 256 + wm * 64 + ms * 32 + 8 * gq + 4 * lh;
        const int chunk = R >> 7, d = R & 127;
        const size_t tok = (size_t)chunk * 128 + t;
        const uint2 u = *(const uint2*)(z + tok * ZW + ZC_U + g * 128 + d);
        uint2 pk;
        pk.x = pack2(__uint_as_float(u.x << 16) * (acc[0][ms][ns][4 * gq] + bias),
                     __uint_as_float(u.x & 0xffff0000u) * (acc[0][ms][ns][4 * gq + 1] + bias));
        pk.y = pack2(__uint_as_float(u.y << 16) * (acc[0][ms][ns][4 * gq + 2] + bias),
                     __uint_as_float(u.y & 0xffff0000u) * (acc[0][ms][ns][4 * gq + 3] + bias));
        *(uint2*)(P + tok * 2048 + g * 128 + d) = pk;
      }
    }
}

DI void phase_m3(const Params& p, int l, char* smem, int only = 0) {
  const int xcd = blockIdx.x & 7, nj = gridDim.x >> 3;
  for (int vj = blockIdx.x >> 3; vj < 32; vj += nj) {
    const int hsel = vj >> 4, f = vj & 15;
    const int hd0 = 4 * xcd + hsel, hd1 = 4 * xcd + 2 + hsel;
    if (only == 0 || only == 1 || only >= 10) mla_item(p, hd0 >> 3, hd0 & 7, f, smem, only >= 10 ? only - 10 : 0);
    if (only == 0 || only == 2) nsa_item(p, l, xcd >> 1, xcd & 1, 63 - vj, smem);
    if (only == 0 || only == 1 || only >= 10) mla_item(p, hd1 >> 3, hd1 & 7, 15 - f, smem, only >= 10 ? only - 10 : 0);
    if (only == 0 || only == 2) nsa_item(p, l, xcd >> 1, xcd & 1, vj, smem);
  }
  if (only == 0 || only == 3)
    for (int it = blockIdx.x; it < (TG / 256) * 4; it += gridDim.x) gmlp_tile(p, l, it >> 2, it & 3, smem);
}

DI size_t gate_off(size_t row4, int col) { return (((row4 >> 2) * 128 + (size_t)(col >> 5)) * 32 + (size_t)(col & 31)) * 4; }
DI void phase_m4a(const Params& p, int l, int grp, char* smem) {
  G256_IDS
  const u16* xb = XB(p) + (size_t)grp * TG * D;
  const u16* wt = WTS(p, l) + W_IN + (size_t)ZW * D;
  const float* bgate = F32L(p, l) + F_BGATE;
  u16* gt = BUF(p, B_Z);
  constexpr int MPX = (TG / 256) / 8;
  auto setup = [&](int xcd, int q, const u16*& Ap, const u16*& Bp) __attribute__((always_inline)) {
    G256_SETUP_IDS
    const int mt = xcd * MPX + q % MPX, nt = q / MPX;
    Ap = xb + (size_t)mt * 256 * D;
    Bp = wt + (size_t)nt * 256 * D;
  };
  auto toff = [&](int r0, int c8, int& aoff, int& boff) __attribute__((always_inline)) {
    aoff = r0 * D + c8 * 8;
    boff = r0 * D + c8 * 8;
  };
  auto epi = [&](int xcd, int q, f32x16 (&acc)[4][2]) __attribute__((always_inline)) {
    G256_EPI_IDS
    const int mt = xcd * MPX + q % MPX, nt = q / MPX;
    const int col0 = nt * 256 + wn * 64 + lr;
    const float bias0 = bgate[col0], bias1 = bgate[col0 + 32];
#pragma unroll
    for (int ms = 0; ms < 4; ++ms)
#pragma unroll
      for (int gq = 0; gq < 4; ++gq) {
        const size_t row = (size_t)mt * 256 + wm * 128 + ms * 32 + 8 * gq + 4 * lh;
        uint2 pk0, pk1;
        pk0.x = pack2(sigmoidf(acc[ms][0][4 * gq] + bias0), sigmoidf(acc[ms][0][4 * gq + 1] + bias0));
        pk0.y = pack2(sigmoidf(acc[ms][0][4 * gq + 2] + bias0), sigmoidf(acc[ms][0][4 * gq + 3] + bias0));
        pk1.x = pack2(sigmoidf(acc[ms][1][4 * gq] + bias1), sigmoidf(acc[ms][1][4 * gq + 1] + bias1));
        pk1.y = pack2(sigmoidf(acc[ms][1][4 * gq + 2] + bias1), sigmoidf(acc[ms][1][4 * gq + 3] + bias1));
        *(uint2*)(gt + gate_off(row, col0)) = pk0;
        *(uint2*)(gt + gate_off(row, col0 + 32)) = pk1;
      }
  };
  gemm256_stream(MPX * 16, D, (long)64 * D, 64, (long)64 * D, toff, setup, epi, smem);
}

DI void phase_m4b(const Params& p, int l, char* smem) {
  const u16* P = BUF(p, B_P);
  const u16* gt = BUF(p, B_Z);
  u16* mg = BUF(p, B_MG);
  const u16* w = WTS(p, l);
  for (int qq = blockIdx.x >> 3; qq < 64; qq += (gridDim.x >> 3)) {
    const int mt = (blockIdx.x & 7) * ((TG / 256) / 8) + (qq & 7), nt = qq >> 3;
    f32x16 accm[2][2];
#pragma unroll
    for (int ms = 0; ms < 2; ++ms)
#pragma unroll
      for (int ns = 0; ns < 2; ++ns)
#pragma unroll
        for (int i = 0; i < 16; ++i) accm[ms][ns][i] = 0.f;
#pragma unroll 1
    for (int br = 0; br < 4; ++br) {
      f32x16 ay[1][2][2];
      gemm_core<1, 2>(ay, P + (size_t)mt * 256 * 2048 + br * 512, 2048, 64, w + W_OUT4 + (size_t)br * 1024 * 512 + (size_t)nt * 128 * 512, nullptr, 512, 512, smem);
      EPI_IDS
#pragma unroll
      for (int ms = 0; ms < 2; ++ms)
#pragma unroll
        for (int ns = 0; ns < 2; ++ns)
#pragma unroll
          for (int gq = 0; gq < 4; ++gq) {
            const size_t row = (size_t)mt * 256 + wm * 64 + ms * 32 + 8 * gq + 4 * lh;
            const int col = nt * 128 + wn * 64 + ns * 32 + lr;
            const unsigned long long gq64 = __builtin_nontemporal_load((const unsigned long long*)(gt + gate_off(row, br * 1024 + col)));
            uint2 gv; gv.x = (unsigned)gq64; gv.y = (unsigned)(gq64 >> 32);
            accm[ms][ns][4 * gq] += __uint_as_float(gv.x << 16) * ay[0][ms][ns][4 * gq];
            accm[ms][ns][4 * gq + 1] += __uint_as_float(gv.x & 0xffff0000u) * ay[0][ms][ns][4 * gq + 1];
            accm[ms][ns][4 * gq + 2] += __uint_as_float(gv.y << 16) * ay[0][ms][ns][4 * gq + 2];
            accm[ms][ns][4 * gq + 3] += __uint_as_float(gv.y & 0xffff0000u) * ay[0][ms][ns][4 * gq + 3];
          }
    }
    EPI_IDS
#pragma unroll
    for (int ms = 0; ms < 2; ++ms)
#pragma unroll
      for (int ns = 0; ns < 2; ++ns)
#pragma unroll
        for (int i = 0; i < 16; ++i) {
          const size_t row = (size_t)mt * 256 + wm * 64 + ms * 32 + crow(i, lh);
          mg[row * D + nt * 128 + wn * 64 + ns * 32 + lr] = f2bf(accm[ms][ns][i]);
        }
  }
}

DI void phase_x1(const Params& p, int l, char* smem) {
  G256_IDS
  const u16* xb = XB(p);
  const u16* w = WTS(p, l);
  u16* xq = BUF(p, B_XQ);
  constexpr int MPX = (T / 256) / 8;
  {
    auto setup = [&](int xcd, int q, const u16*& Ap, const u16*& Bp) __attribute__((always_inline)) {
    G256_SETUP_IDS
      const int mt = xcd * MPX + q % MPX, nt = q / MPX;
      Ap = xb + (size_t)mt * 256 * D;
      Bp = w + W_XQ + (size_t)nt * 256 * D;
    };
    auto toff = [&](int r0, int c8, int& aoff, int& boff) __attribute__((always_inline)) {
      aoff = r0 * D + c8 * 8;
      boff = r0 * D + c8 * 8;
    };
    auto epi = [&](int xcd, int q, f32x16 (&acc)[4][2]) __attribute__((always_inline)) {
    G256_EPI_IDS
      const int mt = xcd * MPX + q % MPX, nt = q / MPX;
#pragma unroll
      for (int ms = 0; ms < 4; ++ms)
#pragma unroll
        for (int ns = 0; ns < 2; ++ns)
#pragma unroll
          for (int i = 0; i < 16; ++i) {
            const size_t row = (size_t)mt * 256 + wm * 128 + ms * 32 + crow(i, lh);
            xq[row * 512 + nt * 256 + wn * 64 + ns * 32 + lr] = f2bf(acc[ms][ns][i]);
          }
    };
    gemm256_stream(2 * MPX, D, (long)64 * D, 64, (long)64 * D, toff, setup, epi, smem);
  }
}

DI void phase_x2(const Params& p, char* smem) {
  const int tid = otid(), lane = tid & 63, wave = tid >> 6, lr = lane & 31, lh = lane >> 5;
  const u16* xq = BUF(p, B_XQ);
  u16* xo = BUF(p, B_XO);
  const u16* kx = (const u16*)(PWS(p) + WS_KX);
  const u16* vxt = (const u16*)(PWS(p) + WS_VXT);
  for (int idx = blockIdx.x >> 3; idx < 64; idx += (gridDim.x >> 3)) {
    const int b = blockIdx.x & 7, h = idx >> 4, qt = idx & 15;
    const size_t tok = (size_t)b * SEQ + qt * 256 + wave * 32 + lr;
    bf16x8 q[8];
#pragma unroll
    for (int kk = 0; kk < 8; ++kk) q[kk] = *(const bf16x8*)(xq + tok * 512 + h * 128 + kk * 16 + lh * 8);
    float m = -1e30f, l = 0.f;
    f32x16 O[4];
#pragma unroll
    for (int d = 0; d < 4; ++d)
#pragma unroll
      for (int i = 0; i < 16; ++i) O[d][i] = 0.f;
    flash_loop<128, 128, 0>(m, l, O, q, 0.08838834764831845f, kx + (size_t)b * MEML * 512 + h * 128, 512,
                            vxt + ((size_t)(b * 4 + h) * 128) * MEML, MEML, 0, 4, 0, 0, 0ull, smem);
    const float inv = 1.f / l;
#pragma unroll
    for (int d = 0; d < 4; ++d)
#pragma unroll
      for (int gq = 0; gq < 4; ++gq) {
        uint2 pk;
        pk.x = pack2(O[d][4 * gq] * inv, O[d][4 * gq + 1] * inv);
        pk.y = pack2(O[d][4 * gq + 2] * inv, O[d][4 * gq + 3] * inv);
        *(uint2*)(xo + tok * 512 + h * 128 + d * 32 + 8 * gq + 4 * lh) = pk;
      }
  }
}

#define XB_TMO      128
#define XB_XCNT(j)  (256  + 64 * (j))
#define XB_XSUB(j)  (1280 + 64 * (j))
#define XB_XGEN(j)  (2304 + 64 * (j))
#define XB_TOP      3328
#define XB_TOPGEN   3392
#define XCD_BAR_WORDS 3456
#define XB_SPIN_CAP (1u << 22)
#define LAS __attribute__((address_space(3)))
DI unsigned xb_ld(unsigned* p) { return __hip_atomic_load(p, __ATOMIC_RELAXED, __HIP_MEMORY_SCOPE_AGENT); }
DI unsigned xb_add(unsigned* p, unsigned v) { return __hip_atomic_fetch_add(p, v, __ATOMIC_RELAXED, __HIP_MEMORY_SCOPE_AGENT); }
DI unsigned xb_xcc_id() { return (unsigned)__builtin_amdgcn_s_getreg((3 << 11) | 20) & 0xFu; }
#define XB_SPIN(cond, bar) do { unsigned _sp = 0; while (cond) { __builtin_amdgcn_s_sleep(1); \
    if ((++_sp & 255u) == 0u) { if (xb_ld(&(bar)[XB_TMO])) break; if (_sp > XB_SPIN_CAP) { atomicAdd(&(bar)[XB_TMO], 1u); break; } } } } while (0)
struct XcdBarrier { unsigned* bar; unsigned x; volatile LAS unsigned* st; };
DI XcdBarrier xcd_barrier_post(unsigned* bar, volatile LAS unsigned* st) {
  XcdBarrier b; b.bar = bar; b.x = xb_xcc_id(); b.st = st;
  if (threadIdx.x == 0) (void)xb_add(&bar[XB_XCNT(b.x)], 1u);
  return b;
}
DI void xcd_barrier_complete(unsigned* bar, unsigned x, unsigned& nloc, unsigned& nx) {
  const unsigned G = gridDim.x * gridDim.y * gridDim.z;
  unsigned sum, cnt, mine, sp = 0u;
  for (;;) {
    sum = 0u; cnt = 0u; mine = 0u;
#pragma unroll
    for (unsigned j = 0; j < 16; ++j) { const unsigned c = xb_ld(&bar[XB_XCNT(j)]); sum += c; cnt += (c > 0u) ? 1u : 0u; mine = (j == x) ? c : mine; }
    if (sum == G) break;
    __builtin_amdgcn_s_sleep(1);
    if ((++sp & 255u) == 0u) { if (xb_ld(&bar[XB_TMO])) break; if (sp > XB_SPIN_CAP) { atomicAdd(&bar[XB_TMO], 1u); break; } }
  }
  nloc = mine > 0u ? mine : 1u; nx = cnt > 0u ? cnt : 1u;
}
DI void xcd_barrier(const XcdBarrier& b) {
  asm volatile("s_waitcnt vmcnt(0)" ::: "memory");
  __syncthreads();
  if (threadIdx.x == 0) {
    unsigned* bar = b.bar;
    __builtin_amdgcn_s_waitcnt(0);
    unsigned nloc = b.st[0], nx = b.st[1];
    if (nloc == 0u) { xcd_barrier_complete(bar, b.x, nloc, nx); b.st[0] = nloc; b.st[1] = nx; }
    const unsigned old = xb_add(&bar[XB_XSUB(b.x)], 1u);
    const unsigned gen = old / nloc;
    if (old + 1u == (gen + 1u) * nloc) {
      __builtin_amdgcn_fence(__ATOMIC_RELEASE, "agent");
      asm volatile("s_waitcnt vmcnt(0)" ::: "memory");
      const unsigned og = xb_add(&bar[XB_TOP], 1u);
      const unsigned tg = og / nx;
      if (og + 1u == (tg + 1u) * nx) xb_add(&bar[XB_TOPGEN], 1u);
      else XB_SPIN(xb_ld(&bar[XB_TOPGEN]) == tg, bar);
      __builtin_amdgcn_fence(__ATOMIC_ACQUIRE, "agent");
      xb_add(&bar[XB_XGEN(b.x)], 1u);
      asm volatile("s_waitcnt vmcnt(0)" ::: "memory");
    } else {
      XB_SPIN(xb_ld(&bar[XB_XGEN(b.x)]) == gen, bar);
      __builtin_amdgcn_fence(__ATOMIC_ACQUIRE, "agent");
      asm volatile("s_waitcnt vmcnt(0)" ::: "memory");
    }
  }
  __syncthreads();
}
DI XcdBarrier mk_bar(const Params& p, char* smem) {
  XcdBarrier b;
  b.bar = (unsigned*)(PWS(p) + WS_BAR);
  b.x = xb_xcc_id();
  b.st = (volatile LAS unsigned*)(smem + XB_LDS_OFF);
  return b;
}

enum { PH_INIT, PH_FFN_UP, PH_RESID, PH_LN, PH_M1, PH_M2, PH_M3, PH_M4A, PH_M4B, PH_X1, PH_X2 };
constexpr int STEPS_PER_LAYER = 3 + NGRP * 6 + 8;
constexpr int NSTEPS = 1 + DEPTH * STEPS_PER_LAYER;
#define PROBE_PH (-1)
#define PROBE_SUB 0
__global__ void __launch_bounds__(NTHREADS) k_mega(Params p) {
  extern __shared__ __attribute__((aligned(16))) char smem[];
  cg::grid_group grid = cg::this_grid();
  {
    volatile LAS unsigned* st = (volatile LAS unsigned*)(smem + XB_LDS_OFF);
    if (threadIdx.x == 0) { st[0] = 0u; st[1] = 0u; }
    __syncthreads();
    (void)xcd_barrier_post((unsigned*)(PWS(p) + WS_BAR), st);
  }
#pragma unroll 1
  for (int step = 0; step < NSTEPS; ++step) {
    int ph = PH_INIT, l = 0, grp = 0, var = 0;
    if (step > 0) {
      const int s1 = step - 1;
      l = s1 / STEPS_PER_LAYER;
      const int r = s1 % STEPS_PER_LAYER;
      constexpr int MIXEND = 3 + NGRP * 6;
      if (r == 0) { ph = PH_FFN_UP; var = 0; }
      else if (r == 1) { ph = PH_RESID; var = 0; }
      else if (r == 2) { ph = PH_LN; var = 0; }
      else if (r < MIXEND) {
        const int m = r - 3, k = m % 6;
        grp = m / 6;
        ph = (k == 0) ? PH_M1 : (k == 1) ? PH_M2 : (k == 2) ? PH_M3 : (k == 3) ? PH_M4A : (k == 4) ? PH_M4B : PH_RESID;
        var = 1;
      }
      else if (r == MIXEND) { ph = PH_LN; var = 1; }
      else if (r == MIXEND + 1) { ph = PH_X1; }
      else if (r == MIXEND + 2) { ph = PH_X2; }
      else if (r == MIXEND + 3) { ph = PH_RESID; var = 2; }
      else if (r == MIXEND + 4) { ph = PH_LN; var = 2; }
      else if (r == MIXEND + 5) { ph = PH_FFN_UP; var = 1; }
      else if (r == MIXEND + 6) { ph = PH_RESID; var = 3; }
      else { ph = PH_LN; var = 3; }
    }
    const u16* w = WTS(p, l);
#pragma unroll 1
    for (int rep = 0; rep < ((ph == PROBE_PH) ? 2 : 1); ++rep) {
    switch (ph) {
      case PH_INIT: phase0(p, smem); break;
      case PH_FFN_UP: phase_ffn_up(p, w + (var ? W_F2W1 : W_F1W1), w + (var ? W_F2W3 : W_F1W3), smem); break;
      case PH_RESID: {
        const u16* A; const u16* Bt; const float* res = p.out; int lda, K, row0 = 0, nrows = T; float scl = 1.f;
        if (var == 0) { A = BUF(p, B_H); lda = FF; K = FF; Bt = w + W_F1W2; scl = 0.5f; if (l == 0) res = p.in[0]; }
        else if (var == 1) { A = BUF(p, B_MG); lda = D; K = D; Bt = w + W_O; row0 = grp * TG; nrows = TG; }
        else if (var == 2) { A = BUF(p, B_XO); lda = 512; K = 512; Bt = w + W_XO; }
        else { A = BUF(p, B_H); lda = FF; K = FF; Bt = w + W_F2W2; scl = 0.5f; }
        (void)res;
        phase_gemm_resid(p, A, lda, K, Bt, (l == DEPTH - 1) && (var == 3), scl, row0, nrows, smem);
      } break;
      case PH_LN: {
        const int gi = (var == 0) ? 5 : (var == 1) ? 27 : (var == 2) ? 33 : 38;
        phase_ln(p, p.in[gi] + l * D, p.in[gi + 1] + l * D, (l == DEPTH - 1) && (var == 3));
      } break;
      case PH_M1: phase_m1(p, l, grp, smem); break;
      case PH_M2: phase_m2(p, l, grp, smem); break;
      case PH_M3: phase_m3(p, l, smem, rep ? PROBE_SUB : 0); break;
      case PH_M4A: phase_m4a(p, l, grp, smem); break;
      case PH_M4B: phase_m4b(p, l, smem); break;
      case PH_X1: phase_x1(p, l, smem); break;
      default: phase_x2(p, smem); break;
    }
    if (step == 0) grid.sync();
    else xcd_barrier(mk_bar(p, smem));
    }
  }
}

extern "C" void kernel_launch(void* const* d_in, const int* in_sizes, int n_in, void* d_out, int out_size, void* d_ws,
                              size_t ws_size, hipStream_t stream) {
  (void)in_sizes; (void)out_size;
  if (n_in < 40 || ws_size < WS_TOTAL) {
    fprintf(stderr, "kernel_launch: unexpected inputs (n_in %d, ws %zu < %zu)\n", n_in, ws_size, (size_t)WS_TOTAL);
    return;
  }
  static int grid_blocks = 0;
  if (!grid_blocks) {
    hipFuncSetAttribute((const void*)k_mega, hipFuncAttributeMaxDynamicSharedMemorySize, SMEM_BYTES);
    int dev = 0, cus = 0, per_cu = 0;
    hipGetDevice(&dev);
    hipDeviceGetAttribute(&cus, hipDeviceAttributeMultiprocessorCount, dev);
    hipOccupancyMaxActiveBlocksPerMultiprocessor(&per_cu, k_mega, NTHREADS, SMEM_BYTES);
    if (per_cu < 1) per_cu = 1;
    grid_blocks = cus * per_cu;
  }
  Params p{};
  for (int i = 0; i < 40; ++i) p.in[i] = (const float*)d_in[i];
  p.out = (float*)d_out;
  p.ws = (char*)d_ws;
  hipMemsetAsync((char*)d_ws + WS_BAR, 0, (size_t)XCD_BAR_WORDS * 4, stream);
  void* args[] = {&p};
  hipError_t e = hipLaunchCooperativeKernel((const void*)k_mega, dim3(grid_blocks), dim3(NTHREADS), args, SMEM_BYTES, stream);
  if (e != hipSuccess) fprintf(stderr, "cooperative launch failed: %s (grid %d)\n", hipGetErrorString(e), grid_blocks);
}
```

```cpp
#include <hip/hip_runtime.h>
#include <hip/hip_cooperative_groups.h>
#include <cstdio>
#include <cstdint>
namespace cg = cooperative_groups;

typedef unsigned short u16;
using bf16x8 = __attribute__((ext_vector_type(8))) short;
using s16x4 = __attribute__((ext_vector_type(4))) short;
using f32x16 = __attribute__((ext_vector_type(16))) float;
#define DI __device__ __forceinline__
#define MFMA(a, b, c) __builtin_amdgcn_mfma_f32_32x32x16_bf16((a), (b), (c), 0, 0, 0)

constexpr int D = 1024, BATCH = 8, SEQ = 4096, T = BATCH * SEQ, DEPTH = 2, MEML = 256, FF = 2816;
constexpr int BG = 4;
constexpr int TG = BG * SEQ;
constexpr int NGRP = BATCH / BG;
constexpr int ZW = 4352;
constexpr int INW = 8376;
constexpr int ZC_U = 0, ZC_V = 512, ZC_CB = 1024, ZC_CC = 1536, ZC_CH = 2048, ZC_QLAT = 2560, ZC_KVLAT = 2816,
              ZC_NQ = 2944, ZC_NKC = 3456, ZC_NVC = 3584, ZC_NKS = 3712, ZC_NVS = 3840, ZC_NKW = 3968,
              ZC_NVW = 4096, ZC_KROPE = 4224, ZC_GATE = 4256;
constexpr float ALPHA = 1.4142135623730951f;
constexpr int NTHREADS = 512;
constexpr int SMEM_BYTES = 140 * 1024;
constexpr int XB_LDS_OFF = 138 * 1024;

constexpr size_t W_F1W1 = 0;
constexpr size_t W_F1W3 = W_F1W1 + (size_t)FF * D;
constexpr size_t W_F1W2 = W_F1W3 + (size_t)FF * D;
constexpr size_t W_F2W1 = W_F1W2 + (size_t)FF * D;
constexpr size_t W_F2W3 = W_F2W1 + (size_t)FF * D;
constexpr size_t W_F2W2 = W_F2W3 + (size_t)FF * D;
constexpr size_t W_IN = W_F2W2 + (size_t)FF * D;
constexpr size_t W_OUT4 = W_IN + (size_t)(ZW + 4096) * D;
constexpr size_t W_UQ = W_OUT4 + (size_t)4 * 1024 * 512;
constexpr size_t W_UKV = W_UQ + (size_t)768 * 256;
constexpr size_t W_O = W_UKV + (size_t)1024 * 128;
constexpr size_t W_XQ = W_O + (size_t)1024 * 1024;
constexpr size_t W_XKV = W_XQ + (size_t)512 * 1024;
constexpr size_t W_XO = W_XKV + (size_t)1024 * 1024;
constexpr size_t W_CK = W_XO + (size_t)1024 * 512;
constexpr size_t W_CV = W_CK + (size_t)128 * 1024;
constexpr size_t W_GWS = W_CV + (size_t)128 * 1024;
constexpr size_t LAYER_W = W_GWS + (size_t)4 * 128 * 128;

constexpr int F_BZ = 0, F_BGATE = ZW, F_CK = ZW + 4096, F_CV = F_CK + 64, F32_PER_LAYER = F_CV + 64;

constexpr size_t al256(size_t x) { return (x + 255) & ~(size_t)255; }
constexpr size_t cmax(size_t a, size_t b) { return a > b ? a : b; }
constexpr size_t WS_WTS = 0;
constexpr size_t WS_F32 = al256(WS_WTS + 2 * LAYER_W * 2);
constexpr size_t WS_BAR = al256(WS_F32 + (size_t)2 * F32_PER_LAYER * 4);
constexpr size_t WS_TAB64 = al256(WS_BAR + (size_t)4096 * 4);
constexpr size_t WS_TAB32 = al256(WS_TAB64 + (size_t)4096 * 32 * 8);
constexpr size_t WS_XB = al256(WS_TAB32 + (size_t)4096 * 16 * 8);
constexpr size_t WS_MEMB = al256(WS_XB + (size_t)T * D * 2);
constexpr size_t WS_KX = al256(WS_MEMB + (size_t)BATCH * MEML * D * 2);
constexpr size_t WS_VXT = al256(WS_KX + (size_t)BATCH * MEML * 512 * 2);
constexpr size_t WS_BIG = al256(WS_VXT + (size_t)BATCH * MEML * 512 * 2);
constexpr size_t B_H = 0;
constexpr size_t B_Z = 0;
constexpr size_t B_P = al256(B_Z + (size_t)TG * ZW * 2);
constexpr size_t B_QB = al256(B_P + (size_t)TG * 2048 * 2);
constexpr size_t B_KB = al256(B_QB + (size_t)TG * 768 * 2);
constexpr size_t B_MG = B_QB;
constexpr size_t B_VT = al256(B_KB + (size_t)TG * 768 * 2);
constexpr size_t B_VST = al256(B_VT + (size_t)TG * 512 * 2);
constexpr size_t B_VWT = al256(B_VST + (size_t)TG * 128 * 2);
constexpr size_t B_VLNT = al256(B_VWT + (size_t)TG * 128 * 2);
constexpr size_t B_UV = al256(B_VLNT + (size_t)TG * 512 * 2);
constexpr size_t B_END = al256(B_UV + (size_t)4 * (TG / 16) * 128 * 4);
constexpr size_t B_XQ = 0;
constexpr size_t B_XO = al256((size_t)T * 512 * 2);
constexpr size_t WS_TOTAL = WS_BIG + cmax(B_END, (size_t)T * FF * 2);
static_assert(WS_TOTAL <= (size_t)512 * 1024 * 1024, "workspace too large");

struct Params {
  const float* in[40];
  float* out;
  char* ws;
};

DI char* launder(char* x) {
  unsigned lo = (unsigned)(uintptr_t)x, hi = (unsigned)((uintptr_t)x >> 32);
  unsigned vlo, vhi;
  asm volatile("v_mov_b32 %0, %2\n\tv_mov_b32 %1, %3" : "=v"(vlo), "=v"(vhi) : "s"(lo), "s"(hi));
  lo = __builtin_amdgcn_readfirstlane(vlo);
  hi = __builtin_amdgcn_readfirstlane(vhi);
  return (char*)(__attribute__((address_space(1))) char*)(((uintptr_t)hi << 32) | (uintptr_t)lo);
}
#define PWS(p) launder((p).ws)
DI u16* WTS(const Params& p, int l) { return (u16*)(PWS(p) + WS_WTS) + (size_t)l * LAYER_W; }
DI float* F32L(const Params& p, int l) { return (float*)(PWS(p) + WS_F32) + (size_t)l * F32_PER_LAYER; }
DI float2* TAB64(const Params& p) { return (float2*)(PWS(p) + WS_TAB64); }
DI float2* TAB32(const Params& p) { return (float2*)(PWS(p) + WS_TAB32); }
DI u16* XB(const Params& p) { return (u16*)(PWS(p) + WS_XB); }
constexpr size_t B_R16_LAST = (size_t)192 * 1024 * 1024;
static_assert(B_R16_LAST >= (size_t)T * FF * 2 && B_R16_LAST + (size_t)T * D * 2 <= cmax(B_END, (size_t)T * FF * 2), "r16 placement");
DI u16* R16(const Params& p, bool last) { return last ? (u16*)(PWS(p) + WS_BIG + B_R16_LAST) : (u16*)launder((char*)p.out); }
DI u16* BUF(const Params& p, size_t off) { return (u16*)(PWS(p) + WS_BIG + off); }

typedef __bf16 hwbf16x2 __attribute__((ext_vector_type(2)));
typedef float f32x2v __attribute__((ext_vector_type(2)));
DI unsigned pack2(float a, float b) { f32x2v v = {a, b}; hwbf16x2 r = __builtin_convertvector(v, hwbf16x2); return __builtin_bit_cast(unsigned, r); }
DI u16 f2bf(float x) { return (u16)(pack2(x, 0.f) & 0xffffu); }
DI float bf2f(u16 v) { return __uint_as_float(((unsigned)v) << 16); }
DI int otid() { int t = threadIdx.x; asm volatile("" : "+v"(t)); return t; }
DI int crow(int i, int h) { return (i & 3) + 8 * (i >> 2) + 4 * h; }
DI float sigmoidf(float x) { return __builtin_amdgcn_rcpf(1.f + __expf(-x)); }
DI float wave_sum(float v) {
#pragma unroll
  for (int o = 32; o >= 1; o >>= 1) v += __shfl_xor(v, o);
  return v;
}

template <int NB, int NS>
DI void gemm_core(f32x16 (&acc)[NB][2][NS], const u16* __restrict__ A, long lda, long akcs,
                  const u16* __restrict__ B0, const u16* __restrict__ B1, long ldb, int K, char* smem) {
  constexpr int A_BYTES = 256 * 128, B_BYTES = 64 * NS * 128, STAGE = A_BYTES + NB * B_BYTES;
  const int tid = otid(), lane = tid & 63, wave = tid >> 6, wm = wave >> 1, wn = wave & 1;
  const int lr = lane & 31, lh = lane >> 5, c8 = tid & 7, r0 = tid >> 3;
  const int swz = (r0 >> 1) & 7;
  const int nk = K >> 6;
#pragma unroll
  for (int b = 0; b < NB; ++b)
#pragma unroll
    for (int ms = 0; ms < 2; ++ms)
#pragma unroll
      for (int ns = 0; ns < NS; ++ns)
#pragma unroll
        for (int i = 0; i < 16; ++i) acc[b][ms][ns][i] = 0.f;

  uint4 ra0, ra1, ra2, ra3, rb0, rb1, rb2, rb3;
  ra0 = ra1 = ra2 = ra3 = rb0 = rb1 = rb2 = rb3 = make_uint4(0, 0, 0, 0);
#define GEMM_GLOAD(kt_)                                                                        \
  {                                                                                            \
    const u16* ap_ = A + (long)r0 * lda + (long)(kt_) * akcs + c8 * 8;                         \
    ra0 = *(const uint4*)(ap_);                                                                \
    ra1 = *(const uint4*)(ap_ + 64 * lda);                                                     \
    ra2 = *(const uint4*)(ap_ + 128 * lda);                                                    \
    ra3 = *(const uint4*)(ap_ + 192 * lda);                                                    \
    const u16* bp_ = B0 + (long)r0 * ldb + (kt_) * 64 + c8 * 8;                                \
    rb0 = *(const uint4*)(bp_);                                                                \
    if constexpr (NS > 1) rb1 = *(const uint4*)(bp_ + 64 * ldb);                               \
    if constexpr (NB > 1) {                                                                    \
      const u16* bq_ = B1 + (long)r0 * ldb + (kt_) * 64 + c8 * 8;                              \
      rb2 = *(const uint4*)(bq_);                                                              \
      if constexpr (NS > 1) rb3 = *(const uint4*)(bq_ + 64 * ldb);                             \
    }                                                                                          \
  }
#define GEMM_SSTORE(s_)                                                                        \
  {                                                                                            \
    char* base_ = smem + (s_) * STAGE + r0 * 128 + ((c8 ^ swz) << 4);                          \
    *(uint4*)(base_) = ra0;                                                                    \
    *(uint4*)(base_ + 64 * 128) = ra1;                                                         \
    *(uint4*)(base_ + 128 * 128) = ra2;                                                        \
    *(uint4*)(base_ + 192 * 128) = ra3;                                                        \
    *(uint4*)(base_ + A_BYTES) = rb0;                                                          \
    if constexpr (NS > 1) *(uint4*)(base_ + A_BYTES + 64 * 128) = rb1;                         \
    if constexpr (NB > 1) {                                                                    \
      *(uint4*)(base_ + A_BYTES + B_BYTES) = rb2;                                              \
      if constexpr (NS > 1) *(uint4*)(base_ + A_BYTES + B_BYTES + 64 * 128) = rb3;             \
    }                                                                                          \
  }
  __syncthreads();
  GEMM_GLOAD(0)
  GEMM_SSTORE(0)
  if (nk > 1) GEMM_GLOAD(1)
  __syncthreads();
  for (int kt = 0; kt < nk; ++kt) {
    const int s = kt & 1;
    if (kt + 1 < nk) GEMM_SSTORE(s ^ 1)
    if (kt + 2 < nk) GEMM_GLOAD(kt + 2)
    __builtin_amdgcn_sched_barrier(0);
    const char* base = smem + s * STAGE;
#pragma unroll
    for (int kk = 0; kk < 4; ++kk) {
      bf16x8 af[2], bfr[NB][NS];
#pragma unroll
      for (int ms = 0; ms < 2; ++ms) {
        const int row = wm * 64 + ms * 32 + lr, ch = kk * 2 + lh;
        af[ms] = *(const bf16x8*)(base + row * 128 + ((ch ^ ((row >> 1) & 7)) << 4));
      }
#pragma unroll
      for (int b = 0; b < NB; ++b)
#pragma unroll
        for (int ns = 0; ns < NS; ++ns) {
          const int row = wn * (32 * NS) + ns * 32 + lr, ch = kk * 2 + lh;
          bfr[b][ns] = *(const bf16x8*)(base + A_BYTES + b * B_BYTES + row * 128 + ((ch ^ ((row >> 1) & 7)) << 4));
        }
#pragma unroll
      for (int b = 0; b < NB; ++b)
#pragma unroll
        for (int ms = 0; ms < 2; ++ms)
#pragma unroll
          for (int ns = 0; ns < NS; ++ns) acc[b][ms][ns] = MFMA(af[ms], bfr[b][ns], acc[b][ms][ns]);
    }
    __syncthreads();
  }
}

#define EPI_IDS                                                                       \
  const int tid = otid(), lane = tid & 63, wave = tid >> 6, wm = wave >> 1, wn = wave & 1; \
  const int lr = lane & 31, lh = lane >> 5;                                           \
  (void)tid; (void)wm; (void)wn; (void)lr; (void)lh;

struct Job { const float* src; u16* dst; int K, N, ld; const float* ks; };

DI Job get_job(const Params& p, int l, int j) {
  u16* w = WTS(p, l);
  Job o;
  o.ks = nullptr;
  const float* win = p.in[7] + (size_t)l * D * INW;
  switch (j) {
    case 0: o.src = p.in[2] + (size_t)l * D * FF; o.dst = w + W_F1W1; o.K = D; o.N = FF; o.ld = FF; break;
    case 1: o.src = p.in[3] + (size_t)l * D * FF; o.dst = w + W_F1W3; o.K = D; o.N = FF; o.ld = FF; break;
    case 2: o.src = p.in[4] + (size_t)l * D * FF; o.dst = w + W_F1W2; o.K = FF; o.N = D; o.ld = D; break;
    case 3: o.src = p.in[35] + (size_t)l * D * FF; o.dst = w + W_F2W1; o.K = D; o.N = FF; o.ld = FF; break;
    case 4: o.src = p.in[36] + (size_t)l * D * FF; o.dst = w + W_F2W3; o.K = D; o.N = FF; o.ld = FF; break;
    case 5: o.src = p.in[37] + (size_t)l * D * FF; o.dst = w + W_F2W2; o.K = FF; o.N = D; o.ld = D; break;
    case 6: o.src = win; o.dst = w + W_IN; o.K = D; o.N = 2944; o.ld = INW; break;
    case 7: o.src = win + 2976; o.dst = w + W_IN + (size_t)2944 * D; o.K = D; o.N = 1280; o.ld = INW; break;
    case 8: o.src = win + 2944; o.dst = w + W_IN + (size_t)ZC_KROPE * D; o.K = D; o.N = 32; o.ld = INW; break;
    case 9: o.src = win + 4256; o.dst = w + W_IN + (size_t)ZC_GATE * D; o.K = D; o.N = 24; o.ld = INW; break;
    case 10: o.src = win + 4280; o.dst = w + W_IN + (size_t)ZW * D; o.K = D; o.N = 4096; o.ld = INW; break;
    case 11: o.src = p.in[13] + (size_t)l * 512 * D; o.dst = w + W_OUT4; o.K = 512; o.N = D; o.ld = D; break;
    case 12: o.src = p.in[15] + (size_t)l * 512 * D; o.dst = w + W_OUT4 + (size_t)1 * 1024 * 512; o.K = 512; o.N = D; o.ld = D; break;
    case 13: o.src = p.in[20] + (size_t)l * 512 * D; o.dst = w + W_OUT4 + (size_t)2 * 1024 * 512; o.K = 512; o.N = D; o.ld = D; break;
    case 14: o.src = p.in[25] + (size_t)l * 512 * D; o.dst = w + W_OUT4 + (size_t)3 * 1024 * 512; o.K = 512; o.N = D; o.ld = D; break;
    case 15: o.src = p.in[18] + (size_t)l * 256 * 768; o.dst = w + W_UQ; o.K = 256; o.N = 768; o.ld = 768; o.ks = p.in[16] + l * 256; break;
    case 16: o.src = p.in[19] + (size_t)l * 128 * 1024; o.dst = w + W_UKV; o.K = 128; o.N = 1024; o.ld = 1024; o.ks = p.in[17] + l * 128; break;
    case 17: o.src = p.in[26] + (size_t)l * D * D; o.dst = w + W_O; o.K = D; o.N = D; o.ld = D; break;
    case 18: o.src = p.in[29] + (size_t)l * D * 512; o.dst = w + W_XQ; o.K = D; o.N = 512; o.ld = 512; break;
    case 19: o.src = p.in[30] + (size_t)l * D * 512; o.dst = w + W_XKV; o.K = D; o.N = 512; o.ld = 512; break;
    case 20: o.src = p.in[31] + (size_t)l * D * 512; o.dst = w + W_XKV + (size_t)512 * D; o.K = D; o.N = 512; o.ld = 512; break;
    case 21: o.src = p.in[32] + (size_t)l * 512 * D; o.dst = w + W_XO; o.K = 512; o.N = D; o.ld = D; break;
    case 22: o.src = p.in[23] + (size_t)l * 2048 * 64; o.dst = w + W_CK; o.K = 1024; o.N = 64; o.ld = 64; break;
    case 23: o.src = p.in[23] + (size_t)l * 2048 * 64 + 1024 * 64; o.dst = w + W_CK + (size_t)64 * 1024; o.K = 1024; o.N = 64; o.ld = 64; break;
    case 24: o.src = p.in[24] + (size_t)l * 2048 * 64; o.dst = w + W_CV; o.K = 1024; o.N = 64; o.ld = 64; break;
    default: o.src = p.in[24] + (size_t)l * 2048 * 64 + 1024 * 64; o.dst = w + W_CV + (size_t)64 * 1024; o.K = 1024; o.N = 64; o.ld = 64; break;
  }
  return o;
}
constexpr int NJOBS = 26;

DI void conv_tiles4(const Job& jb, int t0, int tstep, int ntiles, int nkt, char* smem) {
  const int tid = otid(), kk = tid >> 3, c = tid & 7;
  float v[4][8];
#pragma unroll
  for (int u = 0; u < 4; ++u) {
    const int t = t0 + u * tstep;
#pragma unroll
    for (int e = 0; e < 8; ++e) v[u][e] = 0.f;
    if (t < ntiles) {
      const int tk = t % nkt, tn = t / nkt;
      const int k = tk * 64 + kk, n0 = tn * 64 + c * 8;
      const float* s = jb.src + (size_t)k * jb.ld + n0;
      if (n0 + 8 <= jb.N) {
        float4 a, b;
        a.x = __builtin_nontemporal_load(s); a.y = __builtin_nontemporal_load(s + 1); a.z = __builtin_nontemporal_load(s + 2); a.w = __builtin_nontemporal_load(s + 3);
        b.x = __builtin_nontemporal_load(s + 4); b.y = __builtin_nontemporal_load(s + 5); b.z = __builtin_nontemporal_load(s + 6); b.w = __builtin_nontemporal_load(s + 7);
        v[u][0] = a.x; v[u][1] = a.y; v[u][2] = a.z; v[u][3] = a.w; v[u][4] = b.x; v[u][5] = b.y; v[u][6] = b.z; v[u][7] = b.w;
      } else {
#pragma unroll
        for (int e = 0; e < 8; ++e) v[u][e] = (n0 + e < jb.N) ? s[e] : 0.f;
      }
    }
  }
#pragma unroll
  for (int u = 0; u < 4; ++u) {
    const int t = t0 + u * tstep;
    if (t < ntiles) {
      u16* Ts = (u16*)smem + u * (64 * 72);
      const float sc = jb.ks ? jb.ks[(t % nkt) * 64 + kk] : 1.f;
#pragma unroll
      for (int e = 0; e < 8; ++e) Ts[(c * 8 + e) * 72 + kk] = f2bf(v[u][e] * sc);
    }
  }
  __syncthreads();
  const int n = tid >> 3, ch = tid & 7;
#pragma unroll
  for (int u = 0; u < 4; ++u) {
    const int t = t0 + u * tstep;
    if (t < ntiles) {
      const int tk = t % nkt, tn = t / nkt;
      if (tn * 64 + n < jb.N) {
        const u16* Ts = (const u16*)smem + u * (64 * 72);
        const uint4 val = *(const uint4*)(Ts + n * 72 + ch * 8);
        *(uint4*)(jb.dst + (size_t)(tn * 64 + n) * jb.K + tk * 64 + ch * 8) = val;
      }
    }
  }
  __syncthreads();
}

DI void phase0(const Params& p, char* smem) {
  const int tid = otid();
  const size_t gtid = (size_t)blockIdx.x * NTHREADS + tid, gsz = (size_t)gridDim.x * NTHREADS;
  for (int l = 0; l < DEPTH; ++l)
    for (int j = 0; j < NJOBS; ++j) {
      Job jb = get_job(p, l, j);
      const int nkt = jb.K / 64, nnt = (jb.N + 63) / 64;
      for (int t = blockIdx.x; t < nkt * nnt; t += 4 * gridDim.x) conv_tiles4(jb, t, gridDim.x, nkt * nnt, nkt, smem);
    }
  for (int l = 0; l < DEPTH; ++l) {
    u16* w = WTS(p, l);
    float* f = F32L(p, l);
    for (size_t i = gtid; i < (size_t)72 * D; i += gsz) w[W_IN + (size_t)4280 * D + i] = 0;
    const float* gws = p.in[11] + (size_t)l * 4 * 128 * 128;
    for (size_t i = gtid; i < (size_t)4 * 128 * 128; i += gsz) {
      const int s = (int)(i & 127), t = (int)((i >> 7) & 127);
      w[W_GWS + i] = (s <= t) ? f2bf(gws[i]) : (u16)0;
    }
    const float* bin = p.in[8] + (size_t)l * INW;
    for (size_t i = gtid; i < (size_t)(ZW + 4096); i += gsz) {
      const int c = (int)i;
      float v;
      if (c < 2944) v = bin[c];
      else if (c < 4224) v = bin[c - 2944 + 2976];
      else if (c < 4256) v = bin[c - 4224 + 2944];
      else if (c < 4280) v = bin[c];
      else if (c < ZW) v = 0.f;
      else v = bin[c - ZW + 4280];
      f[F_BZ + c] = v;
    }
  }
  for (int it = blockIdx.x; it < DEPTH * 2; it += gridDim.x) {
    const int l = it >> 1, kv = it & 1;
    const float* pe = p.in[kv ? 22 : 21] + (size_t)l * 2048;
    const float* wc = p.in[kv ? 24 : 23] + (size_t)l * 2048 * 64;
    float* red = (float*)smem;
    const int e = tid & 63, part = tid >> 6;
    float a = 0.f;
    for (int i = part * 256; i < part * 256 + 256; ++i) a += pe[i] * wc[(size_t)i * 64 + e];
    __syncthreads();
    red[part * 64 + e] = a;
    __syncthreads();
    if (tid < 64) {
      float s = 0.f;
      for (int q = 0; q < 8; ++q) s += red[q * 64 + tid];
      F32L(p, l)[(kv ? F_CV : F_CK) + tid] = s;
    }
    __syncthreads();
  }
  {
    float2* t64 = TAB64(p);
    float2* t32 = TAB32(p);
    for (size_t i = gtid; i < (size_t)4096 * 48; i += gsz) {
      int pos, idx;
      float inv;
      float2* dst;
      if (i < (size_t)4096 * 32) { pos = (int)(i >> 5); idx = (int)(i & 31); inv = powf(10000.f, -(float)idx / 32.f); dst = t64 + i; }
      else { size_t k = i - (size_t)4096 * 32; pos = (int)(k >> 4); idx = (int)(k & 15); inv = powf(10000.f, -(float)idx / 16.f); dst = t32 + k; }
      const float ang = (float)pos * inv;
      const float kq = rintf(ang * 0.15915494309189535f);
      float r = fmaf(-kq, 6.2831854820251465f, ang);
      r = fmaf(-kq, -1.7484555e-7f, r);
      *dst = make_float2(__cosf(r), __sinf(r));
    }
  }
  {
    const float* x = p.in[0];
    u16* xb = XB(p);
    for (size_t i = gtid; i < (size_t)T * D / 8; i += gsz) {
      const float* s8 = x + i * 8;
      float4 a, b;
      a.x = __builtin_nontemporal_load(s8); a.y = __builtin_nontemporal_load(s8 + 1); a.z = __builtin_nontemporal_load(s8 + 2); a.w = __builtin_nontemporal_load(s8 + 3);
      b.x = __builtin_nontemporal_load(s8 + 4); b.y = __builtin_nontemporal_load(s8 + 5); b.z = __builtin_nontemporal_load(s8 + 6); b.w = __builtin_nontemporal_load(s8 + 7);
      uint4 o; o.x = pack2(a.x, a.y); o.y = pack2(a.z, a.w); o.z = pack2(b.x, b.y); o.w = pack2(b.z, b.w);
      *(uint4*)(xb + i * 8) = o;
    }
    const float* mem = p.in[1];
    u16* mb = (u16*)(PWS(p) + WS_MEMB);
    for (size_t i = gtid; i < (size_t)BATCH * MEML * D / 8; i += gsz) {
      float4 a = *(const float4*)(mem + i * 8), b = *(const float4*)(mem + i * 8 + 4);
      uint4 o; o.x = pack2(a.x, a.y); o.y = pack2(a.z, a.w); o.z = pack2(b.x, b.y); o.w = pack2(b.z, b.w);
      *(uint4*)(mb + i * 8) = o;
    }
  }
}

template <class Toff, class Setup, class Epi>
DI void gemm256_stream(int tiles_per_xcd, int K, long ais, long akcs, long bis, Toff toff, Setup setup, Epi epi, char* smem) {
  constexpr int A_BYTES = 256 * 128, STAGE = 2 * A_BYTES;
  const int tid = otid(), lane = tid & 63, wave = tid >> 6, wm = wave >> 2, wn = wave & 3;
  const int lr = lane & 31, lh = lane >> 5, c8 = tid & 7, r0 = tid >> 3, swz = (r0 >> 1) & 7;
  const int xcd = blockIdx.x & 7, jb = blockIdx.x >> 3, nj = gridDim.x >> 3;
  int q = jb;
  if (q >= tiles_per_xcd) return;
  f32x16 acc[4][2];
#pragma unroll
  for (int ms = 0; ms < 4; ++ms)
#pragma unroll
    for (int ns = 0; ns < 2; ++ns)
#pragma unroll
      for (int i = 0; i < 16; ++i) acc[ms][ns][i] = 0.f;
  const u16 *Ac, *Bc, *An = nullptr, *Bn = nullptr;
  int aoff, boff;
  toff(r0, c8, aoff, boff);
  setup(xcd, q, Ac, Bc);
  uint4 ra0, ra1, ra2, ra3, rb0, rb1, rb2, rb3;
#define G256_GLOAD(Ap_, Bp_, kt_)                                 \
  {                                                               \
    const u16* ap_ = (Ap_) + aoff + (long)(kt_) * akcs;           \
    const u16* bp_ = (Bp_) + boff + (kt_) * 64;                   \
    ra0 = *(const uint4*)(ap_);                                   \
    ra1 = *(const uint4*)(ap_ + ais);                             \
    ra2 = *(const uint4*)(ap_ + 2 * ais);                         \
    ra3 = *(const uint4*)(ap_ + 3 * ais);                         \
    rb0 = *(const uint4*)(bp_);                                   \
    rb1 = *(const uint4*)(bp_ + bis);                             \
    rb2 = *(const uint4*)(bp_ + 2 * bis);                         \
    rb3 = *(const uint4*)(bp_ + 3 * bis);                         \
  }
#define G256_SSTORE(s_)                                                       \
  {                                                                           \
    char* base_ = smem + (s_) * STAGE + r0 * 128 + ((c8 ^ swz) << 4);         \
    *(uint4*)(base_) = ra0;                                                   \
    *(uint4*)(base_ + 64 * 128) = ra1;                                        \
    *(uint4*)(base_ + 2 * 64 * 128) = ra2;                                    \
    *(uint4*)(base_ + 3 * 64 * 128) = ra3;                                    \
    *(uint4*)(base_ + A_BYTES) = rb0;                                         \
    *(uint4*)(base_ + A_BYTES + 64 * 128) = rb1;                              \
    *(uint4*)(base_ + A_BYTES + 2 * 64 * 128) = rb2;                          \
    *(uint4*)(base_ + A_BYTES + 3 * 64 * 128) = rb3;                          \
  }
#define G256_ST1(s_, kk_, RA, RB)                                                                        \
  {                                                                                                        \
    char* base_ = smem + (s_) * STAGE + r0 * 128 + ((c8 ^ swz) << 4) + (kk_) * 64 * 128;                   \
    *(uint4*)(base_) = RA;                                                                                 \
    *(uint4*)(base_ + A_BYTES) = RB;                                                                       \
  }
#define G256_LD1(Ap_, Bp_, kt_, kk_, RA, RB)                                                               \
  {                                                                                                        \
    RA = *(const uint4*)((Ap_) + aoff + (long)(kt_) * akcs + (kk_) * ais);                                 \
    RB = *(const uint4*)((Bp_) + boff + (kt_) * 64 + (kk_) * bis);                                         \
  }
#define G256_KSTEP(kk, RA, RB)                                                                             \
  {                                                                                                        \
    bf16x8 af[4], bfr[2];                                                                                  \
    const int ch = kk * 2 + lh;                                                                            \
    _Pragma("unroll") for (int ms = 0; ms < 4; ++ms) {                                                     \
      const int row = wm * 128 + ms * 32 + lr;                                                             \
      af[ms] = *(const bf16x8*)(base + row * 128 + ((ch ^ ((row >> 1) & 7)) << 4));                        \
    }                                                                                                      \
    _Pragma("unroll") for (int ns = 0; ns < 2; ++ns) {                                                     \
      const int row = wn * 64 + ns * 32 + lr;                                                              \
      bfr[ns] = *(const bf16x8*)(base + A_BYTES + row * 128 + ((ch ^ ((row >> 1) & 7)) << 4));            \
    }                                                                                                      \
    if (have1) G256_ST1(s ^ 1, kk, RA, RB)                                                                 \
    if (have2) G256_LD1(Ap2, Bp2, kt2, kk, RA, RB)                                                         \
    __builtin_amdgcn_sched_barrier(0);                                                                     \
    _Pragma("unroll") for (int ms = 0; ms < 4; ++ms)                                                       \
      _Pragma("unroll") for (int ns = 0; ns < 2; ++ns) acc[ms][ns] = MFMA(af[ms], bfr[ns], acc[ms][ns]);   \
  }
  const int nk = K >> 6;
  __syncthreads();
  G256_GLOAD(Ac, Bc, 0)
  G256_SSTORE(0)
  G256_GLOAD(Ac, Bc, 1)
  __syncthreads();
  while (true) {
    const int qn = q + nj;
    const bool has_next = qn < tiles_per_xcd;
    if (has_next) setup(xcd, qn, An, Bn);
    for (int kt = 0; kt < nk; ++kt) {
      const int s = kt & 1;
      const bool have1 = (kt + 1 < nk) || has_next;
      const bool in_cur = (kt + 2 < nk);
      const bool have2 = in_cur || (has_next && kt + 2 == nk);
      const u16* Ap2 = in_cur ? Ac : An;
      const u16* Bp2 = in_cur ? Bc : Bn;
      const int kt2 = in_cur ? kt + 2 : kt + 2 - nk;
      const char* base = smem + s * STAGE;
      G256_KSTEP(0, ra0, rb0)
      G256_KSTEP(1, ra1, rb1)
      G256_KSTEP(2, ra2, rb2)
      G256_KSTEP(3, ra3, rb3)
      __syncthreads();
    }
    epi(xcd, q, acc);
#pragma unroll
    for (int ms = 0; ms < 4; ++ms)
#pragma unroll
      for (int ns = 0; ns < 2; ++ns)
#pragma unroll
        for (int i = 0; i < 16; ++i) acc[ms][ns][i] = 0.f;
    if (!has_next) break;
    q = qn;
    Ac = An;
    Bc = Bn;
    G256_GLOAD(Ac, Bc, 1)
  }
}
#define G256_IDS
#define G256_SETUP_IDS
#define G256_EPI_IDS                                                                          \
  const int tid = otid(), lane = tid & 63, wave = tid >> 6, wm = wave >> 2, wn = wave & 3;    \
  const int lr = lane & 31, lh = lane >> 5;                                                   \
  (void)wm; (void)wn; (void)lr; (void)lh;

DI void phase_ffn_up(const Params& p, const u16* w1t, const u16* w3t, char* smem) {
  G256_IDS
  const u16* xb = XB(p);
  u16* hb = BUF(p, B_H);
  constexpr int MPX = (T / 256) / 8;
  auto setup = [&](int xcd, int q, const u16*& Ap, const u16*& Bp) __attribute__((always_inline)) {
    G256_SETUP_IDS
    const int mt = xcd * MPX + (q / (4 * (FF / 128))) * 4 + (q & 3), nt = (q >> 2) % (FF / 128);
    Ap = xb + (size_t)mt * 256 * D;
    Bp = w1t + (size_t)nt * 128 * D;
  };
  const int w3off = (int)(w3t - w1t);
  auto toff = [&](int r0, int c8, int& aoff, int& boff) __attribute__((always_inline)) {
    aoff = r0 * D + c8 * 8;
    boff = ((r0 < 32) ? 0 : w3off) + (r0 & 31) * D + c8 * 8;
  };
  auto epi = [&](int xcd, int q, f32x16 (&acc)[4][2]) __attribute__((always_inline)) {
    G256_EPI_IDS
    const int mt = xcd * MPX + (q / (4 * (FF / 128))) * 4 + (q & 3), nt = (q >> 2) % (FF / 128);
#pragma unroll
    for (int ms = 0; ms < 4; ++ms)
#pragma unroll
      for (int i = 0; i < 16; ++i) {
        const size_t row = (size_t)mt * 256 + wm * 128 + ms * 32 + crow(i, lh);
        const int col = nt * 128 + wn * 32 + lr;
        const float a = acc[ms][0][i], b = acc[ms][1][i];
        __builtin_nontemporal_store(f2bf(a * sigmoidf(a) * b), &hb[row * FF + col]);
      }
  };
  gemm256_stream(MPX * (FF / 128), D, (long)64 * D, 64, (long)32 * D, toff, setup, epi, smem);
}

DI void phase_gemm_resid(const Params& p, const u16* A, int lda, int K, const u16* Bt, bool last_sub, float scl,
                         int row0, int nrows, char* smem) {
  G256_IDS
  u16* r16 = R16(p, last_sub);
  const u16* xres = XB(p);
  const int mpx = (nrows / 256) / 8;
  auto setup = [&](int xcd, int q, const u16*& Ap, const u16*& Bp) __attribute__((always_inline)) {
    G256_SETUP_IDS
    const int mt = xcd * mpx + (q >> 5) * 8 + (q & 7), nt = (q >> 3) & 3;
    Ap = A + (size_t)mt * 256 * lda;
    Bp = Bt + (size_t)nt * 256 * K;
  };
  auto toff = [&](int r0, int c8, int& aoff, int& boff) __attribute__((always_inline)) {
    aoff = r0 * lda + c8 * 8;
    boff = r0 * K + c8 * 8;
  };
  auto epi = [&](int xcd, int q, f32x16 (&acc)[4][2]) __attribute__((always_inline)) {
    G256_EPI_IDS
    const int mt = xcd * mpx + (q >> 5) * 8 + (q & 7), nt = (q >> 3) & 3;
#pragma unroll
    for (int ms = 0; ms < 4; ++ms)
#pragma unroll
      for (int ns = 0; ns < 2; ++ns)
#pragma unroll
        for (int i = 0; i < 16; ++i) {
          const size_t row = (size_t)row0 + mt * 256 + wm * 128 + ms * 32 + crow(i, lh);
          const int col = nt * 256 + wn * 64 + ns * 32 + lr;
          __builtin_nontemporal_store(__builtin_bit_cast(u16, (_Float16)(ALPHA * bf2f(xres[row * D + col]) + scl * acc[ms][ns][i])), &r16[row * D + col]);
        }
  };
  gemm256_stream(mpx * 4, K, (long)64 * lda, 64, (long)64 * K, toff, setup, epi, smem);
}

DI void phase_ln(const Params& p, const float* g, const float* b, bool final_ln) {
  const int tid_ = otid(); const int lane = tid_ & 63, wave = tid_ >> 6;
  float* X = (float*)launder((char*)p.out);
  const u16* r16 = R16(p, final_ln);
  u16* xb = XB(p);
  float4 gg[4], bb[4];
#pragma unroll
  for (int i = 0; i < 4; ++i) { gg[i] = *(const float4*)(g + i * 256 + lane * 4); bb[i] = *(const float4*)(b + i * 256 + lane * 4); }
  for (int row = blockIdx.x * 8 + wave; row < T; row += gridDim.x * 8) {
    float* xr = X + (size_t)row * D;
    float4 v[4];
    float s = 0.f;
#pragma unroll
    for (int i = 0; i < 4; ++i) {
      const unsigned long long raw = __builtin_nontemporal_load((const unsigned long long*)(r16 + (size_t)row * D + i * 256 + lane * 4));
      v[i].x = (float)__builtin_bit_cast(_Float16, (u16)(raw & 0xffffu));
      v[i].y = (float)__builtin_bit_cast(_Float16, (u16)((raw >> 16) & 0xffffu));
      v[i].z = (float)__builtin_bit_cast(_Float16, (u16)((raw >> 32) & 0xffffu));
      v[i].w = (float)__builtin_bit_cast(_Float16, (u16)(raw >> 48));
      s += v[i].x + v[i].y + v[i].z + v[i].w;
    }
    const float mean = wave_sum(s) * (1.f / D);
    float q = 0.f;
#pragma unroll
    for (int i = 0; i < 4; ++i) {
      v[i].x -= mean; v[i].y -= mean; v[i].z -= mean; v[i].w -= mean;
      q += v[i].x * v[i].x + v[i].y * v[i].y + v[i].z * v[i].z + v[i].w * v[i].w;
    }
    const float rstd = rsqrtf(wave_sum(q) * (1.f / D) + 1e-5f);
#pragma unroll
    for (int i = 0; i < 4; ++i) {
      float4 o;
      o.x = v[i].x * rstd * gg[i].x + bb[i].x; o.y = v[i].y * rstd * gg[i].y + bb[i].y;
      o.z = v[i].z * rstd * gg[i].z + bb[i].z; o.w = v[i].w * rstd * gg[i].w + bb[i].w;
      if (final_ln) {
        float* dst4 = xr + i * 256 + lane * 4;
        __builtin_nontemporal_store(o.x, dst4); __builtin_nontemporal_store(o.y, dst4 + 1);
        __builtin_nontemporal_store(o.z, dst4 + 2); __builtin_nontemporal_store(o.w, dst4 + 3);
      }
      uint2 pk; pk.x = pack2(o.x, o.y); pk.y = pack2(o.z, o.w);
      *(uint2*)(xb + (size_t)row * D + i * 256 + lane * 4) = pk;
    }
  }
}

DI void phase_m1(const Params& p, int l, int grp, char* smem) {
  G256_IDS
  const u16* xb = XB(p) + (size_t)grp * TG * D;
  const u16* wt = WTS(p, l) + W_IN;
  const float* bz = F32L(p, l) + F_BZ;
  u16* z = BUF(p, B_Z);
  u16* vst = BUF(p, B_VST);
  u16* vwt = BUF(p, B_VWT);
  const float2* t64 = TAB64(p);
  const float2* t32 = TAB32(p);
  constexpr int MPX = (TG / 256) / 8, NT = ZW / 256;
  auto setup = [&](int xcd, int q, const u16*& Ap, const u16*& Bp) __attribute__((always_inline)) {
    G256_SETUP_IDS
    const int mt = xcd * MPX + q % MPX, nt = q / MPX;
    Ap = xb + (size_t)mt * 256 * D;
    Bp = wt + (size_t)nt * 256 * D;
  };
  auto toff = [&](int r0, int c8, int& aoff, int& boff) __attribute__((always_inline)) {
    aoff = r0 * D + c8 * 8;
    boff = r0 * D + c8 * 8;
  };
  auto epi = [&](int xcd, int q, f32x16 (&acc)[4][2]) __attribute__((always_inline)) {
    G256_EPI_IDS
    const int mt = xcd * MPX + q % MPX, nt = q / MPX;
    const int cb0 = nt * 256 + wn * 64;
    const int sec = cb0 >> 7, kvg = (cb0 >> 6) & 1;
    const float bias0 = bz[cb0 + lr], bias1 = bz[cb0 + 32 + lr];
    const bool rope64 = (sec >= 23 && sec < 27) || sec == 29 || sec == 31;
    const bool vtr = (sec == 30) || (sec == 32);
    if (vtr) {
      u16* vt = (sec == 30) ? vst : vwt;
#pragma unroll
      for (int ms = 0; ms < 4; ++ms)
#pragma unroll
        for (int ns = 0; ns < 2; ++ns)
#pragma unroll
          for (int gq = 0; gq < 4; ++gq) {
            const int row = mt * 256 + wm * 128 + ms * 32 + 8 * gq + 4 * lh;
            const int bl = row >> 12, s = row & 4095;
            const int dv = ns * 32 + lr;
            const float bs = ns ? bias1 : bias0;
            uint2 pk;
            pk.x = pack2(acc[ms][ns][4 * gq] + bs, acc[ms][ns][4 * gq + 1] + bs);
            pk.y = pack2(acc[ms][ns][4 * gq + 2] + bs, acc[ms][ns][4 * gq + 3] + bs);
            *(uint2*)(vt + ((size_t)(bl * 2 + kvg) * 64 + dv) * SEQ + s) = pk;
          }
    } else if (rope64) {
#pragma unroll
      for (int ms = 0; ms < 4; ++ms)
#pragma unroll
        for (int i = 0; i < 16; ++i) {
          const int row = mt * 256 + wm * 128 + ms * 32 + crow(i, lh);
          const int pos = row & 4095;
          const float2 cs = t64[pos * 32 + lr];
          const float x1 = acc[ms][0][i] + bias0, x2 = acc[ms][1][i] + bias1;
          z[(size_t)row * ZW + cb0 + lr] = f2bf(x1 * cs.x - x2 * cs.y);
          z[(size_t)row * ZW + cb0 + 32 + lr] = f2bf(x1 * cs.y + x2 * cs.x);
        }
    } else {
      const bool rope32 = (cb0 == ZC_KROPE);
#pragma unroll
      for (int ms = 0; ms < 4; ++ms)
#pragma unroll
        for (int ns = 0; ns < 2; ++ns)
#pragma unroll
          for (int i = 0; i < 16; ++i) {
            const int row = mt * 256 + wm * 128 + ms * 32 + crow(i, lh);
            float v = acc[ms][ns][i] + (ns ? bias1 : bias0);
            if (rope32 && ns == 0) {
              const float pr = __shfl_xor(v, 16);
              const float2 cs = t32[(row & 4095) * 16 + (lr & 15)];
              v = (lr < 16) ? (v * cs.x - pr * cs.y) : (pr * cs.y + v * cs.x);
            }
            z[(size_t)row * ZW + cb0 + ns * 32 + lr] = f2bf(v);
          }
    }
  };
  gemm256_stream(MPX * NT, D, (long)64 * D, 64, (long)64 * D, toff, setup, epi, smem);
}

DI void m2_gmlp_ln(const Params& p, int l, int chunk, char* smem) {
  const int tid = otid(), s = tid & 127, cgi = tid >> 7;
  const u16* z = BUF(p, B_Z);
  u16* vl = BUF(p, B_VLNT);
  const float* lg = p.in[9] + (size_t)l * 512 + cgi * 128;
  const float* lb = p.in[10] + (size_t)l * 512 + cgi * 128;
  float* red = (float*)smem;
  const u16* src = z + (size_t)(chunk * 128 + s) * ZW + ZC_V + cgi * 128;
  uint4 v[16];
  float sm = 0.f, sq = 0.f;
#pragma unroll
  for (int i = 0; i < 16; ++i) {
    v[i] = *(const uint4*)(src + i * 8);
    const unsigned w[4] = {v[i].x, v[i].y, v[i].z, v[i].w};
#pragma unroll
    for (int e = 0; e < 4; ++e) {
      const float a = __uint_as_float(w[e] << 16), b = __uint_as_float(w[e] & 0xffff0000u);
      sm += a + b; sq += a * a + b * b;
    }
  }
  __syncthreads();
  red[cgi * 128 + s] = sm;
  red[512 + cgi * 128 + s] = sq;
  __syncthreads();
  const float ts = red[s] + red[128 + s] + red[256 + s] + red[384 + s];
  const float tq = red[512 + s] + red[640 + s] + red[768 + s] + red[896 + s];
  const float mean = ts * (1.f / 512.f);
  const float var = fmaxf(tq * (1.f / 512.f) - mean * mean, 0.f);
  const float rstd = rsqrtf(var + 1e-5f);
  u16* dst = vl + ((size_t)cgi * TG + (size_t)chunk * 128) * 128 + s;
#pragma unroll
  for (int i = 0; i < 16; ++i) {
    const unsigned w[4] = {v[i].x, v[i].y, v[i].z, v[i].w};
#pragma unroll
    for (int e = 0; e < 4; ++e) {
      const float a = __uint_as_float(w[e] << 16), b = __uint_as_float(w[e] & 0xffff0000u);
      const int d0 = i * 8 + e * 2;
      dst[(size_t)d0 * 128] = f2bf((a - mean) * rstd * lg[d0] + lb[d0]);
      dst[(size_t)(d0 + 1) * 128] = f2bf((b - mean) * rstd * lg[d0 + 1] + lb[d0 + 1]);
    }
  }
  __syncthreads();
}

DI void m2_conv(const Params& p, int l, int item) {
  const int tid = otid();
  const u16* z = BUF(p, B_Z);
  u16* P = BUF(p, B_P);
  const float* cw = p.in[14] + (size_t)l * 3 * 512;
#pragma unroll 1
  for (int i = 0; i < 8; ++i) {
    const int vi = tid + 512 * i, tok = item * 64 + (vi >> 6), c0 = (vi & 63) * 8;
    const int s = tok & 4095;
    float y[8];
#pragma unroll
    for (int e = 0; e < 8; ++e) y[e] = 0.f;
#pragma unroll
    for (int k = 0; k < 3; ++k) {
      if (s - 2 + k >= 0) {
        const u16* zr = z + (size_t)(tok - 2 + k) * ZW;
        const uint4 c = *(const uint4*)(zr + ZC_CC + c0), h = *(const uint4*)(zr + ZC_CH + c0);
        const unsigned cwd[4] = {c.x, c.y, c.z, c.w}, hwd[4] = {h.x, h.y, h.z, h.w};
#pragma unroll
        for (int e = 0; e < 4; ++e) {
          const float c_lo = __uint_as_float(cwd[e] << 16), c_hi = __uint_as_float(cwd[e] & 0xffff0000u);
          const float h_lo = __uint_as_float(hwd[e] << 16), h_hi = __uint_as_float(hwd[e] & 0xffff0000u);
          y[2 * e] += c_lo * h_lo * cw[k * 512 + c0 + 2 * e];
          y[2 * e + 1] += c_hi * h_hi * cw[k * 512 + c0 + 2 * e + 1];
        }
      }
    }
    const uint4 b = *(const uint4*)(z + (size_t)tok * ZW + ZC_CB + c0);
    const unsigned bwd[4] = {b.x, b.y, b.z, b.w};
    uint4 o;
    unsigned ow[4];
#pragma unroll
    for (int e = 0; e < 4; ++e)
      ow[e] = pack2(__uint_as_float(bwd[e] << 16) * y[2 * e], __uint_as_float(bwd[e] & 0xffff0000u) * y[2 * e + 1]);
    o.x = ow[0]; o.y = ow[1]; o.z = ow[2]; o.w = ow[3];
    *(uint4*)(P + (size_t)tok * 2048 + 512 + c0) = o;
  }
}

constexpr int RS_OFF = 132 * 1024;
template <int W>
DI void row_rstd(const u16* z, int m0, int c0, char* smem) {
  const int tid = otid(), r = tid >> 1, hf = tid & 1;
  const u16* src = z + (size_t)(m0 + r) * ZW + c0 + hf * (W / 2);
  float sq = 0.f;
#pragma unroll
  for (int i = 0; i < W / 16; ++i) {
    const uint4 v = *(const uint4*)(src + i * 8);
    const unsigned w[4] = {v.x, v.y, v.z, v.w};
#pragma unroll
    for (int e = 0; e < 4; ++e) {
      const float a = __uint_as_float(w[e] << 16), b = __uint_as_float(w[e] & 0xffff0000u);
      sq += a * a + b * b;
    }
  }
  sq += __shfl_xor(sq, 1);
  __syncthreads();
  if (hf == 0) ((float*)(smem + RS_OFF))[r] = rsqrtf(sq * (1.f / W) + 1e-6f);
  __syncthreads();
}

DI void m2_mla_q(const Params& p, int l, int mt, int nt, char* smem) {
  EPI_IDS
  const u16* z = BUF(p, B_Z);
  u16* qb = BUF(p, B_QB);
  const float2* t32 = TAB32(p);
  row_rstd<256>(z, mt * 256, ZC_QLAT, smem);
  f32x16 acc[1][2][2];
  gemm_core<1, 2>(acc, z + (size_t)mt * 256 * ZW + ZC_QLAT, ZW, 64, WTS(p, l) + W_UQ + (size_t)nt * 128 * 256, nullptr, 256, 256, smem);
  const float* rs = (const float*)(smem + RS_OFF);
#pragma unroll
  for (int ms = 0; ms < 2; ++ms)
#pragma unroll
    for (int ns = 0; ns < 2; ++ns) {
      const int cbase = nt * 128 + wn * 64 + ns * 32;
      const bool rope = ((cbase >> 5) % 3) == 2;
#pragma unroll
      for (int i = 0; i < 16; ++i) {
        const int rl = wm * 64 + ms * 32 + crow(i, lh), row = mt * 256 + rl;
        float v = acc[0][ms][ns][i] * rs[rl];
        if (rope) {
          const float pr = __shfl_xor(v, 16);
          const float2 cs = t32[(row & 4095) * 16 + (lr & 15)];
          v = (lr < 16) ? (v * cs.x - pr * cs.y) : (pr * cs.y + v * cs.x);
        }
        qb[(size_t)row * 768 + cbase + lr] = f2bf(v);
      }
    }
}

DI void m2_mla_kv(const Params& p, int l, int mt, int nt, char* smem) {
  EPI_IDS
  const u16* z = BUF(p, B_Z);
  u16* kb = BUF(p, B_KB);
  u16* vt = BUF(p, B_VT);
  row_rstd<128>(z, mt * 256, ZC_KVLAT, smem);
  f32x16 acc[1][2][2];
  gemm_core<1, 2>(acc, z + (size_t)mt * 256 * ZW + ZC_KVLAT, ZW, 64, WTS(p, l) + W_UKV + (size_t)nt * 128 * 128, nullptr, 128, 128, smem);
  const float* rs = (const float*)(smem + RS_OFF);
  if (wn == 0) {
#pragma unroll
    for (int ms = 0; ms < 2; ++ms)
#pragma unroll
      for (int ns = 0; ns < 2; ++ns)
#pragma unroll
        for (int i = 0; i < 16; ++i) {
          const int rl = wm * 64 + ms * 32 + crow(i, lh), row = mt * 256 + rl;
          kb[(size_t)row * 768 + nt * 96 + ns * 32 + lr] = f2bf(acc[0][ms][ns][i] * rs[rl]);
        }
  } else {
#pragma unroll
    for (int ms = 0; ms < 2; ++ms)
#pragma unroll
      for (int ns = 0; ns < 2; ++ns)
#pragma unroll
        for (int gq = 0; gq < 4; ++gq) {
          const int rl = wm * 64 + ms * 32 + 8 * gq + 4 * lh, row = mt * 256 + rl;
          const int bl = row >> 12, s = row & 4095, dv = ns * 32 + lr;
          uint2 pk;
          pk.x = pack2(acc[0][ms][ns][4 * gq] * rs[rl], acc[0][ms][ns][4 * gq + 1] * rs[rl + 1]);
          pk.y = pack2(acc[0][ms][ns][4 * gq + 2] * rs[rl + 2], acc[0][ms][ns][4 * gq + 3] * rs[rl + 3]);
          *(uint2*)(vt + ((size_t)(bl * 8 + nt) * 64 + dv) * SEQ + s) = pk;
        }
  }
#pragma unroll
  for (int i = 0; i < 2; ++i) {
    const int ci = tid + 512 * i, r = ci >> 2, c = ci & 3;
    const size_t row = (size_t)mt * 256 + r;
    *(uint4*)(kb + row * 768 + nt * 96 + 64 + c * 8) = *(const uint4*)(z + row * ZW + ZC_KROPE + c * 8);
  }
}

DI void m2_uv(const Params& p, int l, int it, char* smem) {
  EPI_IDS
  const int kv = it >> 3, g = (it >> 2) & 1, mt = it & 3;
  const u16* z = BUF(p, B_Z);
  float* uv = (float*)(PWS(p) + WS_BIG + B_UV) + ((size_t)(kv * 2 + g) * (TG / 16)) * 128;
  f32x16 acc[1][2][2];
  gemm_core<1, 2>(acc, z + (size_t)mt * 256 * 16 * ZW + (kv ? ZC_NVC : ZC_NKC) + g * 64, (long)16 * ZW, ZW,
                  WTS(p, l) + (kv ? W_CV : W_CK), nullptr, 1024, 1024, smem);
#pragma unroll
  for (int ms = 0; ms < 2; ++ms)
#pragma unroll
    for (int ns = 0; ns < 2; ++ns)
#pragma unroll
      for (int i = 0; i < 16; ++i) {
        const int seg = mt * 256 + wm * 64 + ms * 32 + crow(i, lh), col = wn * 64 + ns * 32 + lr;
        uv[(size_t)seg * 128 + col] = acc[0][ms][ns][i];
      }
}

DI void m2_xkv(const Params& p, int l, int it, char* smem) {
  EPI_IDS
  const int mt = it >> 3, nt = it & 7;
  const u16* mb = (const u16*)(PWS(p) + WS_MEMB);
  u16* kx = (u16*)(PWS(p) + WS_KX);
  u16* vxt = (u16*)(PWS(p) + WS_VXT);
  f32x16 acc[1][2][2];
  gemm_core<1, 2>(acc, mb + (size_t)mt * 256 * D, D, 64, WTS(p, l) + W_XKV + (size_t)nt * 128 * D, nullptr, D, D, smem);
  if (nt < 4) {
#pragma unroll
    for (int ms = 0; ms < 2; ++ms)
#pragma unroll
      for (int ns = 0; ns < 2; ++ns)
#pragma unroll
        for (int i = 0; i < 16; ++i) {
          const size_t row = (size_t)mt * 256 + wm * 64 + ms * 32 + crow(i, lh);
          kx[row * 512 + nt * 128 + wn * 64 + ns * 32 + lr] = f2bf(acc[0][ms][ns][i]);
        }
  } else {
    const int hx = nt - 4;
#pragma unroll
    for (int ms = 0; ms < 2; ++ms)
#pragma unroll
      for (int ns = 0; ns < 2; ++ns)
#pragma unroll
        for (int gq = 0; gq < 4; ++gq) {
          const int mrow = wm * 64 + ms * 32 + 8 * gq + 4 * lh;
          const int dv = wn * 64 + ns * 32 + lr;
          uint2 pk;
          pk.x = pack2(acc[0][ms][ns][4 * gq], acc[0][ms][ns][4 * gq + 1]);
          pk.y = pack2(acc[0][ms][ns][4 * gq + 2], acc[0][ms][ns][4 * gq + 3]);
          *(uint2*)(vxt + ((size_t)(mt * 4 + hx) * 128 + dv) * MEML + mrow) = pk;
        }
  }
}

constexpr int M2_NQ = (TG / 256) * 6, M2_NKV = (TG / 256) * 8, M2_NUV = 16, M2_NLN = TG / 128, M2_NCONV = TG / 64;
DI void phase_m2(const Params& p, int l, int grp, char* smem) {
  constexpr int TOT = M2_NKV + M2_NQ + M2_NUV + M2_NLN + M2_NCONV;
  const int nx = (grp == 0) ? 64 : 0;
  for (int t = blockIdx.x; t < TOT + nx; t += gridDim.x) {
    int it = t;
    if (it >= TOT) { m2_xkv(p, l, it - TOT, smem); continue; }
    if (it < M2_NUV) { m2_uv(p, l, it, smem); continue; }
    it -= M2_NUV;
    if (it < M2_NQ) { m2_mla_q(p, l, it / 6, it % 6, smem); continue; }
    it -= M2_NQ;
    if (it < M2_NKV) { m2_mla_kv(p, l, it >> 3, it & 7, smem); continue; }
    it -= M2_NKV;
    if (it < M2_NLN) { m2_gmlp_ln(p, l, it, smem); continue; }
    it -= M2_NLN;
    m2_conv(p, l, it);
  }
}

template <int DK, int DV>
struct FA {
  static constexpr int KSTR = DK * 2 + 16, VSTR = 144, KBYTES = 64 * KSTR, VBYTES = DV * VSTR, STAGE = KBYTES + VBYTES;
  static constexpr int KCH = 64 * DK / 8, VCH = DV * 8, KN = (KCH + 511) / 512, VN = (VCH + 511) / 512;
};
template <int DK, int DV, int MODE>
DI bool fa_active(int kb, int wave_qmax, unsigned long long sel) {
  bool active = true;
  if (MODE != 0) active = (kb * 64 <= wave_qmax);
  if (MODE == 2) {
    const bool selbit = (sel >> kb) & 1ull;
    if (__ballot(selbit) == 0ull) active = false;
  }
  return active;
}
template <int DK, int DV, int MODE>
DI void fa_qk(f32x16 (&S)[2], const bf16x8 (&q)[DK / 16], const char* base, int lr, int lh) {
  using C = FA<DK, DV>;
#pragma unroll
  for (int ks = 0; ks < 2; ++ks) {
#pragma unroll
    for (int kk = 0; kk < DK / 16; ++kk) {
      const bf16x8 kf = *(const bf16x8*)(base + (ks * 32 + lr) * C::KSTR + (kk * 2 + lh) * 16);
      if (kk == 0) {
#pragma unroll
        for (int i = 0; i < 16; ++i) S[ks][i] = 0.f;
      }
      S[ks] = MFMA(kf, q[kk], S[ks]);
    }
  }
}
template <int DK, int DV, int MODE>
DI void fa_softmax_pv(f32x16 (&S)[2], float& m, float& l, f32x16 (&O)[DV / 32], float scale, const char* base, int kb,
                      int qpos, int wave_qmax, unsigned long long sel, int lr, int lh, int variant = 0) {
  using C = FA<DK, DV>;
  bool selbit = true;
  bool need_mask = false;
  if (MODE != 0) need_mask = (kb * 64 + 63 > wave_qmax - 31);
  if (MODE == 2) selbit = (sel >> kb) & 1ull;
  if (MODE == 3) need_mask = need_mask || (kb * 64 <= wave_qmax - 512);
  const float c2 = scale * 1.4426950408889634f;
  if (need_mask) {
#pragma unroll
    for (int ks = 0; ks < 2; ++ks)
#pragma unroll
      for (int i = 0; i < 16; ++i) {
        const int key = kb * 64 + ks * 32 + crow(i, lh);
        bool valid = key <= qpos;
        if (MODE == 2) valid = valid && selbit;
        if (MODE == 3) valid = valid && (qpos - key < 512);
        S[ks][i] = valid ? S[ks][i] : -1e30f;
      }
  }
  float mx = fmaxf(S[0][0], S[0][1]);
#pragma unroll
  for (int ks = 0; ks < 2; ++ks)
#pragma unroll
    for (int i = (ks ? 0 : 2); i < 16; i += 2) mx = fmaxf(fmaxf(mx, S[ks][i]), S[ks][i + 1]);
  mx = fmaxf(mx, __shfl_xor(mx, 32));
  if (MODE == 2) mx = selbit ? mx : -1e30f;
  const float mn = fmaxf(m, mx);
  if (__any((mn - m) * c2 > 8.f)) {
    const float alpha = __builtin_amdgcn_exp2f((m - mn) * c2);
    m = mn;
    l *= alpha;
#pragma unroll
    for (int d = 0; d < DV / 32; ++d) O[d] = O[d] * alpha;
  }
  float mc = m * c2;
  if (MODE == 2) mc = selbit ? mc : 1e30f;
  const f32x2v c2v = {c2, c2}, mcv = {-mc, -mc};
  f32x2v rs2 = {0.f, 0.f};
#pragma unroll
  for (int ks = 0; ks < 2; ++ks)
#pragma unroll
    for (int st = 0; st < 2; ++st) {
      union { unsigned u[4]; bf16x8 v; } pf;
#pragma unroll
      for (int j = 0; j < 4; ++j) {
        const int i0 = 8 * st + 2 * j;
        f32x2v t = {S[ks][i0], S[ks][i0 + 1]};
        t = __builtin_elementwise_fma(t, c2v, mcv);
        f32x2v pv;
        if (variant == 1) { pv = t; } else {
        pv.x = __builtin_amdgcn_exp2f(t.x);
        pv.y = __builtin_amdgcn_exp2f(t.y);
        }
        if (MODE != 0) {
          if (need_mask) {
            pv.x = (S[ks][i0] > -1e29f) ? pv.x : 0.f;
            pv.y = (S[ks][i0 + 1] > -1e29f) ? pv.y : 0.f;
          }
        }
        rs2 += pv;
        pf.u[j] = __builtin_bit_cast(unsigned, __builtin_convertvector(pv, hwbf16x2));
      }
#pragma unroll
      for (int d = 0; d < DV / 32; ++d) {
        const char* vp = base + C::KBYTES + (d * 32 + lr) * C::VSTR + (ks * 32 + 16 * st + 4 * lh) * 2;
        const s16x4 lo = *(const s16x4*)vp, hi = *(const s16x4*)(vp + 16);
        const bf16x8 vf = __builtin_shufflevector(lo, hi, 0, 1, 2, 3, 4, 5, 6, 7);
        O[d] = MFMA(vf, pf.v, O[d]);
      }
    }
  float rs = rs2.x + rs2.y;
  rs += __shfl_xor(rs, 32);
  l += rs;
}

template <int N> DI void wait_vmcnt() { asm volatile("s_waitcnt vmcnt(%0)" ::"n"(N) : "memory"); }
DI void raw_barrier() {
  asm volatile("s_waitcnt lgkmcnt(0)" ::: "memory");
  __builtin_amdgcn_s_barrier();
  asm volatile("" ::: "memory");
}
template <int DK, int DV, int MODE>
DI void flash_loop(float& m, float& l, f32x16 (&O)[DV / 32], const bf16x8 (&q)[DK / 16], float scale,
                   const u16* __restrict__ Kp, long ldk, const u16* __restrict__ VTp, long ldvt, int kb0, int kb1,
                   int qpos, int wave_qmax, unsigned long long sel, char* smem, int variant = 0) {
  using C = FA<DK, DV>;
  constexpr int KC = C::KSTR / 16, NCH = C::STAGE / 16, NW = NCH / 64, NI = (NW + 7) / 8;
  constexpr int NST = (C::STAGE * 4 <= 100 * 1024) ? 4 : 3;
  static_assert(NCH % 64 == 0 && (64 * KC) % 64 == 0 && NI <= 5, "piece layout");
  const int tid = otid(), lane = tid & 63, wave = tid >> 6, lr = lane & 31, lh = lane >> 5;
  const int ntile = kb1 - kb0;
  __syncthreads();
  if (ntile <= 0) return;
  const u16* src[5];
  long stp[5];
  int ldo[5];
#pragma unroll
  for (int i = 0; i < 5; ++i) {
    src[i] = Kp; stp[i] = 0; ldo[i] = 0;
    if (i < NI) {
      int w_ = i * 8 + wave;
      if (w_ > NW - 1) w_ = NW - 1;
      const int L = w_ * 64 + lane;
      if (w_ < KC) {
        const int row = L / KC;
        int c = L % KC;
        if (c > DK / 8 - 1) c = DK / 8 - 1;
        src[i] = Kp + (long)(kb0 * 64 + row) * ldk + c * 8;
        stp[i] = 64 * ldk;
      } else {
        const int L2 = L - 64 * KC, row = L2 / 9;
        int c = L2 % 9;
        if (c > 7) c = 7;
        src[i] = VTp + (long)row * ldvt + kb0 * 64 + c * 8;
        stp[i] = 64;
      }
      ldo[i] = w_ * 1024;
    }
  }
#define FA_ISSUE(t_, stage_)                                                                              \
  {                                                                                                       \
    _Pragma("unroll") for (int i = 0; i < NI; ++i)                                                        \
        __builtin_amdgcn_global_load_lds((const unsigned*)(src[i] + (long)(t_) * stp[i]),                 \
                                         (unsigned*)(smem + (stage_) * C::STAGE + ldo[i]), 16, 0, 0);      \
  }
  asm volatile("s_waitcnt vmcnt(0)" ::: "memory");
#pragma unroll
  for (int t = 0; t < NST - 1; ++t)
    if (t < ntile) FA_ISSUE(t, t)
  int stage = 0;
  for (int t = 0; t < ntile; ++t) {
    int ahead = ((ntile < t + NST - 1) ? ntile : t + NST - 1) - (t + 1);
    if (NST == 4 && ahead >= 2) wait_vmcnt<2 * NI>();
    else if (ahead >= 1) wait_vmcnt<NI>();
    else wait_vmcnt<0>();
    raw_barrier();
    if (t + NST - 1 < ntile) {
      const int sn = (stage == 0) ? NST - 1 : stage - 1;
      FA_ISSUE(t + NST - 1, sn)
    }
    const int kb = kb0 + t;
    if (fa_active<DK, DV, MODE>(kb, wave_qmax, sel)) {
      f32x16 S[2];
      const char* base = smem + stage * C::STAGE;
      fa_qk<DK, DV, MODE>(S, q, base, lr, lh);
      fa_softmax_pv<DK, DV, MODE>(S, m, l, O, scale, base, kb, qpos, wave_qmax, sel, lr, lh, variant);
    }
    stage = (stage == NST - 1) ? 0 : stage + 1;
  }
  raw_barrier();
}

DI void mla_item(const Params& p, int bl, int h, int qt, char* smem, int variant = 0) {
  const int tid = otid(), lane = tid & 63, wave = tid >> 6, lr = lane & 31, lh = lane >> 5;
  const u16* qb = BUF(p, B_QB);
  const u16* kb = BUF(p, B_KB);
  const u16* vt = BUF(p, B_VT);
  u16* P = BUF(p, B_P);
  const int wq0 = qt * 256 + wave * 32, qpos = wq0 + lr;
  const size_t tok = (size_t)bl * SEQ + qpos;
  bf16x8 q[6];
#pragma unroll
  for (int kk = 0; kk < 6; ++kk) q[kk] = *(const bf16x8*)(qb + tok * 768 + h * 96 + kk * 16 + lh * 8);
  float m = -1e30f, l = 0.f;
  f32x16 O[2];
#pragma unroll
  for (int d = 0; d < 2; ++d)
#pragma unroll
    for (int i = 0; i < 16; ++i) O[d][i] = 0.f;
  flash_loop<96, 64, 1>(m, l, O, q, 0.10206207261596577f, kb + (size_t)bl * SEQ * 768 + h * 96, 768,
                        vt + ((size_t)(bl * 8 + h) * 64) * SEQ, SEQ, 0, 4 * (qt + 1), qpos, wq0 + 31, 0ull, smem, variant);
  if (variant != 0 && l > -1e38f) return;
  const float inv = 1.f / l;
#pragma unroll
  for (int d = 0; d < 2; ++d)
#pragma unroll
    for (int gq = 0; gq < 4; ++gq) {
      uint2 pk;
      pk.x = pack2(O[d][4 * gq] * inv, O[d][4 * gq + 1] * inv);
      pk.y = pack2(O[d][4 * gq + 2] * inv, O[d][4 * gq + 3] * inv);
      *(uint2*)(P + tok * 2048 + 1024 + h * 64 + d * 32 + 8 * gq + 4 * lh) = pk;
    }
}

constexpr int NSA_KC_OFF = 0, NSA_VC_OFF = 36864, NSA_IMP_OFF = 36864 + 33792, NSA_SEL_OFF = 137216;
constexpr int VCSTR = 528;
DI void nsa_item(const Params& p, int l, int bl, int g, int jq, char* smem) {
  const int tid = otid(), lane = tid & 63, wave = tid >> 6, lr = lane & 31, lh = lane >> 5;
  const int hh = wave & 3, qs = wave >> 2;
  const int q0 = jq * 64, qloc = qs * 32 + lr, qpos = q0 + qloc;
  const int head = g * 4 + hh;
  const size_t tokbase = (size_t)bl * SEQ;
  const u16* z = BUF(p, B_Z);
  u16* P = BUF(p, B_P);
  const float scale = 0.125f;
  char* sKc = smem + NSA_KC_OFF;
  char* sVc = smem + NSA_VC_OFF;
  float* sImp = (float*)(smem + NSA_IMP_OFF);
  unsigned char* sSel = (unsigned char*)(smem + NSA_SEL_OFF);

  bf16x8 q[4];
#pragma unroll
  for (int kk = 0; kk < 4; ++kk) q[kk] = *(const bf16x8*)(z + (tokbase + qpos) * ZW + ZC_NQ + head * 64 + kk * 16 + lh * 8);

  const int ncnt = min(255, (q0 + 32) / 16 + 1);
  const int ntile = (ncnt + 63) >> 6;
  __syncthreads();
  {
    const float* uvb = (const float*)(PWS(p) + WS_BIG + B_UV);
    const float* UVk = uvb + ((size_t)(0 * 2 + g) * (TG / 16) + (size_t)bl * 256) * 128;
    const float* UVv = uvb + ((size_t)(1 * 2 + g) * (TG / 16) + (size_t)bl * 256) * 128;
    const float* ck = F32L(p, l) + F_CK;
    const float* cv = F32L(p, l) + F_CV;
    const float2* t64 = TAB64(p);
    for (int idx = tid; idx < ntile * 64 * 32; idx += NTHREADS) {
      const int n = idx >> 5, e = idx & 31;
      float r1 = 0.f, r2 = 0.f, v1 = 0.f, v2 = 0.f;
      if (n < 255) {
        const float k1 = UVk[n * 128 + e] + UVk[(n + 1) * 128 + 64 + e] + ck[e];
        const float k2 = UVk[n * 128 + e + 32] + UVk[(n + 1) * 128 + 96 + e] + ck[e + 32];
        v1 = UVv[n * 128 + e] + UVv[(n + 1) * 128 + 64 + e] + cv[e];
        v2 = UVv[n * 128 + e + 32] + UVv[(n + 1) * 128 + 96 + e] + cv[e + 32];
        const float2 cs = t64[(16 * n + 31) * 32 + e];
        r1 = k1 * cs.x - k2 * cs.y;
        r2 = k1 * cs.y + k2 * cs.x;
      }
      *(u16*)(sKc + n * 144 + e * 2) = f2bf(r1);
      *(u16*)(sKc + n * 144 + (e + 32) * 2) = f2bf(r2);
      *(u16*)(sVc + e * VCSTR + n * 2) = f2bf(v1);
      *(u16*)(sVc + (e + 32) * VCSTR + n * 2) = f2bf(v2);
    }
    for (int idx = tid; idx < 4 * 64 * 65; idx += NTHREADS) sImp[idx] = 0.f;
  }
  __syncthreads();

  float mc = -1e30f, lc = 0.f;
#pragma unroll 1
  for (int t = 0; t < ntile; ++t) {
    f32x16 S[2];
    float mx = -1e30f;
#pragma unroll
    for (int ks = 0; ks < 2; ++ks) {
#pragma unroll
      for (int i = 0; i < 16; ++i) S[ks][i] = 0.f;
#pragma unroll
      for (int kk = 0; kk < 4; ++kk) {
        const bf16x8 kf = *(const bf16x8*)(sKc + (t * 64 + ks * 32 + lr) * 144 + (kk * 2 + lh) * 16);
        S[ks] = MFMA(kf, q[kk], S[ks]);
      }
#pragma unroll
      for (int i = 0; i < 16; ++i) {
        const int n = t * 64 + ks * 32 + crow(i, lh);
        const float tv = (16 * n + 31 <= qpos) ? S[ks][i] * scale : -1e30f;
        S[ks][i] = tv;
        mx = fmaxf(mx, tv);
      }
    }
    mx = fmaxf(mx, __shfl_xor(mx, 32));
    const float mn = fmaxf(mc, mx);
    float rs = 0.f;
#pragma unroll
    for (int ks = 0; ks < 2; ++ks)
#pragma unroll
      for (int i = 0; i < 16; ++i) rs += (S[ks][i] > -1e29f) ? __expf(S[ks][i] - mn) : 0.f;
    rs += __shfl_xor(rs, 32);
    lc = lc * __expf(mc - mn) + rs;
    mc = mn;
  }
  const float invl = (lc > 0.f) ? 1.f / lc : 0.f;

  f32x16 Oo[2];
#pragma unroll
  for (int d = 0; d < 2; ++d)
#pragma unroll
    for (int i = 0; i < 16; ++i) Oo[d][i] = 0.f;
#pragma unroll
  for (int t = 0; t < 4; ++t) {
    if (t < ntile) {
#pragma unroll
      for (int ks = 0; ks < 2; ++ks) {
        f32x16 S;
#pragma unroll
        for (int i = 0; i < 16; ++i) S[i] = 0.f;
#pragma unroll
        for (int kk = 0; kk < 4; ++kk) {
          const bf16x8 kf = *(const bf16x8*)(sKc + (t * 64 + ks * 32 + lr) * 144 + (kk * 2 + lh) * 16);
          S = MFMA(kf, q[kk], S);
        }
#pragma unroll
        for (int i = 0; i < 16; ++i) {
          const int n = t * 64 + ks * 32 + crow(i, lh);
          S[i] = (16 * n + 31 <= qpos) ? __expf(S[i] * scale - mc) * invl : 0.f;
        }
#pragma unroll
        for (int gq = 0; gq < 4; ++gq) {
          const int j = t * 16 + ks * 8 + 2 * gq + lh;
          atomicAdd(&sImp[(hh * 64 + qloc) * 65 + j], S[4 * gq] + S[4 * gq + 1] + S[4 * gq + 2] + 0.5f * S[4 * gq + 3]);
          if (j + 1 < 64) atomicAdd(&sImp[(hh * 64 + qloc) * 65 + j + 1], 0.5f * S[4 * gq + 3]);
        }
#pragma unroll
        for (int st = 0; st < 2; ++st) {
          union { unsigned u[4]; bf16x8 v; } pf;
#pragma unroll
          for (int j = 0; j < 4; ++j) pf.u[j] = pack2(S[8 * st + 2 * j], S[8 * st + 2 * j + 1]);
#pragma unroll
          for (int d = 0; d < 2; ++d) {
            const char* vp = sVc + (d * 32 + lr) * VCSTR + (t * 64 + ks * 32 + 16 * st + 4 * lh) * 2;
            const s16x4 lo = *(const s16x4*)vp, hi = *(const s16x4*)(vp + 16);
            const bf16x8 vf = __builtin_shufflevector(lo, hi, 0, 1, 2, 3, 4, 5, 6, 7);
            Oo[d] = MFMA(vf, pf.v, Oo[d]);
          }
        }
      }
    }
  }
  __syncthreads();

  {
    const int qq = tid >> 3, part = tid & 7;
    float v[8];
#pragma unroll
    for (int k = 0; k < 8; ++k) {
      const int j = part * 8 + k;
      float val = sImp[(0 * 64 + qq) * 65 + j] + sImp[(1 * 64 + qq) * 65 + j] + sImp[(2 * 64 + qq) * 65 + j] + sImp[(3 * 64 + qq) * 65 + j];
      const bool forced = (j == 0) || (j == jq) || (j == jq - 1);
      val = forced ? 1e9f : val;
      val = (j <= jq) ? val : -1.f;
      v[k] = val;
    }
    unsigned taken = 0, selb = 0;
#pragma unroll 1
    for (int r = 0; r < 8; ++r) {
      float best = -2.f;
      int bidx = 1000;
#pragma unroll
      for (int k = 0; k < 8; ++k)
        if (!((taken >> k) & 1u) && v[k] > best) { best = v[k]; bidx = part * 8 + k; }
#pragma unroll
      for (int off = 1; off < 8; off <<= 1) {
        const float ob = __shfl_xor(best, off);
        const int oi = __shfl_xor(bidx, off);
        if (ob > best || (ob == best && oi < bidx)) { best = ob; bidx = oi; }
      }
      if ((bidx >> 3) == part) {
        taken |= 1u << (bidx & 7);
        if (best >= 0.f) selb |= 1u << (bidx & 7);
      }
    }
    sSel[qq * 8 + part] = (unsigned char)selb;
  }
  __syncthreads();
  const unsigned long long sel = *(const unsigned long long*)(sSel + qloc * 8);

  const u16* gz = z + (tokbase + qpos) * ZW + ZC_GATE + head * 3;
  const float g0 = sigmoidf(bf2f(gz[0])), g1 = sigmoidf(bf2f(gz[1])), g2 = sigmoidf(bf2f(gz[2]));
#pragma unroll
  for (int d = 0; d < 2; ++d)
#pragma unroll
    for (int i = 0; i < 16; ++i) Oo[d][i] *= g0;

  {
    float m = -1e30f, ls = 0.f;
    f32x16 O[2];
#pragma unroll
    for (int d = 0; d < 2; ++d)
#pragma unroll
      for (int i = 0; i < 16; ++i) O[d][i] = 0.f;
    flash_loop<64, 64, 2>(m, ls, O, q, scale, z + tokbase * ZW + ZC_NKS + g * 64, ZW,
                          BUF(p, B_VST) + ((size_t)(bl * 2 + g) * 64) * SEQ, SEQ, 0, jq + 1, qpos, q0 + 63, sel, smem);
    const float f = (ls > 0.f) ? g1 / ls : 0.f;
#pragma unroll
    for (int d = 0; d < 2; ++d)
#pragma unroll
      for (int i = 0; i < 16; ++i) Oo[d][i] += f * O[d][i];
  }
  {
    float m = -1e30f, lw = 0.f;
    f32x16 O[2];
#pragma unroll
    for (int d = 0; d < 2; ++d)
#pragma unroll
      for (int i = 0; i < 16; ++i) O[d][i] = 0.f;
    flash_loop<64, 64, 3>(m, lw, O, q, scale, z + tokbase * ZW + ZC_NKW + g * 64, ZW,
                          BUF(p, B_VWT) + ((size_t)(bl * 2 + g) * 64) * SEQ, SEQ, max(0, jq - 8), jq + 1, qpos, q0 + 63, 0ull, smem);
    const float f = (lw > 0.f) ? g2 / lw : 0.f;
#pragma unroll
    for (int d = 0; d < 2; ++d)
#pragma unroll
      for (int i = 0; i < 16; ++i) Oo[d][i] += f * O[d][i];
  }
#pragma unroll
  for (int d = 0; d < 2; ++d)
#pragma unroll
    for (int gq = 0; gq < 4; ++gq) {
      uint2 pk;
      pk.x = pack2(Oo[d][4 * gq], Oo[d][4 * gq + 1]);
      pk.y = pack2(Oo[d][4 * gq + 2], Oo[d][4 * gq + 3]);
      *(uint2*)(P + (tokbase + qpos) * 2048 + 1536 + head * 64 + d * 32 + 8 * gq + 4 * lh) = pk;
    }
  __syncthreads();
}

DI void gmlp_tile(const Params& p, int l, int mt, int g, char* smem) {
  EPI_IDS
  const u16* vl = BUF(p, B_VLNT) + (size_t)g * TG * 128;
  const u16* z = BUF(p, B_Z);
  u16* P = BUF(p, B_P);
  const float* bs = p.in[12] + (size_t)l * 512 + g * 128;
  f32x16 acc[1][2][2];
  gemm_core<1, 2>(acc, vl + (size_t)mt * 256 * 128, 128, 64, WTS(p, l) + W_GWS + (size_t)g * 128 * 128, nullptr, 128, 128, smem);
#pragma unroll
  for (int ms = 0; ms < 2; ++ms)
#pragma unroll
    for (int ns = 0; ns < 2; ++ns) {
      const int t = wn * 64 + ns * 32 + lr;
      const float bias = bs[t];
#pragma unroll
      for (int gq = 0; gq < 4; ++gq) {
        const int R = mt * 256 + wm * 64 + ms * 32 + 8 * gq + 4 * lh;
        const int chunk = R >> 7, d = R & 127;
        const size_t tok = (size_t)chunk * 128 + t;
        const uint2 u = *(const uint2*)(z + tok * ZW + ZC_U + g * 128 + d);
        uint2 pk;
        pk.x = pack2(__uint_as_float(u.x << 16) * (acc[0][ms][ns][4 * gq] + bias),
                     __uint_as_float(u.x & 0xffff0000u) * (acc[0][ms][ns][4 * gq + 1] + bias));
        pk.y = pack2(__uint_as_float(u.y << 16) * (acc[0][ms][ns][4 * gq + 2] + bias),
                     __uint_as_float(u.y & 0xffff0000u) * (acc[0][ms][ns][4 * gq + 3] + bias));
        *(uint2*)(P + tok * 2048 + g * 128 + d) = pk;
      }
    }
}

DI void phase_m3(const Params& p, int l, char* smem, int only = 0) {
  const int xcd = blockIdx.x & 7, nj = gridDim.x >> 3;
  for (int vj = blockIdx.x >> 3; vj < 32; vj += nj) {
    const int hsel = vj >> 4, f = vj & 15;
    const int hd0 = 4 * xcd + hsel, hd1 = 4 * xcd + 2 + hsel;
    if (only == 0 || only == 1 || only >= 10) mla_item(p, hd0 >> 3, hd0 & 7, f, smem, only >= 10 ? only - 10 : 0);
    if (only == 0 || only == 2) nsa_item(p, l, xcd >> 1, xcd & 1, 63 - vj, smem);
    if (only == 0 || only == 1 || only >= 10) mla_item(p, hd1 >> 3, hd1 & 7, 15 - f, smem, only >= 10 ? only - 10 : 0);
    if (only == 0 || only == 2) nsa_item(p, l, xcd >> 1, xcd & 1, vj, smem);
  }
  if (only == 0 || only == 3)
    for (int it = blockIdx.x; it < (TG / 256) * 4; it += gridDim.x) gmlp_tile(p, l, it >> 2, it & 3, smem);
}

DI size_t gate_off(size_t row4, int col) { return (((row4 >> 2) * 128 + (size_t)(col >> 5)) * 32 + (size_t)(col & 31)) * 4; }
DI void phase_m4a(const Params& p, int l, int grp, char* smem) {
  G256_IDS
  const u16* xb = XB(p) + (size_t)grp * TG * D;
  const u16* wt = WTS(p, l) + W_IN + (size_t)ZW * D;
  const float* bgate = F32L(p, l) + F_BGATE;
  u16* gt = BUF(p, B_Z);
  constexpr int MPX = (TG / 256) / 8;
  auto setup = [&](int xcd, int q, const u16*& Ap, const u16*& Bp) __attribute__((always_inline)) {
    G256_SETUP_IDS
    const int mt = xcd * MPX + q % MPX, nt = q / MPX;
    Ap = xb + (size_t)mt * 256 * D;
    Bp = wt + (size_t)nt * 256 * D;
  };
  auto toff = [&](int r0, int c8, int& aoff, int& boff) __attribute__((always_inline)) {
    aoff = r0 * D + c8 * 8;
    boff = r0 * D + c8 * 8;
  };
  auto epi = [&](int xcd, int q, f32x16 (&acc)[4][2]) __attribute__((always_inline)) {
    G256_EPI_IDS
    const int mt = xcd * MPX + q % MPX, nt = q / MPX;
    const int col0 = nt * 256 + wn * 64 + lr;
    const float bias0 = bgate[col0], bias1 = bgate[col0 + 32];
#pragma unroll
    for (int ms = 0; ms < 4; ++ms)
#pragma unroll
      for (int gq = 0; gq < 4; ++gq) {
        const size_t row = (size_t)mt * 256 + wm * 128 + ms * 32 + 8 * gq + 4 * lh;
        uint2 pk0, pk1;
        pk0.x = pack2(sigmoidf(acc[ms][0][4 * gq] + bias0), sigmoidf(acc[ms][0][4 * gq + 1] + bias0));
        pk0.y = pack2(sigmoidf(acc[ms][0][4 * gq + 2] + bias0), sigmoidf(acc[ms][0][4 * gq + 3] + bias0));
        pk1.x = pack2(sigmoidf(acc[ms][1][4 * gq] + bias1), sigmoidf(acc[ms][1][4 * gq + 1] + bias1));
        pk1.y = pack2(sigmoidf(acc[ms][1][4 * gq + 2] + bias1), sigmoidf(acc[ms][1][4 * gq + 3] + bias1));
        *(uint2*)(gt + gate_off(row, col0)) = pk0;
        *(uint2*)(gt + gate_off(row, col0 + 32)) = pk1;
      }
  };
  gemm256_stream(MPX * 16, D, (long)64 * D, 64, (long)64 * D, toff, setup, epi, smem);
}

DI void phase_m4b(const Params& p, int l, char* smem) {
  const u16* P = BUF(p, B_P);
  const u16* gt = BUF(p, B_Z);
  u16* mg = BUF(p, B_MG);
  const u16* w = WTS(p, l);
  for (int qq = blockIdx.x >> 3; qq < 64; qq += (gridDim.x >> 3)) {
    const int mt = (blockIdx.x & 7) * ((TG / 256) / 8) + (qq & 7), nt = qq >> 3;
    f32x16 accm[2][2];
#pragma unroll
    for (int ms = 0; ms < 2; ++ms)
#pragma unroll
      for (int ns = 0; ns < 2; ++ns)
#pragma unroll
        for (int i = 0; i < 16; ++i) accm[ms][ns][i] = 0.f;
#pragma unroll 1
    for (int br = 0; br < 4; ++br) {
      f32x16 ay[1][2][2];
      gemm_core<1, 2>(ay, P + (size_t)mt * 256 * 2048 + br * 512, 2048, 64, w + W_OUT4 + (size_t)br * 1024 * 512 + (size_t)nt * 128 * 512, nullptr, 512, 512, smem);
      EPI_IDS
#pragma unroll
      for (int ms = 0; ms < 2; ++ms)
#pragma unroll
        for (int ns = 0; ns < 2; ++ns)
#pragma unroll
          for (int gq = 0; gq < 4; ++gq) {
            const size_t row = (size_t)mt * 256 + wm * 64 + ms * 32 + 8 * gq + 4 * lh;
            const int col = nt * 128 + wn * 64 + ns * 32 + lr;
            const unsigned long long gq64 = __builtin_nontemporal_load((const unsigned long long*)(gt + gate_off(row, br * 1024 + col)));
            uint2 gv; gv.x = (unsigned)gq64; gv.y = (unsigned)(gq64 >> 32);
            accm[ms][ns][4 * gq] += __uint_as_float(gv.x << 16) * ay[0][ms][ns][4 * gq];
            accm[ms][ns][4 * gq + 1] += __uint_as_float(gv.x & 0xffff0000u) * ay[0][ms][ns][4 * gq + 1];
            accm[ms][ns][4 * gq + 2] += __uint_as_float(gv.y << 16) * ay[0][ms][ns][4 * gq + 2];
            accm[ms][ns][4 * gq + 3] += __uint_as_float(gv.y & 0xffff0000u) * ay[0][ms][ns][4 * gq + 3];
          }
    }
    EPI_IDS
#pragma unroll
    for (int ms = 0; ms < 2; ++ms)
#pragma unroll
      for (int ns = 0; ns < 2; ++ns)
#pragma unroll
        for (int i = 0; i < 16; ++i) {
          const size_t row = (size_t)mt * 256 + wm * 64 + ms * 32 + crow(i, lh);
          mg[row * D + nt * 128 + wn * 64 + ns * 32 + lr] = f2bf(accm[ms][ns][i]);
        }
  }
}

DI void phase_x1(const Params& p, int l, char* smem) {
  G256_IDS
  const u16* xb = XB(p);
  const u16* w = WTS(p, l);
  u16* xq = BUF(p, B_XQ);
  constexpr int MPX = (T / 256) / 8;
  {
    auto setup = [&](int xcd, int q, const u16*& Ap, const u16*& Bp) __attribute__((always_inline)) {
    G256_SETUP_IDS
      const int mt = xcd * MPX + q % MPX, nt = q / MPX;
      Ap = xb + (size_t)mt * 256 * D;
      Bp = w + W_XQ + (size_t)nt * 256 * D;
    };
    auto toff = [&](int r0, int c8, int& aoff, int& boff) __attribute__((always_inline)) {
      aoff = r0 * D + c8 * 8;
      boff = r0 * D + c8 * 8;
    };
    auto epi = [&](int xcd, int q, f32x16 (&acc)[4][2]) __attribute__((always_inline)) {
    G256_EPI_IDS
      const int mt = xcd * MPX + q % MPX, nt = q / MPX;
#pragma unroll
      for (int ms = 0; ms < 4; ++ms)
#pragma unroll
        for (int ns = 0; ns < 2; ++ns)
#pragma unroll
          for (int i = 0; i < 16; ++i) {
            const size_t row = (size_t)mt * 256 + wm * 128 + ms * 32 + crow(i, lh);
            xq[row * 512 + nt * 256 + wn * 64 + ns * 32 + lr] = f2bf(acc[ms][ns][i]);
          }
    };
    gemm256_stream(2 * MPX, D, (long)64 * D, 64, (long)64 * D, toff, setup, epi, smem);
  }
}

DI void phase_x2(const Params& p, char* smem) {
  const int tid = otid(), lane = tid & 63, wave = tid >> 6, lr = lane & 31, lh = lane >> 5;
  const u16* xq = BUF(p, B_XQ);
  u16* xo = BUF(p, B_XO);
  const u16* kx = (const u16*)(PWS(p) + WS_KX);
  const u16* vxt = (const u16*)(PWS(p) + WS_VXT);
  for (int t = blockIdx.x; t < BATCH * 4 * 16; t += gridDim.x) {
    const int b = t >> 6, h = (t >> 4) & 3, qt = t & 15;
    const size_t tok = (size_t)b * SEQ + qt * 256 + wave * 32 + lr;
    bf16x8 q[8];
#pragma unroll
    for (int kk = 0; kk < 8; ++kk) q[kk] = *(const bf16x8*)(xq + tok * 512 + h * 128 + kk * 16 + lh * 8);
    float m = -1e30f, l = 0.f;
    f32x16 O[4];
#pragma unroll
    for (int d = 0; d < 4; ++d)
#pragma unroll
      for (int i = 0; i < 16; ++i) O[d][i] = 0.f;
    flash_loop<128, 128, 0>(m, l, O, q, 0.08838834764831845f, kx + (size_t)b * MEML * 512 + h * 128, 512,
                            vxt + ((size_t)(b * 4 + h) * 128) * MEML, MEML, 0, 4, 0, 0, 0ull, smem);
    const float inv = 1.f / l;
#pragma unroll
    for (int d = 0; d < 4; ++d)
#pragma unroll
      for (int gq = 0; gq < 4; ++gq) {
        uint2 pk;
        pk.x = pack2(O[d][4 * gq] * inv, O[d][4 * gq + 1] * inv);
        pk.y = pack2(O[d][4 * gq + 2] * inv, O[d][4 * gq + 3] * inv);
        *(uint2*)(xo + tok * 512 + h * 128 + d * 32 + 8 * gq + 4 * lh) = pk;
      }
  }
}

#define XB_TMO      128
#define XB_XCNT(j)  (256  + 64 * (j))
#define XB_XSUB(j)  (1280 + 64 * (j))
#define XB_XGEN(j)  (2304 + 64 * (j))
#define XB_TOP      3328
#define XB_TOPGEN   3392
#define XCD_BAR_WORDS 3456
#define XB_SPIN_CAP (1u << 22)
#define LAS __attribute__((address_space(3)))
DI unsigned xb_ld(unsigned* p) { return __hip_atomic_load(p, __ATOMIC_RELAXED, __HIP_MEMORY_SCOPE_AGENT); }
DI unsigned xb_add(unsigned* p, unsigned v) { return __hip_atomic_fetch_add(p, v, __ATOMIC_RELAXED, __HIP_MEMORY_SCOPE_AGENT); }
DI unsigned xb_xcc_id() { return (unsigned)__builtin_amdgcn_s_getreg((3 << 11) | 20) & 0xFu; }
#define XB_SPIN(cond, bar) do { unsigned _sp = 0; while (cond) { __builtin_amdgcn_s_sleep(1); \
    if ((++_sp & 255u) == 0u) { if (xb_ld(&(bar)[XB_TMO])) break; if (_sp > XB_SPIN_CAP) { atomicAdd(&(bar)[XB_TMO], 1u); break; } } } } while (0)
struct XcdBarrier { unsigned* bar; unsigned x; volatile LAS unsigned* st; };
DI XcdBarrier xcd_barrier_post(unsigned* bar, volatile LAS unsigned* st) {
  XcdBarrier b; b.bar = bar; b.x = xb_xcc_id(); b.st = st;
  if (threadIdx.x == 0) (void)xb_add(&bar[XB_XCNT(b.x)], 1u);
  return b;
}
DI void xcd_barrier_complete(unsigned* bar, unsigned x, unsigned& nloc, unsigned& nx) {
  const unsigned G = gridDim.x * gridDim.y * gridDim.z;
  unsigned sum, cnt, mine, sp = 0u;
  for (;;) {
    sum = 0u; cnt = 0u; mine = 0u;
#pragma unroll
    for (unsigned j = 0; j < 16; ++j) { const unsigned c = xb_ld(&bar[XB_XCNT(j)]); sum += c; cnt += (c > 0u) ? 1u : 0u; mine = (j == x) ? c : mine; }
    if (sum == G) break;
    __builtin_amdgcn_s_sleep(1);
    if ((++sp & 255u) == 0u) { if (xb_ld(&bar[XB_TMO])) break; if (sp > XB_SPIN_CAP) { atomicAdd(&bar[XB_TMO], 1u); break; } }
  }
  nloc = mine > 0u ? mine : 1u; nx = cnt > 0u ? cnt : 1u;
}
DI void xcd_barrier(const XcdBarrier& b) {
  asm volatile("s_waitcnt vmcnt(0)" ::: "memory");
  __syncthreads();
  if (threadIdx.x == 0) {
    unsigned* bar = b.bar;
    __builtin_amdgcn_s_waitcnt(0);
    unsigned nloc = b.st[0], nx = b.st[1];
    if (nloc == 0u) { xcd_barrier_complete(bar, b.x, nloc, nx); b.st[0] = nloc; b.st[1] = nx; }
    const unsigned old = xb_add(&bar[XB_XSUB(b.x)], 1u);
    const unsigned gen = old / nloc;
    if (old + 1u == (gen + 1u) * nloc) {
      __builtin_amdgcn_fence(__ATOMIC_RELEASE, "agent");
      asm volatile("s_waitcnt vmcnt(0)" ::: "memory");
      const unsigned og = xb_add(&bar[XB_TOP], 1u);
      const unsigned tg = og / nx;
      if (og + 1u == (tg + 1u) * nx) xb_add(&bar[XB_TOPGEN], 1u);
      else XB_SPIN(xb_ld(&bar[XB_TOPGEN]) == tg, bar);
      __builtin_amdgcn_fence(__ATOMIC_ACQUIRE, "agent");
      xb_add(&bar[XB_XGEN(b.x)], 1u);
      asm volatile("s_waitcnt vmcnt(0)" ::: "memory");
    } else {
      XB_SPIN(xb_ld(&bar[XB_XGEN(b.x)]) == gen, bar);
      __builtin_amdgcn_fence(__ATOMIC_ACQUIRE, "agent");
      asm volatile("s_waitcnt vmcnt(0)" ::: "memory");
    }
  }
  __syncthreads();
}
DI XcdBarrier mk_bar(const Params& p, char* smem) {
  XcdBarrier b;
  b.bar = (unsigned*)(PWS(p) + WS_BAR);
  b.x = xb_xcc_id();
  b.st = (volatile LAS unsigned*)(smem + XB_LDS_OFF);
  return b;
}

enum { PH_INIT, PH_FFN_UP, PH_RESID, PH_LN, PH_M1, PH_M2, PH_M3, PH_M4A, PH_M4B, PH_X1, PH_X2 };
constexpr int STEPS_PER_LAYER = 3 + NGRP * 6 + 8;
constexpr int NSTEPS = 1 + DEPTH * STEPS_PER_LAYER;
#define PROBE_PH (-1)
#define PROBE_SUB 0
__global__ void __launch_bounds__(NTHREADS) k_mega(Params p) {
  extern __shared__ __attribute__((aligned(16))) char smem[];
  cg::grid_group grid = cg::this_grid();
  {
    volatile LAS unsigned* st = (volatile LAS unsigned*)(smem + XB_LDS_OFF);
    if (threadIdx.x == 0) { st[0] = 0u; st[1] = 0u; }
    __syncthreads();
    (void)xcd_barrier_post((unsigned*)(PWS(p) + WS_BAR), st);
  }
#pragma unroll 1
  for (int step = 0; step < NSTEPS; ++step) {
    int ph = PH_INIT, l = 0, grp = 0, var = 0;
    if (step > 0) {
      const int s1 = step - 1;
      l = s1 / STEPS_PER_LAYER;
      const int r = s1 % STEPS_PER_LAYER;
      constexpr int MIXEND = 3 + NGRP * 6;
      if (r == 0) { ph = PH_FFN_UP; var = 0; }
      else if (r == 1) { ph = PH_RESID; var = 0; }
      else if (r == 2) { ph = PH_LN; var = 0; }
      else if (r < MIXEND) {
        const int m = r - 3, k = m % 6;
        grp = m / 6;
        ph = (k == 0) ? PH_M1 : (k == 1) ? PH_M2 : (k == 2) ? PH_M3 : (k == 3) ? PH_M4A : (k == 4) ? PH_M4B : PH_RESID;
        var = 1;
      }
      else if (r == MIXEND) { ph = PH_LN; var = 1; }
      else if (r == MIXEND + 1) { ph = PH_X1; }
      else if (r == MIXEND + 2) { ph = PH_X2; }
      else if (r == MIXEND + 3) { ph = PH_RESID; var = 2; }
      else if (r == MIXEND + 4) { ph = PH_LN; var = 2; }
      else if (r == MIXEND + 5) { ph = PH_FFN_UP; var = 1; }
      else if (r == MIXEND + 6) { ph = PH_RESID; var = 3; }
      else { ph = PH_LN; var = 3; }
    }
    const u16* w = WTS(p, l);
#pragma unroll 1
    for (int rep = 0; rep < ((ph == PROBE_PH) ? 2 : 1); ++rep) {
    switch (ph) {
      case PH_INIT: phase0(p, smem); break;
      case PH_FFN_UP: phase_ffn_up(p, w + (var ? W_F2W1 : W_F1W1), w + (var ? W_F2W3 : W_F1W3), smem); break;
      case PH_RESID: {
        const u16* A; const u16* Bt; const float* res = p.out; int lda, K, row0 = 0, nrows = T; float scl = 1.f;
        if (var == 0) { A = BUF(p, B_H); lda = FF; K = FF; Bt = w + W_F1W2; scl = 0.5f; if (l == 0) res = p.in[0]; }
        else if (var == 1) { A = BUF(p, B_MG); lda = D; K = D; Bt = w + W_O; row0 = grp * TG; nrows = TG; }
        else if (var == 2) { A = BUF(p, B_XO); lda = 512; K = 512; Bt = w + W_XO; }
        else { A = BUF(p, B_H); lda = FF; K = FF; Bt = w + W_F2W2; scl = 0.5f; }
        (void)res;
        phase_gemm_resid(p, A, lda, K, Bt, (l == DEPTH - 1) && (var == 3), scl, row0, nrows, smem);
      } break;
      case PH_LN: {
        const int gi = (var == 0) ? 5 : (var == 1) ? 27 : (var == 2) ? 33 : 38;
        phase_ln(p, p.in[gi] + l * D, p.in[gi + 1] + l * D, (l == DEPTH - 1) && (var == 3));
      } break;
      case PH_M1: phase_m1(p, l, grp, smem); break;
      case PH_M2: phase_m2(p, l, grp, smem); break;
      case PH_M3: phase_m3(p, l, smem, rep ? PROBE_SUB : 0); break;
      case PH_M4A: phase_m4a(p, l, grp, smem); break;
      case PH_M4B: phase_m4b(p, l, smem); break;
      case PH_X1: phase_x1(p, l, smem); break;
      default: phase_x2(p, smem); break;
    }
    if (step == 0) grid.sync();
    else xcd_barrier(mk_bar(p, smem));
    }
  }
}

extern "C" void kernel_launch(void* const* d_in, const int* in_sizes, int n_in, void* d_out, int out_size, void* d_ws,
                              size_t ws_size, hipStream_t stream) {
  (void)in_sizes; (void)out_size;
  if (n_in < 40 || ws_size < WS_TOTAL) {
    fprintf(stderr, "kernel_launch: unexpected inputs (n_in %d, ws %zu < %zu)\n", n_in, ws_size, (size_t)WS_TOTAL);
    return;
  }
  static int grid_blocks = 0;
  if (!grid_blocks) {
    hipFuncSetAttribute((const void*)k_mega, hipFuncAttributeMaxDynamicSharedMemorySize, SMEM_BYTES);
    int dev = 0, cus = 0, per_cu = 0;
    hipGetDevice(&dev);
    hipDeviceGetAttribute(&cus, hipDeviceAttributeMultiprocessorCount, dev);
    hipOccupancyMaxActiveBlocksPerMultiprocessor(&per_cu, k_mega, NTHREADS, SMEM_BYTES);
    if (per_cu < 1) per_cu = 1;
    grid_blocks = cus * per_cu;
  }
  Params p{};
  for (int i = 0; i < 40; ++i) p.in[i] = (const float*)d_in[i];
  p.out = (float*)d_out;
  p.ws = (char*)d_ws;
  hipMemsetAsync((char*)d_ws + WS_BAR, 0, (size_t)XCD_BAR_WORDS * 4, stream);
  void* args[] = {&p};
  hipError_t e = hipLaunchCooperativeKernel((const void*)k_mega, dim3(grid_blocks), dim3(NTHREADS), args, SMEM_BYTES, stream);
  if (e != hipSuccess) fprintf(stderr, "cooperative launch failed: %s (grid %d)\n", hipGetErrorString(e), grid_blocks);
}
```
